# Optimizing an MI355X kernel written in HIP

```python
import jax, jax.numpy as jnp
from jax import lax
import numpy as np

D_MODEL = 1024
BATCH = 16
SEQ = 2048
DEPTH = 4

N_MIXERS = 4
GW = D_MODEL // N_MIXERS
HEAD_DIM = 64
SG_HEADS = GW // HEAD_DIM
SG_CHUNK = 128
CONV_WIDTH = 31
NSA_HEADS = GW // HEAD_DIM
CMP_BLOCK = 32
CMP_STRIDE = 16
SLC_BLOCK = 64
SLC_TOPK = 8
WIN = 512
Q_BLOCK = 128
FORCE_BONUS = 1e4
NEG = -1e30
POOL_WINDOWS = (2, 4, 8, 16)
POOL_GROUP = GW // len(POOL_WINDOWS)
FFN_HIDDEN = -(-8 * D_MODEL // (3 * 256)) * 256
RMS_EPS = 1e-6
LN_EPS = 1e-5
IN_SIZES = (GW, GW, GW, GW, GW, 6 * HEAD_DIM, 3 * NSA_HEADS, GW)
IN_COLS = sum(IN_SIZES)

kernel_name = 'hybrid_parallel_sgmlp_conformer_nsa_pool'


def rmsnorm(x, g):
    xf = x.astype(jnp.float32)
    r = lax.rsqrt(jnp.mean(xf * xf, axis=-1, keepdims=True) + RMS_EPS)
    return (xf * r).astype(x.dtype) * g


def layernorm(x, g, b):
    xf = x.astype(jnp.float32)
    mu = jnp.mean(xf, axis=-1, keepdims=True)
    var = jnp.mean(jnp.square(xf - mu), axis=-1, keepdims=True)
    return ((xf - mu) * lax.rsqrt(var + LN_EPS)).astype(x.dtype) * g + b


def spatial_gating(u, v, ln_g, w_s, b_s):
    B, S, _ = u.shape
    nc = S // SG_CHUNK
    v = layernorm(v, ln_g, jnp.zeros((), v.dtype))
    v = v.reshape(B, nc, SG_CHUNK, SG_HEADS, HEAD_DIM)
    w = jnp.tril(w_s)
    sv = jnp.einsum('hts,bcshd->bcthd', w, v) + b_s.T[None, None, :, :, None]
    return u * sv.reshape(B, S, GW)


def conformer_conv(a, gate, w_dw, b_dw, ln_g, ln_b, w_pw, b_pw):
    h = a * jax.nn.sigmoid(gate)
    h = lax.conv_general_dilated(
        h, w_dw[:, None, :], window_strides=(1,), padding=[(CONV_WIDTH - 1, 0)],
        dimension_numbers=('NWC', 'WIO', 'NWC'), feature_group_count=GW) + b_dw
    h = jax.nn.silu(layernorm(h, ln_g, ln_b))
    return h @ w_pw + b_pw


def nsa_mixer(q, kv, gate_logits, pos_k, pos_v, w1k, w2k, w1v, w2v):
    B, S, _ = q.shape
    H, D = NSA_HEADS, HEAD_DIM
    dt = q.dtype
    q = q.reshape(B, S, H, D) * (D ** -0.5)
    k_c, v_c, k_s, v_s, k_w, v_w = jnp.split(kv, 6, axis=-1)
    pos = np.arange(S)

    n_cmp = (S - CMP_BLOCK) // CMP_STRIDE + 1
    blk_idx = np.arange(n_cmp)[:, None] * CMP_STRIDE + np.arange(CMP_BLOCK)[None, :]

    def compress(t, pe, w1, w2):
        tb = (t[:, blk_idx] + pe).reshape(B, n_cmp, CMP_BLOCK * D)
        return jax.nn.silu(tb @ w1) @ w2

    kc = compress(k_c, pos_k, w1k, w2k)
    vc = compress(v_c, pos_v, w1v, w2v)
    cmp_end = np.arange(n_cmp) * CMP_STRIDE + CMP_BLOCK - 1
    cmask = cmp_end[None, :] <= pos[:, None]
    has_cmp = cmask.any(axis=-1)[:, None]
    s = jnp.einsum('bshd,bcd->bhsc', q, kc).astype(jnp.float32)
    p_cmp = jnp.where(has_cmp, jax.nn.softmax(jnp.where(cmask, s, NEG), axis=-1), 0.0)
    o_cmp = jnp.einsum('bhsc,bcd->bshd', p_cmp.astype(dt), vc)

    n_slc = S // SLC_BLOCK
    c_start = np.arange(n_cmp) * CMP_STRIDE
    j_start = np.arange(n_slc) * SLC_BLOCK
    overlap = ((c_start[:, None] <= j_start[None, :] + SLC_BLOCK - 1)
               & (c_start[:, None] + CMP_BLOCK - 1 >= j_start[None, :])).astype(np.float32)
    imp = jnp.einsum('bhsc,cj->bsj', p_cmp, overlap)
    cur = pos // SLC_BLOCK
    jj = np.arange(n_slc)[None, :]
    valid_blk = j_start[None, :] <= pos[:, None]
    forced = (jj == 0) | (jj == cur[:, None]) | (jj == cur[:, None] - 1)
    score = jnp.where(valid_blk, imp + jnp.where(forced, FORCE_BONUS, 0.0), NEG)
    k_sel = min(SLC_TOPK, n_slc)
    top_val, top_idx = lax.top_k(score, k_sel)
    sel_ok = top_val > NEG / 2

    nb = S // Q_BLOCK
    qb = q.reshape(B, nb, Q_BLOCK, H, D).transpose(1, 0, 2, 3, 4)
    ib = top_idx.reshape(B, nb, Q_BLOCK, k_sel).transpose(1, 0, 2, 3)
    okb = sel_ok.reshape(B, nb, Q_BLOCK, k_sel).transpose(1, 0, 2, 3)
    qposb = jnp.arange(S).reshape(nb, Q_BLOCK)

    def sel_block(args):
        qc, ic, okc, qp = args
        tok = ic[..., None] * SLC_BLOCK + jnp.arange(SLC_BLOCK)
        kg = jax.vmap(lambda t, i: t[i])(k_s, tok)
        vg = jax.vmap(lambda t, i: t[i])(v_s, tok)
        m = okc[..., None] & (tok <= qp[None, :, None, None])
        sc = jnp.einsum('bqhd,bqkld->bhqkl', qc, kg).astype(jnp.float32)
        sc = jnp.where(m[:, None], sc, NEG).reshape(B, H, Q_BLOCK, k_sel * SLC_BLOCK)
        pr = jax.nn.softmax(sc, axis=-1).reshape(B, H, Q_BLOCK, k_sel, SLC_BLOCK)
        return jnp.einsum('bhqkl,bqkld->bqhd', pr.astype(dt), vg)

    o_slc = lax.map(sel_block, (qb, ib, okb, qposb))
    o_slc = o_slc.transpose(1, 0, 2, 3, 4).reshape(B, S, H, D)

    kpad = jnp.pad(k_w, ((0, 0), (WIN, 0), (0, 0)))
    vpad = jnp.pad(v_w, ((0, 0), (WIN, 0), (0, 0)))
    band = np.arange(nb)[:, None] * Q_BLOCK + np.arange(WIN + Q_BLOCK)[None, :]
    kb = kpad[:, band]
    vb = vpad[:, band]
    rel = np.arange(WIN + Q_BLOCK)[None, :] - WIN - np.arange(Q_BLOCK)[:, None]
    wmask = ((rel <= 0) & (rel > -WIN))[None] & ((band - WIN) >= 0)[:, None, :]
    qw = q.reshape(B, nb, Q_BLOCK, H, D)
    sw = jnp.einsum('bnqhd,bnkd->bhnqk', qw, kb).astype(jnp.float32)
    pw = jax.nn.softmax(jnp.where(wmask, sw, NEG), axis=-1)
    o_win = jnp.einsum('bhnqk,bnkd->bnqhd', pw.astype(dt), vb).reshape(B, S, H, D)

    g = jax.nn.sigmoid(gate_logits.reshape(B, S, H, 3))
    o = g[..., 0:1] * o_cmp + g[..., 1:2] * o_slc + g[..., 2:3] * o_win
    return o.reshape(B, S, GW)


def pool_mixer(xd, w_pool, scale):
    B, S, _ = xd.shape
    xf = xd.astype(jnp.float32)
    cs = jnp.pad(jnp.cumsum(xf, axis=1), ((0, 0), (1, 0), (0, 0)))
    t1 = np.arange(1, S + 1)
    outs = []
    for gi, w in enumerate(POOL_WINDOWS):
        sl = slice(gi * POOL_GROUP, (gi + 1) * POOL_GROUP)
        lo = np.maximum(t1 - w, 0)
        cnt = np.minimum(t1, w).astype(np.float32)
        mean = (cs[:, 1:, sl] - cs[:, lo, sl]) / cnt[None, :, None]
        outs.append((mean - xf[..., sl]).astype(xd.dtype) @ w_pool[gi])
    return jnp.concatenate(outs, axis=-1) * scale


def hybrid_layer(x, g_pre_mix, g_post_mix, g_pre_ffn, g_post_ffn, w_in,
                 sg_ln_g, sg_w, sg_b, cv_w, cv_b, cv_ln_g, cv_ln_b, cv_pw, cv_pw_b,
                 cmp_pos_k, cmp_pos_v, cmp_w1_k, cmp_w2_k, cmp_w1_v, cmp_w2_v,
                 pool_w, pool_scale, w_out, ffn_w_gu, ffn_w_down):
    h = rmsnorm(x, g_pre_mix)
    z = h @ w_in
    offs = [int(o) for o in np.cumsum(IN_SIZES)[:-1]]
    a_u, a_v, b_a, b_g, c_q, c_kv, c_gate, d_in = jnp.split(z, offs, axis=-1)
    y_a = spatial_gating(a_u, a_v, sg_ln_g, sg_w, sg_b)
    y_b = conformer_conv(b_a, b_g, cv_w, cv_b, cv_ln_g, cv_ln_b, cv_pw, cv_pw_b)
    y_c = nsa_mixer(c_q, c_kv, c_gate, cmp_pos_k, cmp_pos_v, cmp_w1_k, cmp_w2_k, cmp_w1_v, cmp_w2_v)
    y_d = pool_mixer(d_in, pool_w, pool_scale)
    mix = jnp.concatenate([y_a, y_b, y_c, y_d], axis=-1) @ w_out
    x = x + rmsnorm(mix, g_post_mix)
    h = rmsnorm(x, g_pre_ffn)
    gate, up = jnp.split(h @ ffn_w_gu, 2, axis=-1)
    f = (jax.nn.silu(gate) * up) @ ffn_w_down
    return x + rmsnorm(f, g_post_ffn)


def setup_inputs(seed: int = 0) -> dict:
    key = jax.random.key(seed)
    ks = jax.random.split(key, 32)
    f32 = jnp.float32

    def nrm(k, shape, scale):
        return jax.random.normal(k, shape, f32) * scale

    def gain(k, shape):
        return 1.0 + nrm(k, shape, 0.05)

    L = DEPTH
    return {
        'x': nrm(ks[0], (BATCH, SEQ, D_MODEL), 1.0),
        'g_pre_mix': gain(ks[1], (L, D_MODEL)),
        'g_post_mix': gain(ks[2], (L, D_MODEL)),
        'g_pre_ffn': gain(ks[3], (L, D_MODEL)),
        'g_post_ffn': gain(ks[4], (L, D_MODEL)),
        'w_in': nrm(ks[5], (L, D_MODEL, IN_COLS), D_MODEL ** -0.5),
        'sg_ln_g': gain(ks[6], (L, GW)),
        'sg_w': nrm(ks[7], (L, SG_HEADS, SG_CHUNK, SG_CHUNK), SG_CHUNK ** -0.5),
        'sg_b': 1.0 + nrm(ks[8], (L, SG_HEADS, SG_CHUNK), 0.01),
        'cv_w': nrm(ks[9], (L, CONV_WIDTH, GW), CONV_WIDTH ** -0.5),
        'cv_b': nrm(ks[10], (L, GW), 0.01),
        'cv_ln_g': gain(ks[11], (L, GW)),
        'cv_ln_b': nrm(ks[12], (L, GW), 0.01),
        'cv_pw': nrm(ks[13], (L, GW, GW), GW ** -0.5),
        'cv_pw_b': nrm(ks[14], (L, GW), 0.01),
        'cmp_pos_k': nrm(ks[15], (L, CMP_BLOCK, HEAD_DIM), 0.1),
        'cmp_pos_v': nrm(ks[16], (L, CMP_BLOCK, HEAD_DIM), 0.1),
        'cmp_w1_k': nrm(ks[17], (L, CMP_BLOCK * HEAD_DIM, HEAD_DIM), (CMP_BLOCK * HEAD_DIM) ** -0.5),
        'cmp_w2_k': nrm(ks[18], (L, HEAD_DIM, HEAD_DIM), HEAD_DIM ** -0.5),
        'cmp_w1_v': nrm(ks[19], (L, CMP_BLOCK * HEAD_DIM, HEAD_DIM), (CMP_BLOCK * HEAD_DIM) ** -0.5),
        'cmp_w2_v': nrm(ks[20], (L, HEAD_DIM, HEAD_DIM), HEAD_DIM ** -0.5),
        'pool_w': nrm(ks[21], (L, len(POOL_WINDOWS), POOL_GROUP, POOL_GROUP), POOL_GROUP ** -0.5),
        'pool_scale': gain(ks[22], (L, GW)),
        'w_out': nrm(ks[23], (L, D_MODEL, D_MODEL), D_MODEL ** -0.5),
        'ffn_w_gu': nrm(ks[24], (L, D_MODEL, 2 * FFN_HIDDEN), D_MODEL ** -0.5),
        'ffn_w_down': nrm(ks[25], (L, FFN_HIDDEN, D_MODEL), FFN_HIDDEN ** -0.5),
    }


def reference(x, g_pre_mix, g_post_mix, g_pre_ffn, g_post_ffn, w_in,
              sg_ln_g, sg_w, sg_b, cv_w, cv_b, cv_ln_g, cv_ln_b, cv_pw, cv_pw_b,
              cmp_pos_k, cmp_pos_v, cmp_w1_k, cmp_w2_k, cmp_w1_v, cmp_w2_v,
              pool_w, pool_scale, w_out, ffn_w_gu, ffn_w_down):
    for l in range(DEPTH):
        x = hybrid_layer(x, g_pre_mix[l], g_post_mix[l], g_pre_ffn[l], g_post_ffn[l], w_in[l],
                         sg_ln_g[l], sg_w[l], sg_b[l], cv_w[l], cv_b[l], cv_ln_g[l], cv_ln_b[l],
                         cv_pw[l], cv_pw_b[l], cmp_pos_k[l], cmp_pos_v[l], cmp_w1_k[l], cmp_w2_k[l],
                         cmp_w1_v[l], cmp_w2_v[l], pool_w[l], pool_scale[l], w_out[l],
                         ffn_w_gu[l], ffn_w_down[l])
    return x
```

```cpp
#include <hip/hip_runtime.h>
#include <hip/hip_cooperative_groups.h>
#include <cstdio>
#include <cstdint>
namespace cg = cooperative_groups;
namespace pg8 {
#define PG8_LAS __attribute__((address_space(3)))
typedef unsigned short bf16_t;
typedef short bf16x8 __attribute__((ext_vector_type(8)));
typedef float f32x4 __attribute__((ext_vector_type(4)));
typedef unsigned u32x4 __attribute__((ext_vector_type(4)));
constexpr int BM = 256, BK = 64, HALF = 128, HTB = HALF * BK * 2  , STAGE_BYTES = 8 * HTB, NXCD = 8, WGM = 8;

__host__ __device__ __forceinline__ int lds_byte(int r, int c) { const int st = (r >> 4) * 2 + (c >> 5), rr = r & 15, cc = c & 31, ob = rr * 64 + cc * 2; return st * 1024 + (ob ^ (((ob >> 9) & 1) << 5)); }
__host__ __device__ __forceinline__ void stage_rc(int b, int& R, int& C) { const int st = b / 1024, sb = b % 1024, swz = sb ^ (((sb >> 9) & 1) << 5); R = (st >> 1) * 16 + swz / 64; C = (st & 1) * 32 + (swz % 64) / 2; }
__host__ __device__ __forceinline__ int perm32(int rho) { const int n = rho >> 4, i = rho & 15; return 8 * (i >> 2) + 4 * n + (i & 3); }

struct Unit { int pm, pn; };
struct Gemm { const bf16_t* A; const bf16_t* Bt; int M, N, K; };

struct StaticOrder {
    int nM, nN, nwg, G, c;
    __host__ __device__ void init(int M, int N, int G_, int c_) { nM = M / BM; nN = N / BM; nwg = nM * nN; G = G_; c = c_; }
    __host__ __device__ bool next(int i, Unit& u) const {
        const long L = (long)i * G + c; if (L >= nwg) return false;
        int wgid = (int)L; { const int q = nwg / NXCD, r = nwg % NXCD, xcd = wgid % NXCD, off = wgid / NXCD; wgid = (xcd < r ? xcd * (q + 1) : r * (q + 1) + (xcd - r) * q) + off; }
        const int nig = WGM * nN, gid = wgid / nig, fm = gid * WGM, gsz = (nM - fm) < WGM ? (nM - fm) : WGM;
        u.pm = fm + ((wgid % nig) % gsz); u.pn = (wgid % nig) / gsz; return true;
    }
    __device__ __forceinline__ void a_ready(const Unit&) const {}
    __device__ __forceinline__ void done(const Unit&) const {}
};

__device__ __forceinline__ unsigned cvt_pk_bf16(float lo, float hi) { unsigned r; asm volatile("v_cvt_pk_bf16_f32 %0, %1, %2" : "=v"(r) : "v"(lo), "v"(hi)); return r; }
typedef float f32x2 __attribute__((ext_vector_type(2)));
__device__ __forceinline__ f32x2 gelu_pk(f32x2 v) {
    const f32x2 av = __builtin_elementwise_abs(v), d = av * 0.2316418882f + 1.0f;
    f32x2 t; t.x = __builtin_amdgcn_rcpf(d.x); t.y = __builtin_amdgcn_rcpf(d.y);
    f32x2 q = t * 0.5307027145f + (-0.7265760135f); q = q * t + 0.7107068705f; q = q * t + (-0.142248368f); q = q * t + 0.127414796f; q = q * t;
    const f32x2 s = (v * v) * (-0.72134752044f);
    f32x2 e; e.x = __builtin_amdgcn_exp2f(s.x); e.y = __builtin_amdgcn_exp2f(s.y);
    const f32x2 m = v * (q * e), r = v - m;
    f32x2 o; o.x = v.x < 0.f ? m.x : r.x; o.y = v.y < 0.f ? m.y : r.y; return o;
}

template <int ACT  > struct EpiBf16 {
    static constexpr bool PERM = true, AFTER_DRAIN = false; static_assert(ACT == 0 || ACT == 1, "EpiBf16: ACT is 0 (none) or 1 (gelu_pk)");
    bf16_t* O; int ldc; const float* bias; int split_cols; size_t split_stride; float scale0;
    __device__ __forceinline__ void operator()(const f32x4 (&acc)[2][2][4][2], const Unit& u, int wr, int wc, int fr, int fq) const {
        const int row0 = u.pm * BM + wr * 64 + fr; int colt = u.pn * BM; bf16_t* base = O;
        float sc = 1.f; if (split_cols) { const int t = colt / split_cols; base += (size_t)t * split_stride; colt -= t * split_cols; if (t == 0) sc = scale0; }
        const int col0 = colt + wc * 32 + 8 * fq, bcol0 = u.pn * BM + wc * 32 + 8 * fq;
        f32x4 bv[2][2];
#pragma unroll
        for (int bj = 0; bj < 2; ++bj)
#pragma unroll
            for (int n = 0; n < 2; ++n) bv[bj][n] = bias ? *(const f32x4*)(bias + bcol0 + bj * HALF + 4 * n) : (f32x4){0.f, 0.f, 0.f, 0.f};
#pragma unroll
        for (int ai = 0; ai < 2; ++ai)
#pragma unroll
            for (int m = 0; m < 4; ++m) { bf16_t* rowp = base + (size_t)(row0 + ai * HALF + m * 16) * ldc + col0;
#pragma unroll
                for (int bj = 0; bj < 2; ++bj) { f32x4 v0 = acc[ai][bj][m][0] + bv[bj][0], v1 = acc[ai][bj][m][1] + bv[bj][1];
                    if (ACT == 1) { f32x2 a = gelu_pk((f32x2){v0[0], v0[1]}), b = gelu_pk((f32x2){v0[2], v0[3]}), c = gelu_pk((f32x2){v1[0], v1[1]}), d = gelu_pk((f32x2){v1[2], v1[3]});
                        v0 = (f32x4){a.x, a.y, b.x, b.y}; v1 = (f32x4){c.x, c.y, d.x, d.y}; }
                    v0 = v0 * sc; v1 = v1 * sc; u32x4 w; w.x = cvt_pk_bf16(v0[0], v0[1]); w.y = cvt_pk_bf16(v0[2], v0[3]); w.z = cvt_pk_bf16(v1[0], v1[1]); w.w = cvt_pk_bf16(v1[2], v1[3]);
                    *(u32x4*)(rowp + bj * HALF) = w; } }
    }
};
struct EpiF32 {
    static constexpr bool PERM = false, AFTER_DRAIN = false;
    float* O; int ldc;
    __device__ __forceinline__ void operator()(const f32x4 (&acc)[2][2][4][2], const Unit& u, int wr, int wc, int fr, int fq) const {
        const int row0 = u.pm * BM + wr * 64 + fr, col0 = u.pn * BM + wc * 32 + 4 * fq;
#pragma unroll
        for (int ai = 0; ai < 2; ++ai)
#pragma unroll
            for (int m = 0; m < 4; ++m) { float* rowp = O + (size_t)(row0 + ai * HALF + m * 16) * ldc + col0;
#pragma unroll
                for (int bj = 0; bj < 2; ++bj)
#pragma unroll
                    for (int n = 0; n < 2; ++n) *(f32x4*)(rowp + bj * HALF + n * 16) = acc[ai][bj][m][n]; }
    }
};
struct EpiSwiGLU {
    static constexpr bool PERM = true, AFTER_DRAIN = false;
    bf16_t* O; int ldc; const float* rs;
    __device__ __forceinline__ void operator()(const f32x4 (&acc)[2][2][4][2], const Unit& u, int wr, int wc, int fr, int fq) const {
        const int row0 = u.pm * BM + wr * 64 + fr, col0 = u.pn * HALF + wc * 32 + 8 * fq;
#pragma unroll
        for (int ai = 0; ai < 2; ++ai)
#pragma unroll
            for (int m = 0; m < 4; ++m) { bf16_t* rowp = O + (size_t)(row0 + ai * HALF + m * 16) * ldc + col0;
                const float r = rs[row0 + ai * HALF + m * 16];
                float h[8];
#pragma unroll
                for (int n = 0; n < 2; ++n)
#pragma unroll
                    for (int e = 0; e < 4; ++e) { const float g = acc[ai][0][m][n][e] * r, up = acc[ai][1][m][n][e] * r;
                        h[n * 4 + e] = g * __builtin_amdgcn_rcpf(1.0f + __builtin_amdgcn_exp2f(-1.4426950408889634f * g)) * up; }
                u32x4 w; w.x = cvt_pk_bf16(h[0], h[1]); w.y = cvt_pk_bf16(h[2], h[3]); w.z = cvt_pk_bf16(h[4], h[5]); w.w = cvt_pk_bf16(h[6], h[7]);
                *(u32x4*)rowp = w; }
    }
};
struct EpiBf16RS {
    static constexpr bool PERM = true, AFTER_DRAIN = false;
    bf16_t* O; int ldc; const float* rs;
    __device__ __forceinline__ void operator()(const f32x4 (&acc)[2][2][4][2], const Unit& u, int wr, int wc, int fr, int fq) const {
        const int row0 = u.pm * BM + wr * 64 + fr, col0 = u.pn * BM + wc * 32 + 8 * fq;
#pragma unroll
        for (int ai = 0; ai < 2; ++ai)
#pragma unroll
            for (int m = 0; m < 4; ++m) { bf16_t* rowp = O + (size_t)(row0 + ai * HALF + m * 16) * ldc + col0; const float r = rs[row0 + ai * HALF + m * 16];
#pragma unroll
                for (int bj = 0; bj < 2; ++bj) { const f32x4 v0 = acc[ai][bj][m][0] * r, v1 = acc[ai][bj][m][1] * r;
                    u32x4 w; w.x = cvt_pk_bf16(v0[0], v0[1]); w.y = cvt_pk_bf16(v0[2], v0[3]); w.z = cvt_pk_bf16(v1[0], v1[1]); w.w = cvt_pk_bf16(v1[2], v1[3]);
                    *(u32x4*)(rowp + bj * HALF) = w; } }
    }
};
template <class Epi, class Sched, bool ALIGN_EPI = false, bool SP2 = false>
__device__ __forceinline__ void gemm_phase(PG8_LAS unsigned char* lds, const Gemm g, const Sched& S, const Epi& E) {
    const int tid = threadIdx.x, wid = __builtin_amdgcn_readfirstlane(tid >> 6), lane = tid & 63, wr = wid >> 2, wc = wid & 3, fr = lane & 15, fq = lane >> 4;
    const int K = g.K, nt = K / BK;
    unsigned voffA[2], voffB[2];
#pragma unroll
    for (int i = 0; i < 2; ++i) { int R, C; stage_rc(tid * 16 + i * 8192, R, C); const int Rb = Epi::PERM ? ((R & ~31) + perm32(R & 31)) : R;
        voffA[i] = (unsigned)(R * K + C) * 2u; voffB[i] = (unsigned)(Rb * K + C) * 2u; }
    const size_t kstep = (size_t)(BK * 2);
    const size_t hstep = (size_t)HALF * K * 2;
    const size_t tstep = 2 * hstep;
    const unsigned ldsw = (unsigned)wid * 1024u;
    const int aoff = lds_byte(wr * 64 + fr, fq * 8), boff = lds_byte(wc * 32 + fr, fq * 8);
#define PG8_SA(b, h) (((b) * 2 + (h)) * HTB)
#define PG8_SB(b, h) ((4 + (b) * 2 + (h)) * HTB)
#define PG8_STAGE(bufoff, gbase, voff) do { _Pragma("unroll") for (int _i = 0; _i < 2; ++_i) \
        __builtin_amdgcn_global_load_lds((const unsigned*)((const char*)(gbase) + (voff)[_i]), (PG8_LAS unsigned*)(lds + (bufoff) + ldsw + _i * 8192), 16, 0, 0); } while (0)
#define PG8_LDA(dst, b, h) do { _Pragma("unroll") for (int m = 0; m < 4; ++m) _Pragma("unroll") for (int k = 0; k < 2; ++k) dst[m][k] = *(const PG8_LAS bf16x8*)(lds + PG8_SA(b, h) + aoff + m * 2048 + k * 1024); } while (0)
#define PG8_LDB(dst, b, h) do { _Pragma("unroll") for (int n = 0; n < 2; ++n) _Pragma("unroll") for (int k = 0; k < 2; ++k) dst[n][k] = *(const PG8_LAS bf16x8*)(lds + PG8_SB(b, h) + boff + n * 2048 + k * 1024); } while (0)
#define PG8_MMA(ai, bj, At, Bt) do { __builtin_amdgcn_s_setprio(1); _Pragma("unroll") for (int m = 0; m < 4; ++m) _Pragma("unroll") for (int n = 0; n < 2; ++n) _Pragma("unroll") for (int k = 0; k < 2; ++k) \
        acc[ai][bj][m][n] = __builtin_amdgcn_mfma_f32_16x16x32_bf16(Bt[n][k], At[m][k], acc[ai][bj][m][n], 0, 0, 0); __builtin_amdgcn_s_setprio(0); } while (0)
#define PG8_WAIT_V(n) asm volatile("s_waitcnt vmcnt(" #n ")" ::: "memory")
#define PG8_WAIT_L(n) asm volatile("s_waitcnt lgkmcnt(" #n ")" ::: "memory")
#define PG8_BAR __builtin_amdgcn_s_barrier()
#define PG8_SCHED __builtin_amdgcn_sched_barrier(0)
    Unit cur, nxt; int ui = 0;
    if (!S.next(0, cur)) return;
    f32x4 acc[2][2][4][2];
#pragma unroll
    for (int a = 0; a < 2; ++a)
#pragma unroll
        for (int b = 0; b < 2; ++b)
#pragma unroll
            for (int m = 0; m < 4; ++m)
#pragma unroll
                for (int n = 0; n < 2; ++n) acc[a][b][m][n] = (f32x4){0.f, 0.f, 0.f, 0.f};
    bf16x8 At[4][2], B0[2][2], B1[2][2];
    const char* cA = (const char*)g.A + (size_t)cur.pm * tstep; const char* cB = (const char*)g.Bt + (size_t)cur.pn * tstep;
    S.a_ready(cur);
    if constexpr (SP2) {
        PG8_STAGE(PG8_SB(0, 0), cB, voffB); PG8_STAGE(PG8_SB(0, 1), cB + hstep, voffB); PG8_STAGE(PG8_SA(0, 0), cA, voffA); PG8_STAGE(PG8_SA(0, 1), cA + hstep, voffA);
        if (wr == 1) PG8_BAR;
        PG8_WAIT_V(2); PG8_BAR;
        PG8_STAGE(PG8_SB(1, 0), cB + kstep, voffB); PG8_STAGE(PG8_SA(1, 0), cA + kstep, voffA); PG8_STAGE(PG8_SB(1, 1), cB + hstep + kstep, voffB);
        PG8_WAIT_V(6); PG8_BAR;
    } else {
        PG8_STAGE(PG8_SB(0, 0), cB, voffB); PG8_STAGE(PG8_SA(0, 0), cA, voffA); PG8_STAGE(PG8_SB(0, 1), cB + hstep, voffB); PG8_STAGE(PG8_SA(0, 1), cA + hstep, voffA);
        if (wr == 1) PG8_BAR;
        PG8_WAIT_V(4); PG8_BAR;
        PG8_STAGE(PG8_SB(1, 0), cB + kstep, voffB); PG8_STAGE(PG8_SA(1, 0), cA + kstep, voffA); PG8_STAGE(PG8_SB(1, 1), cB + hstep + kstep, voffB);
        PG8_WAIT_V(6); PG8_BAR;
    }
    for (;;) {
        const bool has_next = S.next(ui + 1, nxt);
        const char* nA = has_next ? (const char*)g.A + (size_t)nxt.pm * tstep : cA; const char* nB = has_next ? (const char*)g.Bt + (size_t)nxt.pn * tstep : cB;
        for (int t = 0; t < nt; t += 2) {
            const bool last = (t == nt - 2);
            const char* a1 = cA + (size_t)(t + 1) * kstep;
            const char* a2 = last ? nA : cA + (size_t)(t + 2) * kstep; const char* b2 = last ? nB : cB + (size_t)(t + 2) * kstep;
            const char* a3 = a2 + kstep; const char* b3 = b2 + kstep;
            if (last && has_next) S.a_ready(nxt);
            if constexpr (SP2) {
            PG8_LDB(B0, 0, 0); PG8_LDB(B1, 0, 1); PG8_SCHED; PG8_LDA(At, 0, 0); PG8_STAGE(PG8_SA(1, 1), a1 + hstep, voffA);
            PG8_WAIT_V(8); PG8_WAIT_L(0); PG8_BAR; PG8_MMA(0, 0, At, B0); PG8_MMA(0, 1, At, B1); PG8_BAR; PG8_SCHED;
            PG8_LDA(At, 0, 1); PG8_STAGE(PG8_SB(0, 0), b2, voffB); PG8_STAGE(PG8_SB(0, 1), b2 + hstep, voffB); PG8_STAGE(PG8_SA(0, 0), a2, voffA);
            PG8_WAIT_V(8); PG8_WAIT_L(0); PG8_BAR; PG8_MMA(1, 0, At, B0); PG8_MMA(1, 1, At, B1); PG8_BAR; PG8_SCHED;
            PG8_LDB(B0, 1, 0); PG8_LDB(B1, 1, 1); PG8_SCHED; PG8_LDA(At, 1, 0); PG8_STAGE(PG8_SA(0, 1), a2 + hstep, voffA);
            PG8_WAIT_V(8); PG8_WAIT_L(0); PG8_BAR; PG8_MMA(0, 0, At, B0); PG8_MMA(0, 1, At, B1); PG8_BAR; PG8_SCHED;
            PG8_LDA(At, 1, 1); PG8_STAGE(PG8_SB(1, 0), b3, voffB); PG8_STAGE(PG8_SB(1, 1), b3 + hstep, voffB); PG8_STAGE(PG8_SA(1, 0), a3, voffA);
            PG8_WAIT_V(8); PG8_WAIT_L(0); PG8_BAR; PG8_MMA(1, 0, At, B0); PG8_MMA(1, 1, At, B1); PG8_BAR; PG8_SCHED;
            } else {
            PG8_LDB(B0, 0, 0); PG8_SCHED; PG8_LDA(At, 0, 0); PG8_STAGE(PG8_SA(1, 1), a1 + hstep, voffA);
            PG8_WAIT_L(8); PG8_BAR; PG8_WAIT_L(0); PG8_MMA(0, 0, At, B0); PG8_BAR; PG8_SCHED;
            PG8_LDB(B1, 0, 1); PG8_STAGE(PG8_SB(0, 0), b2, voffB);
            PG8_BAR; PG8_WAIT_L(0); PG8_MMA(0, 1, At, B1); PG8_BAR;
            PG8_LDA(At, 0, 1); PG8_STAGE(PG8_SA(0, 0), a2, voffA);
            PG8_BAR; PG8_WAIT_L(0); PG8_MMA(1, 0, At, B0); PG8_BAR; PG8_SCHED;
            PG8_STAGE(PG8_SB(0, 1), b2 + hstep, voffB);
            PG8_WAIT_V(6); PG8_BAR; PG8_MMA(1, 1, At, B1); PG8_BAR;
            PG8_LDB(B0, 1, 0); PG8_SCHED; PG8_LDA(At, 1, 0); PG8_STAGE(PG8_SA(0, 1), a2 + hstep, voffA);
            PG8_WAIT_L(8); PG8_BAR; PG8_WAIT_L(0); PG8_MMA(0, 0, At, B0); PG8_BAR; PG8_SCHED;
            PG8_LDB(B1, 1, 1); PG8_STAGE(PG8_SB(1, 0), b3, voffB);
            PG8_BAR; PG8_WAIT_L(0); PG8_MMA(0, 1, At, B1); PG8_BAR;
            PG8_LDA(At, 1, 1); PG8_STAGE(PG8_SA(1, 0), a3, voffA);
            PG8_BAR; PG8_WAIT_L(0); PG8_MMA(1, 0, At, B0); PG8_BAR; PG8_SCHED;
            PG8_STAGE(PG8_SB(1, 1), b3 + hstep, voffB);
            PG8_WAIT_V(6); PG8_BAR; PG8_MMA(1, 1, At, B1); PG8_BAR;
            }
        }
        if constexpr (ALIGN_EPI) { if (wr == 0) PG8_BAR; }
        if constexpr (!Epi::AFTER_DRAIN) { E(acc, cur, wr, wc, fr, fq); S.done(cur); }
        if (!has_next) break;
#pragma unroll
        for (int a = 0; a < 2; ++a)
#pragma unroll
            for (int b = 0; b < 2; ++b)
#pragma unroll
                for (int m = 0; m < 4; ++m)
#pragma unroll
                    for (int n = 0; n < 2; ++n) acc[a][b][m][n] = (f32x4){0.f, 0.f, 0.f, 0.f};
        cur = nxt; cA = nA; cB = nB; ++ui;
        if constexpr (ALIGN_EPI) { if (wr == 1) PG8_BAR; }
    }
    PG8_WAIT_V(0);
    if constexpr (!ALIGN_EPI) { if (wr == 0) PG8_BAR; }
    PG8_BAR;
    if constexpr (Epi::AFTER_DRAIN) { E.fused(acc, cur, wr, wc, fr, fq, lds, wid, lane); S.done(cur); }
#undef PG8_SA
#undef PG8_SB
#undef PG8_STAGE
#undef PG8_LDA
#undef PG8_LDB
#undef PG8_MMA
#undef PG8_WAIT_V
#undef PG8_WAIT_L
#undef PG8_BAR
#undef PG8_SCHED
}
}

#ifndef PG8_SP2
#define PG8_SP2 true
#endif
#ifndef PG8_ALIGN
#define PG8_ALIGN true
#endif

#define LAS __attribute__((address_space(3)))
typedef unsigned short bf16;
typedef unsigned v4u __attribute__((ext_vector_type(4)));
typedef unsigned v2u __attribute__((ext_vector_type(2)));
typedef float f32x4 __attribute__((ext_vector_type(4)));
typedef short bf16x8 __attribute__((ext_vector_type(8)));

constexpr int DM = 1024, NBATCH = 16, SEQ = 2048, DEPTH = 4, MROWS = NBATCH * SEQ, INC = 1932, ZC = 2048, FFH = 2816;
constexpr int NTHREADS = 512, NWAVES = 8;
constexpr int LDS_BYTES = 147456;
constexpr int ZC_AU = 0, ZC_AV = 256, ZC_BA = 512, ZC_BG = 768, ZC_Q = 1024, ZC_KC = 1280, ZC_VC = 1344, ZC_KS = 1408, ZC_VS = 1472, ZC_KW = 1536, ZC_VW = 1600, ZC_D = 1664, ZC_G = 1920;
constexpr size_t MiB = 1u << 20;
constexpr size_t WS_CTL = 0, CTL_BYTES = 16384;
constexpr size_t WS_W = 1 * MiB, WS_WL = 24 * MiB;
constexpr size_t WO_IN = 0, WO_OUT = 4 * MiB, WO_GU = 6 * MiB, WO_DN = 17 * MiB, WO_SG = 23 * MiB - 512 * 1024, WO_PW = WO_SG + 131072, WO_POOL = WO_PW + 131072, WO_W1K = WO_POOL + 32768, WO_W1V = WO_W1K + 262144;
static_assert(WO_DN + (size_t)1024 * 2816 * 2 <= WO_SG && WO_W1V + 262144 <= WS_WL, "weight map");
constexpr size_t WS_H = 98 * MiB, WS_Z = 162 * MiB, WS_MIX = 290 * MiB, WS_HID = 162 * MiB, WS_Y = 354 * MiB;
constexpr size_t WS_VTS = 482 * MiB, WS_VTW = 486 * MiB, WS_KC = 490 * MiB, WS_VCT = 490 * MiB + 262144, WS_R2 = 491 * MiB, WS_END = 493 * MiB;
static_assert(WS_HID + (size_t)MROWS * FFH * 2 <= WS_Y, "hid overlay");

#define LDS_WAIT() asm volatile("s_waitcnt lgkmcnt(0)" ::: "memory")
__device__ __forceinline__ float bflo(unsigned w) { return __uint_as_float(w << 16); }
__device__ __forceinline__ float bfhi(unsigned w) { return __uint_as_float(w & 0xffff0000u); }
__device__ __forceinline__ float bf2f(bf16 v) { return __uint_as_float((unsigned)v << 16); }
__device__ __forceinline__ unsigned f2bf(float f) { unsigned u = __float_as_uint(f); return (u + 0x7fffu + ((u >> 16) & 1u)) >> 16; }
__device__ __forceinline__ unsigned pk2(float lo, float hi) { unsigned r; asm("v_cvt_pk_bf16_f32 %0, %1, %2" : "=v"(r) : "v"(lo), "v"(hi)); return r; }
__device__ __forceinline__ float sigmoidf_(float x) { return __builtin_amdgcn_rcpf(1.0f + __builtin_amdgcn_exp2f(-1.4426950408889634f * x)); }
__device__ __forceinline__ float siluf_(float x) { return x * sigmoidf_(x); }
__device__ __forceinline__ float wave_sum(float v) {
#pragma unroll
    for (int o = 1; o < 64; o <<= 1) v += __shfl_xor(v, o);
    return v;
}
__device__ __forceinline__ f32x4 mfma16(v4u a, v4u b, f32x4 c) {
    return __builtin_amdgcn_mfma_f32_16x16x32_bf16(__builtin_bit_cast(bf16x8, a), __builtin_bit_cast(bf16x8, b), c, 0, 0, 0);
}

struct Args { const float* in[26]; float* out; unsigned char* ws; int ph_lo, ph_hi; };
typedef const __attribute__((address_space(4))) Args* ArgP;
enum { I_X = 0, I_GPM, I_GQM, I_GPF, I_GQF, I_WIN, I_SGLN, I_SGW, I_SGB, I_CVW, I_CVB, I_CVLG, I_CVLB, I_CVPW, I_CVPB, I_POSK, I_POSV, I_W1K, I_W2K, I_W1V, I_W2V, I_POOLW, I_POOLS, I_WOUT, I_GU, I_DN };

__device__ __forceinline__ void tr_item(const float* __restrict__ src, int Nsrc, int K, bf16* dst, int k0, int n0d, int nsrc0, int nvalid, LAS float* scr, int lane, const float* gk = nullptr) {
    const int kk8 = lane >> 3, n4 = (lane & 7) * 4; const bool ok = n4 < nvalid;
#pragma unroll
    for (int i = 0; i < 8; ++i) { const int kk = 8 * i + kk8; f32x4 v = (f32x4){0.f, 0.f, 0.f, 0.f};
        if (ok) { v = *(const f32x4*)(src + (size_t)(k0 + kk) * Nsrc + nsrc0 + n4); if (gk) v = v * gk[k0 + kk]; }
        LAS float* sp = scr + kk * 33 + n4; sp[0] = v.x; sp[1] = v.y; sp[2] = v.z; sp[3] = v.w; }
    LDS_WAIT();
    const int c = lane & 7;
#pragma unroll
    for (int j = 0; j < 4; ++j) { const int n = (lane >> 3) + 8 * j; const LAS float* s = scr + (8 * c) * 33 + n;
        v4u o; o.x = pk2(s[0 * 33], s[1 * 33]); o.y = pk2(s[2 * 33], s[3 * 33]); o.z = pk2(s[4 * 33], s[5 * 33]); o.w = pk2(s[6 * 33], s[7 * 33]);
        *(v4u*)(dst + (size_t)(n0d + n) * K + k0 + 8 * c) = o; }
    LDS_WAIT();
}
constexpr int TI_IN = 1024, TI_OUT = 512, TI_GU = 2816, TI_DN = 1408, TI_PW = 32, TI_POOL = 8, TI_W1 = 64;
constexpr int TI_LAYER = TI_IN + TI_OUT + TI_GU + TI_DN + TI_PW + TI_POOL + 2 * TI_W1;

__device__ __forceinline__ void prologue_item(ArgP A, int it, LAS float* scr, int lane) {
    const int l = it / TI_LAYER; int r = it % TI_LAYER;
    unsigned char* wl = A->ws + WS_W + (size_t)l * WS_WL;
    if (r < TI_IN) { const int kb = r >> 6, nb = r & 63, n0d = 32 * nb; int ns = n0d, nv = 32;
        if (n0d >= ZC_D && n0d < ZC_G) ns = n0d + 12; else if (n0d == ZC_G) { ns = 1664; nv = 12; } else if (n0d > ZC_G) { ns = 0; nv = 0; }
        tr_item(A->in[I_WIN] + (size_t)l * DM * INC, INC, DM, (bf16*)(wl + WO_IN), 64 * kb, n0d, ns, nv, scr, lane, A->in[I_GPM] + l * DM); return; }
    r -= TI_IN;
    if (r < TI_OUT) { const int kb = r >> 5, nb = r & 31;
        tr_item(A->in[I_WOUT] + (size_t)l * DM * DM, DM, DM, (bf16*)(wl + WO_OUT), 64 * kb, 32 * nb, 32 * nb, 32, scr, lane); return; }
    r -= TI_OUT;
    if (r < TI_GU) { const int kb = r / 176, nb = r % 176, n0d = 32 * nb, pn = n0d >> 8, bj = (n0d >> 7) & 1, i0 = n0d & 127;
        tr_item(A->in[I_GU] + (size_t)l * DM * 2 * FFH, 2 * FFH, DM, (bf16*)(wl + WO_GU), 64 * kb, n0d, bj * FFH + 128 * pn + i0, 32, scr, lane, A->in[I_GPF] + l * DM); return; }
    r -= TI_GU;
    if (r < TI_DN) { const int kb = r >> 5, nb = r & 31;
        tr_item(A->in[I_DN] + (size_t)l * FFH * DM, DM, FFH, (bf16*)(wl + WO_DN), 64 * kb, 32 * nb, 32 * nb, 32, scr, lane); return; }
    r -= TI_DN;
    if (r < TI_PW) { const int kb = r >> 3, nb = r & 7;
        tr_item(A->in[I_CVPW] + (size_t)l * 65536, 256, 256, (bf16*)(wl + WO_PW), 64 * kb, 32 * nb, 32 * nb, 32, scr, lane); return; }
    r -= TI_PW;
    if (r < TI_POOL) { const int g = r >> 1, nb = r & 1;
        tr_item(A->in[I_POOLW] + (size_t)l * 16384 + g * 4096, 64, 64, (bf16*)(wl + WO_POOL) + g * 4096, 0, 32 * nb, 32 * nb, 32, scr, lane); return; }
    r -= TI_POOL;
    if (r < TI_W1) { const int kb = r >> 1, nb = r & 1;
        tr_item(A->in[I_W1K] + (size_t)l * 131072, 64, 2048, (bf16*)(wl + WO_W1K), 64 * kb, 32 * nb, 32 * nb, 32, scr, lane); return; }
    r -= TI_W1;
    { const int kb = r >> 1, nb = r & 1;
        tr_item(A->in[I_W1V] + (size_t)l * 131072, 64, 2048, (bf16*)(wl + WO_W1V), 64 * kb, 32 * nb, 32 * nb, 32, scr, lane); }
}

struct NRow { f32x4 x[4], y[4]; };
template <bool HASY>
__device__ __forceinline__ void nr_load(NRow& r, const float* xin, const float* y, int m, int lane) {
    const f32x4* xr = (const f32x4*)(xin + (size_t)m * DM) + lane;
#pragma unroll
    for (int j = 0; j < 4; ++j) r.x[j] = xr[64 * j];
    if (HASY) { const f32x4* yr = (const f32x4*)(y + (size_t)m * DM) + lane;
#pragma unroll
        for (int j = 0; j < 4; ++j) r.y[j] = yr[64 * j]; }
}
template <bool HASY, bool HASH>
__device__ __forceinline__ void nr_proc(NRow& r, const float* g1, float* xout, const float* g2, bf16* Hout, int m, int lane) {
    if (HASY) { float ss = 0.f;
#pragma unroll
        for (int j = 0; j < 4; ++j) ss += (r.y[j].x * r.y[j].x + r.y[j].y * r.y[j].y) + (r.y[j].z * r.y[j].z + r.y[j].w * r.y[j].w);
        const float rr = 1.0f / sqrtf(wave_sum(ss) * (1.0f / DM) + 1e-6f);
        f32x4* xo = (f32x4*)(xout + (size_t)m * DM) + lane;
#pragma unroll
        for (int j = 0; j < 4; ++j) { const f32x4 g = ((const f32x4*)g1)[lane + 64 * j]; r.x[j] = r.x[j] + (r.y[j] * rr) * g; xo[64 * j] = r.x[j]; } }
    if (HASH) { float ss = 0.f;
#pragma unroll
        for (int j = 0; j < 4; ++j) ss += (r.x[j].x * r.x[j].x + r.x[j].y * r.x[j].y) + (r.x[j].z * r.x[j].z + r.x[j].w * r.x[j].w);
        const float rr = 1.0f / sqrtf(wave_sum(ss) * (1.0f / DM) + 1e-6f);
        v2u* ho = (v2u*)(Hout + (size_t)m * DM) + lane;
#pragma unroll
        for (int j = 0; j < 4; ++j) { const f32x4 g = ((const f32x4*)g2)[lane + 64 * j]; const f32x4 o = (r.x[j] * rr) * g; v2u w; w.x = pk2(o.x, o.y); w.y = pk2(o.z, o.w); ho[64 * j] = w; } }
}
template <bool HASY, bool HASH>
__device__ __forceinline__ void norm_rows(const float* xin, const float* y, const float* g1, float* xout, const float* g2, bf16* Hout, int gw, int ngw, int lane) {
    if ((MROWS % (2 * ngw)) == 0) {
        for (int m = gw; m < MROWS; m += 2 * ngw) {
            NRow ra, rb;
            nr_load<HASY>(ra, xin, y, m, lane); nr_load<HASY>(rb, xin, y, m + ngw, lane);
            nr_proc<HASY, HASH>(ra, g1, xout, g2, Hout, m, lane); nr_proc<HASY, HASH>(rb, g1, xout, g2, Hout, m + ngw, lane);
        }
    } else {
        for (int m = gw; m < MROWS; m += ngw) { NRow ra; nr_load<HASY>(ra, xin, y, m, lane); nr_proc<HASY, HASH>(ra, g1, xout, g2, Hout, m, lane); }
    }
}

__device__ __forceinline__ void norm_first(const float* xin, bf16* XB, float* R2, int bid, int G, int wave, int lane) {
    for (int c = bid; c < MROWS / 32; c += G)
        for (int i = 0; i < 4; ++i) { const int m = 32 * c + wave + 8 * i;
            const f32x4* xr = (const f32x4*)(xin + (size_t)m * DM) + lane; f32x4 xv[4]; float ss = 0.f;
#pragma unroll
            for (int j = 0; j < 4; ++j) { xv[j] = xr[64 * j]; ss += (xv[j].x * xv[j].x + xv[j].y * xv[j].y) + (xv[j].z * xv[j].z + xv[j].w * xv[j].w); }
            const float r = 1.0f / sqrtf(wave_sum(ss) * (1.0f / DM) + 1e-6f);
            if (lane == 0) R2[m] = r;
            v2u* ho = (v2u*)(XB + (size_t)m * DM) + lane;
#pragma unroll
            for (int j = 0; j < 4; ++j) { v2u w; w.x = pk2(xv[j].x, xv[j].y); w.y = pk2(xv[j].z, xv[j].w); ho[64 * j] = w; }
        }
}
template <bool LAST, int NR>
__device__ __forceinline__ void norm_bf_rows(const bf16* XB, bf16* XO, const bf16* Yb, const f32x4 (&g)[2][2], float* R2, float* out, int m0, int ngw, int lane) {
    v4u xw[NR][2], yw[NR][2];
#pragma unroll
    for (int r = 0; r < NR; ++r)
#pragma unroll
        for (int j = 0; j < 2; ++j) { const size_t o = (size_t)(m0 + r * ngw) * DM + 8 * lane + 512 * j; xw[r][j] = *(const v4u*)(XB + o); yw[r][j] = *(const v4u*)(Yb + o); }
#pragma unroll
    for (int r = 0; r < NR; ++r) { const int m = m0 + r * ngw;
        float xv[2][8], yv[2][8]; float ss = 0.f;
#pragma unroll
        for (int j = 0; j < 2; ++j) {
            xv[j][0] = bflo(xw[r][j].x); xv[j][1] = bfhi(xw[r][j].x); xv[j][2] = bflo(xw[r][j].y); xv[j][3] = bfhi(xw[r][j].y); xv[j][4] = bflo(xw[r][j].z); xv[j][5] = bfhi(xw[r][j].z); xv[j][6] = bflo(xw[r][j].w); xv[j][7] = bfhi(xw[r][j].w);
            yv[j][0] = bflo(yw[r][j].x); yv[j][1] = bfhi(yw[r][j].x); yv[j][2] = bflo(yw[r][j].y); yv[j][3] = bfhi(yw[r][j].y); yv[j][4] = bflo(yw[r][j].z); yv[j][5] = bfhi(yw[r][j].z); yv[j][6] = bflo(yw[r][j].w); yv[j][7] = bfhi(yw[r][j].w);
#pragma unroll
            for (int e = 0; e < 8; ++e) ss += yv[j][e] * yv[j][e]; }
        const float rr = 1.0f / sqrtf(wave_sum(ss) * (1.0f / DM) + 1e-6f);
        float s2 = 0.f;
#pragma unroll
        for (int j = 0; j < 2; ++j)
#pragma unroll
            for (int e = 0; e < 8; ++e) { xv[j][e] = xv[j][e] + (yv[j][e] * rr) * g[j][e >> 2][e & 3]; s2 += xv[j][e] * xv[j][e]; }
        if (LAST) {
#pragma unroll
            for (int j = 0; j < 2; ++j) { f32x4* op = (f32x4*)(out + (size_t)m * DM + 8 * lane + 512 * j); op[0] = (f32x4){xv[j][0], xv[j][1], xv[j][2], xv[j][3]}; op[1] = (f32x4){xv[j][4], xv[j][5], xv[j][6], xv[j][7]}; }
        } else {
            const float r2 = 1.0f / sqrtf(wave_sum(s2) * (1.0f / DM) + 1e-6f);
            if (lane == 0) R2[m] = r2;
#pragma unroll
            for (int j = 0; j < 2; ++j) { v4u w; w.x = pk2(xv[j][0], xv[j][1]); w.y = pk2(xv[j][2], xv[j][3]); w.z = pk2(xv[j][4], xv[j][5]); w.w = pk2(xv[j][6], xv[j][7]);
                *(v4u*)(XO + (size_t)m * DM + 8 * lane + 512 * j) = w; }
        }
    }
}
template <bool LAST>
__device__ __forceinline__ void norm_bf(const bf16* XB, bf16* XO, const bf16* Yb, const float* g1, float* R2, float* out, int bid, int G, int wave, int lane) {
    f32x4 g[2][2];
#pragma unroll
    for (int j = 0; j < 2; ++j) { g[j][0] = *(const f32x4*)(g1 + 8 * lane + 512 * j); g[j][1] = *(const f32x4*)(g1 + 8 * lane + 512 * j + 4); }
    for (int c = bid; c < MROWS / 32; c += G) norm_bf_rows<LAST, 4>(XB, XO, Yb, g, R2, out, 32 * c + wave, 8, lane);
}

__device__ __forceinline__ void mixer_a(ArgP A, int l, int item, LAS unsigned char* lds, int tid, int wave, int lane) {
    const bf16* Z = (const bf16*)(A->ws + WS_Z); bf16* MIX = (bf16*)(A->ws + WS_MIX);
    const bf16* sgw = (const bf16*)(A->ws + WS_W + (size_t)l * WS_WL + WO_SG);
    const int b = item >> 4, ch = item & 15; const size_t r0 = (size_t)b * SEQ + 128 * ch;
    LAS bf16* VT = (LAS bf16*)lds;
    LAS float* ST = (LAS float*)(lds + 69632);
    { const int s = tid >> 2, qd = tid & 3; float sm = 0.f, sq = 0.f;
#pragma unroll
        for (int i = 0; i < 8; ++i) { const v4u w = *(const v4u*)(Z + (r0 + s) * ZC + ZC_AV + 64 * qd + 8 * i);
            const float a0 = bflo(w.x), a1 = bfhi(w.x), a2 = bflo(w.y), a3 = bfhi(w.y), a4 = bflo(w.z), a5 = bfhi(w.z), a6 = bflo(w.w), a7 = bfhi(w.w);
            sm += ((a0 + a1) + (a2 + a3)) + ((a4 + a5) + (a6 + a7)); sq += ((a0 * a0 + a1 * a1) + (a2 * a2 + a3 * a3)) + ((a4 * a4 + a5 * a5) + (a6 * a6 + a7 * a7)); }
        sm += __shfl_xor(sm, 1); sq += __shfl_xor(sq, 1); sm += __shfl_xor(sm, 2); sq += __shfl_xor(sq, 2);
        const float mu = sm * (1.0f / 256.0f), var = fmaxf(sq * (1.0f / 256.0f) - mu * mu, 0.f);
        if (qd == 0) { ST[2 * s] = mu; ST[2 * s + 1] = 1.0f / sqrtf(var + 1e-5f); } }
    __syncthreads();
    { const int s = tid & 127, og = tid >> 7; const float mu = ST[2 * s], rs = ST[2 * s + 1];
        const float* gp = A->in[I_SGLN] + l * 256;
#pragma unroll 2
        for (int i = 0; i < 8; ++i) { const int oct = og + 4 * i;
            const v4u w = *(const v4u*)(Z + (r0 + s) * ZC + ZC_AV + 8 * oct);
            const f32x4 g0 = *(const f32x4*)(gp + 8 * oct), g1 = *(const f32x4*)(gp + 8 * oct + 4);
            LAS bf16* vp = VT + (8 * oct) * 136 + s;
            vp[0 * 136] = (bf16)f2bf((bflo(w.x) - mu) * rs * g0.x); vp[1 * 136] = (bf16)f2bf((bfhi(w.x) - mu) * rs * g0.y);
            vp[2 * 136] = (bf16)f2bf((bflo(w.y) - mu) * rs * g0.z); vp[3 * 136] = (bf16)f2bf((bfhi(w.y) - mu) * rs * g0.w);
            vp[4 * 136] = (bf16)f2bf((bflo(w.z) - mu) * rs * g1.x); vp[5 * 136] = (bf16)f2bf((bfhi(w.z) - mu) * rs * g1.y);
            vp[6 * 136] = (bf16)f2bf((bflo(w.w) - mu) * rs * g1.z); vp[7 * 136] = (bf16)f2bf((bfhi(w.w) - mu) * rs * g1.w); } }
    __syncthreads();
    const int h = wave >> 1, th = wave & 1, fr = lane & 15, q = lane >> 4;
    f32x4 acc[4][4];
#pragma unroll
    for (int a = 0; a < 4; ++a)
#pragma unroll
        for (int c = 0; c < 4; ++c) acc[a][c] = (f32x4){0.f, 0.f, 0.f, 0.f};
    const bf16* Wb = sgw + (size_t)h * 128 * 128;
#pragma unroll 2
    for (int ks = 0; ks < 4; ++ks) {
        v4u vf[4];
#pragma unroll
        for (int nt = 0; nt < 4; ++nt) vf[nt] = *(const LAS v4u*)(VT + (64 * h + 16 * nt + fr) * 136 + 32 * ks + 8 * q);
#pragma unroll
        for (int mt = 0; mt < 4; ++mt) { const int t = 64 * th + 16 * mt + fr; const v4u wf = *(const v4u*)(Wb + t * 128 + 32 * ks + 8 * q);
#pragma unroll
            for (int nt = 0; nt < 4; ++nt) acc[mt][nt] = mfma16(vf[nt], wf, acc[mt][nt]); }
    }
#pragma unroll
    for (int mt = 0; mt < 4; ++mt) { const int t = 64 * th + 16 * mt + fr; const float bias = A->in[I_SGB][l * 512 + h * 128 + t];
#pragma unroll
        for (int nt = 0; nt < 4; ++nt) { const int d0 = 64 * h + 16 * nt + 4 * q;
            const v2u uw = *(const v2u*)(Z + (r0 + t) * ZC + ZC_AU + d0); const f32x4 a = acc[mt][nt];
            v2u o; o.x = pk2(bflo(uw.x) * (a.x + bias), bfhi(uw.x) * (a.y + bias)); o.y = pk2(bflo(uw.y) * (a.z + bias), bfhi(uw.y) * (a.w + bias));
            *(v2u*)(MIX + (r0 + t) * DM + d0) = o; } }
    __syncthreads();
}

__device__ __forceinline__ void mixer_b(ArgP A, int l, int item, LAS unsigned char* lds, int tid, int wave, int lane) {
    const bf16* Z = (const bf16*)(A->ws + WS_Z); bf16* MIX = (bf16*)(A->ws + WS_MIX);
    const bf16* pwt = (const bf16*)(A->ws + WS_W + (size_t)l * WS_WL + WO_PW);
    const int b = item >> 5, tau = item & 31, t0 = 64 * tau; const size_t r0 = (size_t)b * SEQ + t0;
    LAS bf16* Ht = (LAS bf16*)lds;
    LAS float* CO = (LAS float*)(lds + 49152);
    LAS bf16* AT = (LAS bf16*)lds;
#pragma unroll
    for (int it_ = 0; it_ < 6; ++it_) { const int idx = tid + it_ * NTHREADS; if (idx >= 94 * 32) break; const int i = idx >> 5, oct = idx & 31, t = t0 - 30 + i; v4u o = (v4u){0u, 0u, 0u, 0u};
        if (t >= 0) { const bf16* zp = Z + ((size_t)b * SEQ + t) * ZC; const v4u a = *(const v4u*)(zp + ZC_BA + 8 * oct), g = *(const v4u*)(zp + ZC_BG + 8 * oct);
            o.x = pk2(bflo(a.x) * sigmoidf_(bflo(g.x)), bfhi(a.x) * sigmoidf_(bfhi(g.x))); o.y = pk2(bflo(a.y) * sigmoidf_(bflo(g.y)), bfhi(a.y) * sigmoidf_(bfhi(g.y)));
            o.z = pk2(bflo(a.z) * sigmoidf_(bflo(g.z)), bfhi(a.z) * sigmoidf_(bfhi(g.z))); o.w = pk2(bflo(a.w) * sigmoidf_(bflo(g.w)), bfhi(a.w) * sigmoidf_(bfhi(g.w))); }
        *(LAS v4u*)(Ht + i * 256 + 8 * oct) = o; }
    __syncthreads();
    { const int c = tid & 255, half = tid >> 8; float wt[31];
#pragma unroll
        for (int w = 0; w < 31; ++w) wt[w] = A->in[I_CVW][(size_t)l * 31 * 256 + w * 256 + c];
        const float bias = A->in[I_CVB][l * 256 + c];
#pragma unroll 1
        for (int tg = 0; tg < 4; ++tg) { const int tb = 32 * half + 8 * tg; float ac[8];
#pragma unroll
            for (int j = 0; j < 8; ++j) ac[j] = bias;
#pragma unroll
            for (int i = 0; i < 38; ++i) { const float hv = bf2f(Ht[(tb + i) * 256 + c]);
#pragma unroll
                for (int j = 0; j < 8; ++j) if (i - j >= 0 && i - j < 31) ac[j] += hv * wt[i - j]; }
#pragma unroll
            for (int j = 0; j < 8; ++j) CO[(tb + j) * 256 + c] = ac[j]; } }
    __syncthreads();
    v4u bpf[8][2];
#pragma unroll
    for (int ks = 0; ks < 8; ++ks)
#pragma unroll
        for (int nt = 0; nt < 2; ++nt) bpf[ks][nt] = *(const v4u*)(pwt + (32 * wave + 16 * nt + (lane & 15)) * 256 + 32 * ks + 8 * (lane >> 4));
    { const f32x4 g = *(const f32x4*)(A->in[I_CVLG] + l * 256 + 4 * lane), bb = *(const f32x4*)(A->in[I_CVLB] + l * 256 + 4 * lane);
#if MIXB_LNNEW
        f32x4 v[8]; float sm[8];
#pragma unroll
        for (int i = 0; i < 8; ++i) { v[i] = *(const LAS f32x4*)(CO + (8 * wave + i) * 256 + 4 * lane); sm[i] = (v[i].x + v[i].y) + (v[i].z + v[i].w); }
#pragma unroll
        for (int o = 1; o < 64; o <<= 1)
#pragma unroll
            for (int i = 0; i < 8; ++i) sm[i] += __shfl_xor(sm[i], o);
#pragma unroll
        for (int i = 0; i < 8; ++i) { v[i] = v[i] - sm[i] * (1.0f / 256.0f); sm[i] = (v[i].x * v[i].x + v[i].y * v[i].y) + (v[i].z * v[i].z + v[i].w * v[i].w); }
#pragma unroll
        for (int o = 1; o < 64; o <<= 1)
#pragma unroll
            for (int i = 0; i < 8; ++i) sm[i] += __shfl_xor(sm[i], o);
#pragma unroll
        for (int i = 0; i < 8; ++i) { const float rs = 1.0f / sqrtf(sm[i] * (1.0f / 256.0f) + 1e-5f);
            const f32x4 y = (v[i] * rs) * g + bb; v2u o; o.x = pk2(siluf_(y.x), siluf_(y.y)); o.y = pk2(siluf_(y.z), siluf_(y.w));
            *(LAS v2u*)(AT + (8 * wave + i) * 264 + 4 * lane) = o; } }
#else
        for (int i = 0; i < 8; ++i) { const int t = 8 * wave + i; const f32x4 v = *(const LAS f32x4*)(CO + t * 256 + 4 * lane);
            const float mu = wave_sum((v.x + v.y) + (v.z + v.w)) * (1.0f / 256.0f); const f32x4 d = v - mu;
            const float var = wave_sum((d.x * d.x + d.y * d.y) + (d.z * d.z + d.w * d.w)) * (1.0f / 256.0f); const float rs = 1.0f / sqrtf(var + 1e-5f);
            const f32x4 y = (d * rs) * g + bb; v2u o; o.x = pk2(siluf_(y.x), siluf_(y.y)); o.y = pk2(siluf_(y.z), siluf_(y.w));
            *(LAS v2u*)(AT + t * 264 + 4 * lane) = o; } }
#endif
    __syncthreads();
    const int fr = lane & 15, q = lane >> 4;
    f32x4 acc[4][2];
#pragma unroll
    for (int a = 0; a < 4; ++a)
#pragma unroll
        for (int c = 0; c < 2; ++c) acc[a][c] = (f32x4){0.f, 0.f, 0.f, 0.f};
#pragma unroll
    for (int ks = 0; ks < 8; ++ks) {
#pragma unroll
        for (int mt = 0; mt < 4; ++mt) { const v4u af = *(const LAS v4u*)(AT + (16 * mt + fr) * 264 + 32 * ks + 8 * q);
#pragma unroll
            for (int nt = 0; nt < 2; ++nt) acc[mt][nt] = mfma16(bpf[ks][nt], af, acc[mt][nt]); } }
#pragma unroll
    for (int mt = 0; mt < 4; ++mt)
#pragma unroll
        for (int nt = 0; nt < 2; ++nt) { const int n0 = 32 * wave + 16 * nt + 4 * q; const f32x4 pb = *(const f32x4*)(A->in[I_CVPB] + l * 256 + n0); const f32x4 o = acc[mt][nt] + pb;
            v2u w; w.x = pk2(o.x, o.y); w.y = pk2(o.z, o.w); *(v2u*)(MIX + (r0 + 16 * mt + fr) * DM + 256 + n0) = w; }
    __syncthreads();
}

template <int W>
__device__ __forceinline__ void pool_means(const LAS bf16* Xt, LAS bf16* AT, int c, int half, int t0) {
    float xv[47];
#pragma unroll
    for (int i = 0; i < 47; ++i) xv[i] = (i >= 16 - W) ? bf2f(Xt[(32 * half + i) * 256 + c]) : 0.f;
    float s = 0.f;
#pragma unroll
    for (int i = 0; i < W; ++i) s += xv[15 - i];
#pragma unroll
    for (int j = 0; j < 32; ++j) { const int jj = 32 * half + j, t = t0 + jj;
        if (j > 0) s += xv[15 + j] - xv[15 + j - W];
        const int cnt = (t + 1 < W) ? (t + 1) : W;
        AT[jj * 264 + c] = (bf16)f2bf(s / (float)cnt - xv[15 + j]); }
}

__device__ __forceinline__ void mixer_d(ArgP A, int l, int item, LAS unsigned char* lds, int tid, int wave, int lane) {
    const bf16* Z = (const bf16*)(A->ws + WS_Z); bf16* MIX = (bf16*)(A->ws + WS_MIX);
    const bf16* poolt = (const bf16*)(A->ws + WS_W + (size_t)l * WS_WL + WO_POOL);
    bf16* VTS = (bf16*)(A->ws + WS_VTS); bf16* VTW = (bf16*)(A->ws + WS_VTW);
    const int b = item >> 5, tau = item & 31, t0 = 64 * tau; const size_t r0 = (size_t)b * SEQ + t0;
    LAS bf16* Xt = (LAS bf16*)lds;
    LAS bf16* AT = (LAS bf16*)(lds + 40960);
    LAS bf16* TS = (LAS bf16*)(lds + 75776);
#pragma unroll
    for (int it_ = 0; it_ < 5; ++it_) { const int idx = tid + it_ * NTHREADS; if (idx >= 79 * 32) break; const int i = idx >> 5, oct = idx & 31, t = t0 - 15 + i; v4u o = (v4u){0u, 0u, 0u, 0u};
        if (t >= 0) o = *(const v4u*)(Z + ((size_t)b * SEQ + t) * ZC + ZC_D + 8 * oct);
        *(LAS v4u*)(Xt + i * 256 + 8 * oct) = o; }
    { const int tok = tid & 63, oct = tid >> 6; const bf16* zp = Z + (r0 + tok) * ZC;
        const v4u a = *(const v4u*)(zp + ZC_VS + 8 * oct), c = *(const v4u*)(zp + ZC_VW + 8 * oct);
        LAS bf16* p0 = TS + (8 * oct) * 72 + tok; LAS bf16* p1 = p0 + 4608;
        p0[0] = (bf16)(a.x & 0xffffu); p0[72] = (bf16)(a.x >> 16); p0[144] = (bf16)(a.y & 0xffffu); p0[216] = (bf16)(a.y >> 16);
        p0[288] = (bf16)(a.z & 0xffffu); p0[360] = (bf16)(a.z >> 16); p0[432] = (bf16)(a.w & 0xffffu); p0[504] = (bf16)(a.w >> 16);
        p1[0] = (bf16)(c.x & 0xffffu); p1[72] = (bf16)(c.x >> 16); p1[144] = (bf16)(c.y & 0xffffu); p1[216] = (bf16)(c.y >> 16);
        p1[288] = (bf16)(c.z & 0xffffu); p1[360] = (bf16)(c.z >> 16); p1[432] = (bf16)(c.w & 0xffffu); p1[504] = (bf16)(c.w >> 16); }
    __syncthreads();
#if MIXD_NEW
    { const int c = tid & 255, half = tid >> 8, g = c >> 6;
        if (g == 0) pool_means<2>(Xt, AT, c, half, t0); else if (g == 1) pool_means<4>(Xt, AT, c, half, t0); else if (g == 2) pool_means<8>(Xt, AT, c, half, t0); else pool_means<16>(Xt, AT, c, half, t0); }
#else
    { const int c = tid & 255, half = tid >> 8, g = c >> 6, w = 2 << g;
        for (int j = 0; j < 32; ++j) { const int jj = 32 * half + j, t = t0 + jj; float s = 0.f;
            for (int i = 0; i < w; ++i) s += bf2f(Xt[(15 + jj - i) * 256 + c]);
            const int cnt = (t + 1 < w) ? (t + 1) : w;
            const float mval = s / (float)cnt - bf2f(Xt[(15 + jj) * 256 + c]);
            AT[jj * 264 + c] = (bf16)f2bf(mval); } }
#endif
    { const int d = tid >> 3, pc = tid & 7;
        *(v4u*)(VTS + ((size_t)b * 64 + d) * SEQ + t0 + 8 * pc) = *(const LAS v4u*)(TS + d * 72 + 8 * pc);
        *(v4u*)(VTW + ((size_t)b * 64 + d) * SEQ + t0 + 8 * pc) = *(const LAS v4u*)(TS + 4608 + d * 72 + 8 * pc); }
    __syncthreads();
    const int fr = lane & 15, q = lane >> 4, g = wave >> 1, nh = wave & 1;
    f32x4 acc[4][2];
#pragma unroll
    for (int a = 0; a < 4; ++a)
#pragma unroll
        for (int c = 0; c < 2; ++c) acc[a][c] = (f32x4){0.f, 0.f, 0.f, 0.f};
#pragma unroll
    for (int ks = 0; ks < 2; ++ks) { v4u bfr[2];
#pragma unroll
        for (int nt = 0; nt < 2; ++nt) bfr[nt] = *(const v4u*)(poolt + g * 4096 + (32 * nh + 16 * nt + fr) * 64 + 32 * ks + 8 * q);
#pragma unroll
        for (int mt = 0; mt < 4; ++mt) { const v4u af = *(const LAS v4u*)(AT + (16 * mt + fr) * 264 + 64 * g + 32 * ks + 8 * q);
#pragma unroll
            for (int nt = 0; nt < 2; ++nt) acc[mt][nt] = mfma16(bfr[nt], af, acc[mt][nt]); } }
#pragma unroll
    for (int mt = 0; mt < 4; ++mt)
#pragma unroll
        for (int nt = 0; nt < 2; ++nt) { const int n0 = 64 * g + 32 * nh + 16 * nt + 4 * q; const f32x4 sc = *(const f32x4*)(A->in[I_POOLS] + l * 256 + n0); const f32x4 o = acc[mt][nt] * sc;
            v2u w; w.x = pk2(o.x, o.y); w.y = pk2(o.z, o.w); *(v2u*)(MIX + (r0 + 16 * mt + fr) * DM + 768 + n0) = w; }
    __syncthreads();
}

__device__ __forceinline__ void nsa_compress(ArgP A, int l, int item, LAS unsigned char* lds, int tid, int wave, int lane) {
    const bf16* Z = (const bf16*)(A->ws + WS_Z);
    bf16* KC = (bf16*)(A->ws + WS_KC); bf16* VCT = (bf16*)(A->ws + WS_VCT);
    const int b = item >> 4, kv = (item >> 3) & 1, mt = item & 7;
    const int colb = kv ? ZC_VC : ZC_KC;
    const float* pos = A->in[kv ? I_POSV : I_POSK] + l * 2048;
    const bf16* w1t = (const bf16*)(A->ws + WS_W + (size_t)l * WS_WL + (kv ? WO_W1V : WO_W1K));
    const float* w2 = A->in[kv ? I_W2V : I_W2K] + l * 4096;
    LAS float* RED = (LAS float*)lds;
    LAS float* H1 = (LAS float*)(lds + 32768);
    const int fr = lane & 15, q = lane >> 4, c = 16 * mt + fr; const bool cok = c < 127;
    f32x4 acc[4];
#pragma unroll
    for (int n = 0; n < 4; ++n) acc[n] = (f32x4){0.f, 0.f, 0.f, 0.f};
#pragma unroll 4
    for (int kk = 0; kk < 8; ++kk) { const int ks = 8 * wave + kk, ltok = ks >> 1, dd = 32 * (ks & 1) + 8 * q;
        v4u af = (v4u){0u, 0u, 0u, 0u};
        if (cok) { const v4u zw = *(const v4u*)(Z + ((size_t)b * SEQ + 16 * c + ltok) * ZC + colb + dd);
            const f32x4 p0 = *(const f32x4*)(pos + ltok * 64 + dd), p1 = *(const f32x4*)(pos + ltok * 64 + dd + 4);
            af.x = pk2(bflo(zw.x) + p0.x, bfhi(zw.x) + p0.y); af.y = pk2(bflo(zw.y) + p0.z, bfhi(zw.y) + p0.w);
            af.z = pk2(bflo(zw.z) + p1.x, bfhi(zw.z) + p1.y); af.w = pk2(bflo(zw.w) + p1.z, bfhi(zw.w) + p1.w); }
#pragma unroll
        for (int nt = 0; nt < 4; ++nt) { const v4u bfr = *(const v4u*)(w1t + (16 * nt + fr) * 2048 + 32 * ks + 8 * q); acc[nt] = mfma16(af, bfr, acc[nt]); } }
#pragma unroll
    for (int nt = 0; nt < 4; ++nt)
#pragma unroll
        for (int rg = 0; rg < 4; ++rg) RED[(wave * 16 + 4 * q + rg) * 64 + 16 * nt + fr] = acc[nt][rg];
    __syncthreads();
#pragma unroll
    for (int x = 0; x < 2; ++x) { const int o = tid + 512 * x, cc = o >> 6, n = o & 63; float s = 0.f;
#pragma unroll
        for (int w = 0; w < 8; ++w) s += RED[(w * 16 + cc) * 64 + n];
        H1[o] = siluf_(s); }
    __syncthreads();
#pragma unroll
    for (int x = 0; x < 2; ++x) { const int o = tid + 512 * x, cc = o >> 6, n2 = o & 63; float s = 0.f;
        for (int n = 0; n < 64; ++n) s += H1[cc * 64 + n] * w2[n * 64 + n2];
        const int cg_ = 16 * mt + cc;
        (kv == 0 ? KC : VCT)[((size_t)b * 128 + cg_) * 64 + n2] = (bf16)f2bf(s); }
    __syncthreads();
}

template <class MaskA, class MaskB>
__device__ __forceinline__ void attn_pair(const LAS bf16* KT, const LAS bf16* VT, const v4u (&qf)[2], int fr, int q, float& m_run, f32x4& o5, f32x4 (&o)[4],
                                          float rba, float rbb, bool ma, bool mb, MaskA okA, MaskB okB) {
    v4u kf0[8], kf1[8];
#pragma unroll
    for (int nt = 0; nt < 8; ++nt) { kf0[nt] = *(const LAS v4u*)(KT + (16 * nt + fr) * 72 + 8 * q); kf1[nt] = *(const LAS v4u*)(KT + (16 * nt + fr) * 72 + 32 + 8 * q); }
    __builtin_amdgcn_sched_barrier(0);
    f32x4 s[8];
#pragma unroll
    for (int nt = 0; nt < 8; ++nt) { const float rb = nt < 4 ? rba : rbb;
        s[nt] = mfma16(kf0[nt], qf[0], (f32x4){rb, rb, rb, rb}); s[nt] = mfma16(kf1[nt], qf[1], s[nt]); }
    __builtin_amdgcn_sched_barrier(0);
    v2u vfa[4][4], vfb[4][4];
#pragma unroll
    for (int k2 = 0; k2 < 4; ++k2)
#pragma unroll
        for (int dt = 0; dt < 4; ++dt) { vfa[k2][dt] = *(const LAS v2u*)(VT + (16 * dt + fr) * 136 + 32 * k2 + 4 * q); vfb[k2][dt] = *(const LAS v2u*)(VT + (16 * dt + fr) * 136 + 32 * k2 + 16 + 4 * q); }
    __builtin_amdgcn_sched_barrier(0);
    if (ma) {
#pragma unroll
        for (int nt = 0; nt < 4; ++nt)
#pragma unroll
            for (int rg = 0; rg < 4; ++rg) s[nt][rg] = okA(16 * nt + 4 * q + rg) ? s[nt][rg] : -1e30f; }
    if (mb) {
#pragma unroll
        for (int nt = 0; nt < 4; ++nt)
#pragma unroll
            for (int rg = 0; rg < 4; ++rg) s[4 + nt][rg] = okB(16 * nt + 4 * q + rg) ? s[4 + nt][rg] : -1e30f; }
    float mx = m_run;
#pragma unroll
    for (int nt = 0; nt < 8; ++nt)
#pragma unroll
        for (int rg = 0; rg < 4; ++rg) mx = fmaxf(mx, s[nt][rg]);
    mx = fmaxf(mx, __shfl_xor(mx, 16)); mx = fmaxf(mx, __shfl_xor(mx, 32));
    if (__ballot(mx != m_run) != 0ull) {
        const float sc = __builtin_amdgcn_exp2f(m_run - mx); m_run = mx; o5 = o5 * sc;
#pragma unroll
        for (int dt = 0; dt < 4; ++dt) o[dt] = o[dt] * sc; }
#pragma unroll
    for (int nt = 0; nt < 8; ++nt)
#pragma unroll
        for (int rg = 0; rg < 4; ++rg) s[nt][rg] = __builtin_amdgcn_exp2f(s[nt][rg] - mx);
    const unsigned onesw = (fr == 0) ? 0x3f803f80u : 0u; const v4u vones = (v4u){onesw, onesw, onesw, onesw};
#pragma unroll
    for (int k2 = 0; k2 < 4; ++k2) { v4u pf; pf.x = pk2(s[2 * k2][0], s[2 * k2][1]); pf.y = pk2(s[2 * k2][2], s[2 * k2][3]); pf.z = pk2(s[2 * k2 + 1][0], s[2 * k2 + 1][1]); pf.w = pk2(s[2 * k2 + 1][2], s[2 * k2 + 1][3]);
        o5 = mfma16(vones, pf, o5);
#pragma unroll
        for (int dt = 0; dt < 4; ++dt) { v4u vf; vf.x = vfa[k2][dt].x; vf.y = vfa[k2][dt].y; vf.z = vfb[k2][dt].x; vf.w = vfb[k2][dt].y; o[dt] = mfma16(vf, pf, o[dt]); } }
}

__device__ __forceinline__ void nsa_attn(ArgP A, int l, int item, LAS unsigned char* lds, int tid, int wave, int lane, int dry = 0) {
    const bf16* Z = (const bf16*)(A->ws + WS_Z); bf16* MIX = (bf16*)(A->ws + WS_MIX);
    const bf16* VTS = (const bf16*)(A->ws + WS_VTS); const bf16* VTW = (const bf16*)(A->ws + WS_VTW);
    const bf16* KC = (const bf16*)(A->ws + WS_KC); const bf16* VCT = (const bf16*)(A->ws + WS_VCT);
    const int jq = item >> 8, ib = item & 255, b = 2 * (ib & 7) + ((ib >> 3) & 1), a = ib >> 4;
    const int tau = (jq == 0) ? a : (jq == 1) ? 31 - a : (jq == 2) ? 32 + a : 63 - a;
    const int t0 = 32 * tau;
    LAS bf16* TB = (LAS bf16*)lds;
    LAS bf16* KT = TB; LAS bf16* VT = TB + 9216;
    LAS float* PS = (LAS float*)(lds + 71680) + wave * (16 * 132);
    LAS float* IMP = (LAS float*)(lds + 139264) + wave * 128;
    LAS unsigned* WANY = (LAS unsigned*)(lds + 143360);
    const int fr = lane & 15, q = lane >> 4, tt = fr >> 2, hh = fr & 3;
    const int t = t0 + 4 * wave + tt; const size_t grow = (size_t)b * SEQ + t;
    const int skey = tid >> 3, spc = tid & 7;
    const int curb = t0 >> 6, wlo = (t0 >= 511) ? ((t0 - 511) >> 6) : 0;
    const bf16* kbase = Z + ((size_t)b * SEQ + skey) * ZC + 8 * spc;
    const size_t vbase = ((size_t)b * 64 + skey) * SEQ + 8 * spc;
    const v4u zero4 = (v4u){0u, 0u, 0u, 0u};
    v4u kr[2], vr[2];
    kr[0] = *(const v4u*)(kbase + ZC_KS); vr[0] = *(const v4u*)(VTS + vbase);
    if (curb > 0) { kr[1] = *(const v4u*)(kbase + (size_t)(64 * curb) * ZC + ZC_KS); vr[1] = *(const v4u*)(VTS + vbase + 64 * curb); } else { kr[1] = zero4; vr[1] = zero4; }
    v4u qf[2];
#pragma unroll
    for (int ks = 0; ks < 2; ++ks) { const v4u w = *(const v4u*)(Z + grow * ZC + ZC_Q + 64 * hh + 32 * ks + 8 * q);
        const float qs = 0.125f * 1.4426950408889634f;
        qf[ks].x = pk2(bflo(w.x) * qs, bfhi(w.x) * qs); qf[ks].y = pk2(bflo(w.y) * qs, bfhi(w.y) * qs);
        qf[ks].z = pk2(bflo(w.z) * qs, bfhi(w.z) * qs); qf[ks].w = pk2(bflo(w.w) * qs, bfhi(w.w) * qs); }
    const float g0 = sigmoidf_(bf2f(Z[grow * ZC + ZC_G + 3 * hh + 0])), g1 = sigmoidf_(bf2f(Z[grow * ZC + ZC_G + 3 * hh + 1])), g2 = sigmoidf_(bf2f(Z[grow * ZC + ZC_G + 3 * hh + 2]));
#pragma unroll
    for (int x = 0; x < 2; ++x) { const int pi = tid + 512 * x;
        { const int c = pi >> 3, pc = pi & 7; *(LAS v4u*)(KT + c * 72 + 8 * pc) = *(const v4u*)(KC + ((size_t)b * 128 + c) * 64 + 8 * pc); }
        { const int c = pi >> 3, pc = pi & 7; const v4u w = *(const v4u*)(VCT + ((size_t)b * 128 + c) * 64 + 8 * pc); LAS bf16* vp = VT + (8 * pc) * 136 + c;
            vp[0] = (bf16)(w.x & 0xffffu); vp[136] = (bf16)(w.x >> 16); vp[272] = (bf16)(w.y & 0xffffu); vp[408] = (bf16)(w.y >> 16);
            vp[544] = (bf16)(w.z & 0xffffu); vp[680] = (bf16)(w.z >> 16); vp[816] = (bf16)(w.w & 0xffffu); vp[952] = (bf16)(w.w >> 16); } }
    __syncthreads();
    f32x4 facc[4];
    unsigned long long bal0, bal1;
    {
        f32x4 s[8];
#pragma unroll
        for (int nt = 0; nt < 8; ++nt) { const v4u k0 = *(const LAS v4u*)(KT + (16 * nt + fr) * 72 + 8 * q), k1 = *(const LAS v4u*)(KT + (16 * nt + fr) * 72 + 32 + 8 * q);
            s[nt] = mfma16(k0, qf[0], (f32x4){0.f, 0.f, 0.f, 0.f}); s[nt] = mfma16(k1, qf[1], s[nt]); }
        float mx = -1e30f;
#pragma unroll
        for (int nt = 0; nt < 8; ++nt)
#pragma unroll
            for (int rg = 0; rg < 4; ++rg) { const int c = 16 * nt + 4 * q + rg; const float v = (16 * c + 31 <= t) ? s[nt][rg] : -1e30f; s[nt][rg] = v; mx = fmaxf(mx, v); }
        mx = fmaxf(mx, __shfl_xor(mx, 16)); mx = fmaxf(mx, __shfl_xor(mx, 32));
        float sum = 0.f;
#pragma unroll
        for (int nt = 0; nt < 8; ++nt)
#pragma unroll
            for (int rg = 0; rg < 4; ++rg) { const float p = (s[nt][rg] > -5e29f) ? __builtin_amdgcn_exp2f(s[nt][rg] - mx) : 0.f; s[nt][rg] = p; sum += p; }
        sum += __shfl_xor(sum, 16); sum += __shfl_xor(sum, 32);
        const float inv = (t >= 31) ? 1.0f / sum : 0.f;
#pragma unroll
        for (int nt = 0; nt < 8; ++nt) { s[nt] = s[nt] * inv; *(LAS f32x4*)(PS + fr * 132 + 16 * nt + 4 * q) = s[nt]; }
        f32x4 oc[4];
#pragma unroll
        for (int dt = 0; dt < 4; ++dt) oc[dt] = (f32x4){0.f, 0.f, 0.f, 0.f};
#pragma unroll
        for (int k2 = 0; k2 < 4; ++k2) { v4u pf; pf.x = pk2(s[2 * k2][0], s[2 * k2][1]); pf.y = pk2(s[2 * k2][2], s[2 * k2][3]); pf.z = pk2(s[2 * k2 + 1][0], s[2 * k2 + 1][1]); pf.w = pk2(s[2 * k2 + 1][2], s[2 * k2 + 1][3]);
#pragma unroll
            for (int dt = 0; dt < 4; ++dt) { const v2u va = *(const LAS v2u*)(VT + (16 * dt + fr) * 136 + 32 * k2 + 4 * q), vb = *(const LAS v2u*)(VT + (16 * dt + fr) * 136 + 32 * k2 + 16 + 4 * q);
                v4u vf; vf.x = va.x; vf.y = va.y; vf.z = vb.x; vf.w = vb.y; oc[dt] = mfma16(vf, pf, oc[dt]); } }
#pragma unroll
        for (int dt = 0; dt < 4; ++dt) facc[dt] = oc[dt] * g0;
        LDS_WAIT();
        const int tt2 = lane >> 4, jl = lane & 15, t2 = t0 + 4 * wave + tt2, cur = t2 >> 6;
        float key[2];
#pragma unroll
        for (int x = 0; x < 2; ++x) { const int j = jl + 16 * x; float im = 0.f;
#pragma unroll
            for (int i = 0; i < 5; ++i) { const int c = 4 * j - 1 + i;
                if (c >= 0 && c <= 126) { im += PS[(4 * tt2 + 0) * 132 + c]; im += PS[(4 * tt2 + 1) * 132 + c]; im += PS[(4 * tt2 + 2) * 132 + c]; im += PS[(4 * tt2 + 3) * 132 + c]; } }
            const bool valid = j <= cur, forced = (j == 0) | (j == cur) | (j == cur - 1);
            key[x] = valid ? (forced ? im + 1e4f : im) : -1e30f; IMP[tt2 * 32 + j] = key[x]; }
        LDS_WAIT();
        int rk0 = 0, rk1 = 0;
        f32x4 kq[8];
#pragma unroll
        for (int i = 0; i < 8; ++i) kq[i] = *(const LAS f32x4*)(IMP + tt2 * 32 + 4 * i);
#pragma unroll
        for (int j2 = 0; j2 < 32; ++j2) { const float k2 = kq[j2 >> 2][j2 & 3];
            rk0 += ((k2 > key[0]) || (k2 == key[0] && j2 < jl)) ? 1 : 0; rk1 += ((k2 > key[1]) || (k2 == key[1] && j2 < jl + 16)) ? 1 : 0; }
        const bool sel0 = (jl <= cur) && rk0 < 8, sel1 = (jl + 16 <= cur) && rk1 < 8;
        bal0 = __ballot(sel0); bal1 = __ballot(sel1);
    }
    const unsigned msk = (unsigned)((bal0 >> (16 * tt)) & 0xffffull) | ((unsigned)((bal1 >> (16 * tt)) & 0xffffull) << 16);
    unsigned wany = 0;
#pragma unroll
    for (int x = 0; x < 4; ++x) wany |= (unsigned)((bal0 >> (16 * x)) & 0xffffull) | ((unsigned)((bal1 >> (16 * x)) & 0xffffull) << 16);
    if (lane == 0) WANY[wave] = wany;
#define ATT_PUT(buf) do { LAS bf16* Kn_ = TB + (buf) * 17920; LAS bf16* Vn_ = Kn_ + 9216; \
        *(LAS v4u*)(Kn_ + skey * 72 + 8 * spc) = kr[0]; *(LAS v4u*)(Kn_ + (64 + skey) * 72 + 8 * spc) = kr[1]; \
        *(LAS v4u*)(Vn_ + skey * 136 + 8 * spc) = vr[0]; *(LAS v4u*)(Vn_ + skey * 136 + 64 + 8 * spc) = vr[1]; } while (0)
    ATT_PUT(1);
    __syncthreads();
    unsigned uni = 0;
#pragma unroll
    for (int w = 0; w < 8; ++w) uni |= WANY[w];
    if (dry & 2) return;
    unsigned rem = uni & ~1u & ~(1u << curb); int gph = 0, gj = wlo;
    int cph = 0, cja = 0, cjb = (curb > 0) ? curb : -1, tb = 1;
    int nph, nja, njb;
#define ATT_NEXT() do { if (gph == 0 && rem == 0u) gph = 1; \
        if (gph == 0) { nph = 0; nja = __builtin_ctz(rem); rem &= rem - 1u; if (rem) { njb = __builtin_ctz(rem); rem &= rem - 1u; } else njb = -1; } \
        else if (gph == 1 && gj <= curb) { nph = 1; nja = gj++; if (gj <= curb) njb = gj++; else njb = -1; } \
        else { gph = 2; nph = 2; nja = 0; njb = -1; } } while (0)
    ATT_NEXT();
    float m_run = -1e4f; f32x4 o5 = (f32x4){0.f, 0.f, 0.f, 0.f}; f32x4 o[4];
#pragma unroll
    for (int dt = 0; dt < 4; ++dt) o[dt] = (f32x4){0.f, 0.f, 0.f, 0.f};
    while (cph != 2) {
        if (nph != 2) { const int kc = nph ? ZC_KW : ZC_KS; const bf16* vsrc = nph ? VTW : VTS;
            kr[0] = *(const v4u*)(kbase + (size_t)(64 * nja) * ZC + kc); vr[0] = *(const v4u*)(vsrc + vbase + 64 * nja);
            if (njb >= 0) { kr[1] = *(const v4u*)(kbase + (size_t)(64 * njb) * ZC + kc); vr[1] = *(const v4u*)(vsrc + vbase + 64 * njb); } else { kr[1] = zero4; vr[1] = zero4; } }
        const LAS bf16* Kb = TB + tb * 17920; const LAS bf16* Vb = Kb + 9216; const int ka = 64 * cja, kb2 = 64 * cjb;
        {
            const bool selA = (msk >> cja) & 1u, selB = (cjb >= 0) && ((msk >> cjb) & 1u);
            const bool doit = cph ? true : (((wany >> cja) & 1u) || ((cjb >= 0) && ((wany >> cjb) & 1u)));
            if (doit && !(dry & 1)) { const float rba = (cph || selA) ? 0.f : -1e30f, rbb = (cjb >= 0 && (cph || selB)) ? 0.f : -1e30f; const int tlo = cph ? t - 512 : -(1 << 30);
                attn_pair(Kb, Vb, qf, fr, q, m_run, o5, o, rba, rbb, (cja == curb) || (cph && cja <= wlo + 1), (cjb == curb) || (cph && cjb <= wlo + 1),
                          [=](int kk) { const int kp = ka + kk; return (kp <= t) && (kp > tlo); }, [=](int kk) { const int kp = kb2 + kk; return (kp <= t) && (kp > tlo); }); } }
        if (nph != 2) ATT_PUT(tb ^ 1);
        if (cph == 0 && nph != 0) {
            const float lt = __shfl(o5[0], fr); const float sc = g1 / lt;
#pragma unroll
            for (int dt = 0; dt < 4; ++dt) { facc[dt] = facc[dt] + o[dt] * sc; o[dt] = (f32x4){0.f, 0.f, 0.f, 0.f}; }
            m_run = -1e4f; o5 = (f32x4){0.f, 0.f, 0.f, 0.f}; }
        __syncthreads();
        cph = nph; cja = nja; cjb = njb; tb ^= 1; ATT_NEXT();
    }
#undef ATT_NEXT
#undef ATT_PUT
    { const float lt = __shfl(o5[0], fr); const float sc = g2 / lt;
#pragma unroll
        for (int dt = 0; dt < 4; ++dt) facc[dt] = facc[dt] + o[dt] * sc; }
    if (!dry) {
#pragma unroll
    for (int dt = 0; dt < 4; ++dt) { v2u w; w.x = pk2(facc[dt].x, facc[dt].y); w.y = pk2(facc[dt].z, facc[dt].w);
        *(v2u*)(MIX + grow * DM + 512 + 64 * hh + 16 * dt + 4 * q) = w; } }
}

#define XB_TMO      128
#define XB_XCNT(j)  (256  + 64 * (j))
#define XB_XSUB(j)  (1280 + 64 * (j))
#define XB_XGEN(j)  (2304 + 64 * (j))
#define XB_TOP      3328
#define XB_TOPGEN   3392
#define XCD_BAR_WORDS 3456
#define XB_SPIN_CAP (1u << 18)

__device__ __forceinline__ unsigned xb_ld(unsigned* p)              { return __hip_atomic_load(p, __ATOMIC_RELAXED, __HIP_MEMORY_SCOPE_AGENT); }
__device__ __forceinline__ unsigned xb_add(unsigned* p, unsigned v) { return __hip_atomic_fetch_add(p, v, __ATOMIC_RELAXED, __HIP_MEMORY_SCOPE_AGENT); }
__device__ __forceinline__ unsigned xb_xcc_id() { return (unsigned)__builtin_amdgcn_s_getreg((3 << 11) | 20) & 0xFu; }
#define XB_SPIN(cond, bar) do { unsigned _sp = 0; while (cond) { __builtin_amdgcn_s_sleep(1); \
    if ((++_sp & 255u) == 0u) { if (xb_ld(&(bar)[XB_TMO])) break; if (_sp > XB_SPIN_CAP) { atomicAdd(&(bar)[XB_TMO], 1u); break; } } } } while (0)

struct XcdBarrier {
    unsigned* bar; unsigned x;
    volatile LAS unsigned* st;
};

__device__ __forceinline__ XcdBarrier xcd_barrier_post(unsigned* bar, volatile LAS unsigned* st) {
    XcdBarrier b; b.bar = bar; b.x = xb_xcc_id(); b.st = st;
    if (threadIdx.x == 0) (void)xb_add(&bar[XB_XCNT(b.x)], 1u);
    return b;
}
__device__ __forceinline__ void xcd_barrier_complete(unsigned* bar, unsigned x, unsigned& nloc, unsigned& nx) {
    const unsigned G = gridDim.x * gridDim.y * gridDim.z;
    unsigned sum, cnt, mine, sp = 0u;
    for (;;) {
        sum = 0u; cnt = 0u; mine = 0u;
#pragma unroll
        for (unsigned j = 0; j < 16; ++j) { const unsigned c = xb_ld(&bar[XB_XCNT(j)]); sum += c; cnt += (c > 0u) ? 1u : 0u; mine = (j == x) ? c : mine; }
        if (sum == G) break;
        __builtin_amdgcn_s_sleep(1);
        if ((++sp & 255u) == 0u) { if (xb_ld(&bar[XB_TMO])) break; if (sp > XB_SPIN_CAP) { atomicAdd(&bar[XB_TMO], 1u); break; } }
    }
    nloc = mine > 0u ? mine : 1u; nx = cnt > 0u ? cnt : 1u;
}

__device__ __forceinline__ void xcd_barrier(const XcdBarrier& b) {
    asm volatile("s_waitcnt vmcnt(0)" ::: "memory");
    __syncthreads();
    if (threadIdx.x == 0) {
        unsigned* bar = b.bar;
        __builtin_amdgcn_s_waitcnt(0);
        unsigned nloc = b.st[0], nx = b.st[1];
        if (nloc == 0u) { xcd_barrier_complete(bar, b.x, nloc, nx); b.st[0] = nloc; b.st[1] = nx; }
        const unsigned old = xb_add(&bar[XB_XSUB(b.x)], 1u);
        const unsigned gen = old / nloc;
        if (old + 1u == (gen + 1u) * nloc) {
            __builtin_amdgcn_fence(__ATOMIC_RELEASE, "agent");
            asm volatile("s_waitcnt vmcnt(0)" ::: "memory");
            const unsigned og = xb_add(&bar[XB_TOP], 1u);
            const unsigned tg = og / nx;
            if (og + 1u == (tg + 1u) * nx) xb_add(&bar[XB_TOPGEN], 1u);
            else XB_SPIN(xb_ld(&bar[XB_TOPGEN]) == tg, bar);
            __builtin_amdgcn_fence(__ATOMIC_ACQUIRE, "agent");
            xb_add(&bar[XB_XGEN(b.x)], 1u);
            asm volatile("s_waitcnt vmcnt(0)" ::: "memory");
        } else {
            XB_SPIN(xb_ld(&bar[XB_XGEN(b.x)]) == gen, bar);
            __builtin_amdgcn_fence(__ATOMIC_ACQUIRE, "agent");
            asm volatile("s_waitcnt vmcnt(0)" ::: "memory");
        }
    }
    __syncthreads();
}

#ifndef POSTBAR_SLEEP
#define POSTBAR_SLEEP do {} while (0)
#endif
#ifndef MIXD_NEW
#define MIXD_NEW 1
#endif
#ifndef MIXB_LNNEW
#define MIXB_LNNEW 1
#endif
#ifndef ATDRY
#define ATDRY 0
#endif
#ifndef ITREP
#define ITREP 0
#endif
#ifndef REPMASK
#define REPMASK 0
#endif
#ifndef PHSEL
#define PHSEL 0xfff
#endif
constexpr int N_PHASES = 1 + 8 * DEPTH;
__global__ void __launch_bounds__(NTHREADS) hybrid_fwd(Args KA) {
    extern __shared__ __attribute__((aligned(16))) unsigned char lds_raw[];
    LAS unsigned char* lds = (LAS unsigned char*)lds_raw;
    cg::grid_group grid = cg::this_grid();
    volatile LAS unsigned* MISC = (volatile LAS unsigned*)(lds + LDS_BYTES - 64);
    if (threadIdx.x < 16) MISC[threadIdx.x] = 0u;
    __syncthreads();
    const XcdBarrier bar = xcd_barrier_post((unsigned*)(KA.ws + WS_CTL), MISC);
#define SEAM(first) do { if (first) { __threadfence(); asm volatile("s_waitcnt vmcnt(0)" ::: "memory"); grid.sync(); __builtin_amdgcn_fence(__ATOMIC_ACQUIRE, "agent"); asm volatile("s_waitcnt vmcnt(0)" ::: "memory"); __syncthreads(); } else { xcd_barrier(bar); POSTBAR_SLEEP; } } while (0)
#if REPMASK
    for (int ph2 = 2 * KA.ph_lo; ph2 < 2 * KA.ph_hi; ++ph2) {
        const int ph = ph2 >> 1;
        if (ph2 & 1) { const int stx = (ph == 0) ? 8 : ((ph - 1) & 7); if (!(((REPMASK & ~0x90) >> stx) & 1) && !((REPMASK >> 9) & 1)) continue; }
        if (ph2 > 2 * KA.ph_lo) SEAM(ph2 == 2 * KA.ph_lo + 2);
        if (ph2 & 1) { const int stx = (ph == 0) ? 8 : ((ph - 1) & 7); if (!(((REPMASK & ~0x90) >> stx) & 1)) continue; }
#else
    for (int ph = KA.ph_lo; ph < KA.ph_hi; ++ph) {
        if (ph > KA.ph_lo) SEAM(ph == KA.ph_lo + 1);
#endif
        ArgP A = (ArgP)__builtin_amdgcn_kernarg_segment_ptr(); asm volatile("" : "+s"(A));
        int tid = threadIdx.x; asm volatile("" : "+v"(tid));
        int G = gridDim.x, bid = blockIdx.x; asm volatile("" : "+s"(G), "+s"(bid));
        const int ngw = G * NWAVES;
        const int lane = tid & 63, wave = __builtin_amdgcn_readfirstlane(tid >> 6), gw = bid * NWAVES + wave;
        unsigned char* ws = A->ws;
        bf16* H = (bf16*)(ws + WS_H); bf16* Zb = (bf16*)(ws + WS_Z); bf16* MIX = (bf16*)(ws + WS_MIX); bf16* HID = (bf16*)(ws + WS_HID); bf16* Y = (bf16*)(ws + WS_Y); float* R2 = (float*)(ws + WS_R2);
        if (ph == 0) {
#if PHSEL & 1
            LAS float* scr = (LAS float*)(lds + wave * 16384);
            for (int it = gw; it < DEPTH * TI_LAYER; it += ngw) prologue_item(A, it, scr, lane);
            for (int idx = bid * NTHREADS + tid; idx < DEPTH * 65536; idx += G * NTHREADS) { const int l = idx >> 16, rem = idx & 65535, tq = (rem >> 7) & 127, sq = rem & 127;
                ((bf16*)(ws + WS_W + (size_t)l * WS_WL + WO_SG))[rem] = (sq <= tq) ? (bf16)f2bf(A->in[I_SGW][idx]) : (bf16)0; }
            norm_first(A->in[I_X], H, R2, bid, G, wave, lane);
#endif
            continue;
        }
        const int l = (ph - 1) >> 3, st = (ph - 1) & 7;
        unsigned char* wl = ws + WS_W + (size_t)l * WS_WL;
        if (st == 0) {
#if PHSEL & 2
            pg8::Gemm g{H, (const bf16*)(wl + WO_IN), MROWS, ZC, DM}; pg8::StaticOrder S; S.init(MROWS, ZC, G, bid);
            pg8::EpiBf16RS E{Zb, ZC, R2 + (size_t)(2 * l) * MROWS};
            pg8::gemm_phase<pg8::EpiBf16RS, pg8::StaticOrder, PG8_ALIGN, PG8_SP2>(lds, g, S, E);
#endif
        } else if (st == 1) {
#if PHSEL & 4
            for (int it0 = bid; it0 < 1536 + (ITREP ? 512 : 0); it0 += G) {
                int it = it0; int tid_i = tid; ArgP A_i = A; asm volatile("" : "+v"(tid_i), "+s"(A_i));
                const int lane_i = tid_i & 63, wave_i = __builtin_amdgcn_readfirstlane(tid_i >> 6);
                if (it0 >= 1536) { const int e = it0 - 1536; if (ITREP == 1) { if (e >= 256) continue; it = e; } else if (ITREP == 2) it = 256 + e; else if (ITREP == 4) it = 768 + e; else { if (e >= 256) continue; it = 1280 + e; } }
                if (it < 256) {
#if PHSEL & 256
                    mixer_a(A_i, l, it, lds, tid_i, wave_i, lane_i);
#endif
                } else if (it < 768) {
#if PHSEL & 512
                    mixer_b(A_i, l, it - 256, lds, tid_i, wave_i, lane_i);
#endif
                } else if (it < 1280) {
#if PHSEL & 1024
                    mixer_d(A_i, l, it - 768, lds, tid_i, wave_i, lane_i);
#endif
                } else {
#if PHSEL & 2048
                    nsa_compress(A_i, l, it - 1280, lds, tid_i, wave_i, lane_i);
#endif
                }
            }
#endif
        } else if (st == 2) {
#if PHSEL & 8
            for (int it0 = bid; it0 < 1024 + (ATDRY ? 1024 : 0); it0 += G) { const int it = it0 & 1023; const int dry_ = (it0 >= 1024) ? ATDRY : 0; int tid_i = tid; ArgP A_i = A; asm volatile("" : "+v"(tid_i), "+s"(A_i));
                nsa_attn(A_i, l, it, lds, tid_i, __builtin_amdgcn_readfirstlane(tid_i >> 6), tid_i & 63, dry_); }
#endif
        } else if (st == 3 || st == 6) {
#if PHSEL & 16
            pg8::Gemm g{st == 3 ? MIX : HID, (const bf16*)(wl + (st == 3 ? WO_OUT : WO_DN)), MROWS, DM, st == 3 ? DM : FFH}; pg8::StaticOrder S; S.init(MROWS, DM, G, bid);
            pg8::EpiBf16<0> E{Y, DM, nullptr, 0, 0, 1.f};
            pg8::gemm_phase<pg8::EpiBf16<0>, pg8::StaticOrder, PG8_ALIGN, PG8_SP2>(lds, g, S, E);
#endif
        } else if (st == 4) {
#if PHSEL & 32
#if (REPMASK >> 4) & 1
            norm_bf<false>(H, HID, Y, A->in[I_GQM] + l * DM, (float*)(ws + WS_MIX), nullptr, bid, G, wave, lane);
#endif
            norm_bf<false>(H, H, Y, A->in[I_GQM] + l * DM, R2 + (size_t)(2 * l + 1) * MROWS, nullptr, bid, G, wave, lane);
#endif
        } else if (st == 5) {
#if PHSEL & 64
            pg8::Gemm g{H, (const bf16*)(wl + WO_GU), MROWS, 2 * FFH, DM}; pg8::StaticOrder S; S.init(MROWS, 2 * FFH, G, bid);
            pg8::EpiSwiGLU E{HID, FFH, R2 + (size_t)(2 * l + 1) * MROWS};
            pg8::gemm_phase<pg8::EpiSwiGLU, pg8::StaticOrder, PG8_ALIGN, PG8_SP2>(lds, g, S, E);
#endif
        } else {
#if PHSEL & 128
            const bool last = (l == DEPTH - 1);
#if (REPMASK >> 7) & 1
            norm_bf<false>(H, HID, Y, A->in[I_GQF] + l * DM, (float*)(ws + WS_MIX), nullptr, bid, G, wave, lane);
#endif
            if (last) norm_bf<true>(H, H, Y, A->in[I_GQF] + l * DM, nullptr, A->out, bid, G, wave, lane);
            else norm_bf<false>(H, H, Y, A->in[I_GQF] + l * DM, R2 + (size_t)(2 * l + 2) * MROWS, nullptr, bid, G, wave, lane);
#endif
        }
    }
}

#ifndef MK_MULTI
#define MK_MULTI 0
#endif
extern "C" void kernel_launch(void* const* d_in, const int* in_sizes, int n_in, void* d_out, int out_size, void* d_ws, size_t ws_size, hipStream_t stream) {
    static int grid = 0;
    if (grid == 0) {
        if (n_in != 26 || out_size != MROWS * DM || ws_size < WS_END) { fprintf(stderr, "kernel_launch: unexpected shapes (n_in %d out %d ws %zu)\n", n_in, out_size, ws_size); grid = -1; return; }
        int dev = 0, cus = 0, per_cu = 0;
        hipGetDevice(&dev); hipDeviceGetAttribute(&cus, hipDeviceAttributeMultiprocessorCount, dev);
        hipFuncSetAttribute((const void*)hybrid_fwd, hipFuncAttributeMaxDynamicSharedMemorySize, LDS_BYTES);
        hipOccupancyMaxActiveBlocksPerMultiprocessor(&per_cu, (const void*)hybrid_fwd, NTHREADS, LDS_BYTES);
        if (per_cu < 1) per_cu = 1;
        grid = cus * per_cu;
        (void)hipGetLastError();
    }
    if (grid < 0) return;
    Args a{};
    for (int i = 0; i < 26; ++i) a.in[i] = (const float*)d_in[i];
    a.out = (float*)d_out; a.ws = (unsigned char*)d_ws;
    if (hipMemsetAsync((char*)d_ws + WS_CTL, 0, CTL_BYTES, stream) != hipSuccess) { fprintf(stderr, "kernel_launch: memset of the barrier words failed\n"); return; }
#if MK_MULTI
    for (int ph = 0; ph < N_PHASES; ++ph) { a.ph_lo = ph; a.ph_hi = ph + 1; hipLaunchKernelGGL(hybrid_fwd, dim3(grid), dim3(NTHREADS), LDS_BYTES, stream, a); }
#else
    a.ph_lo = 0; a.ph_hi = N_PHASES;
    void* args[] = {&a};
    hipError_t e = hipLaunchCooperativeKernel((const void*)hybrid_fwd, dim3(grid), dim3(NTHREADS), args, LDS_BYTES, stream);
    if (e != hipSuccess) fprintf(stderr, "cooperative launch failed: %s (grid %d)\n", hipGetErrorString(e), grid);
#endif
}
```

```cpp
#include <hip/hip_runtime.h>
#include <hip/hip_cooperative_groups.h>
#include <cstdio>
#include <cstdint>
namespace cg = cooperative_groups;
namespace pg8 {
#define PG8_LAS __attribute__((address_space(3)))
typedef unsigned short bf16_t;
typedef short bf16x8 __attribute__((ext_vector_type(8)));
typedef float f32x4 __attribute__((ext_vector_type(4)));
typedef unsigned u32x4 __attribute__((ext_vector_type(4)));
constexpr int BM = 256, BK = 64, HALF = 128, HTB = HALF * BK * 2  , STAGE_BYTES = 8 * HTB, NXCD = 8, WGM = 8;

__host__ __device__ __forceinline__ int lds_byte(int r, int c) { const int st = (r >> 4) * 2 + (c >> 5), rr = r & 15, cc = c & 31, ob = rr * 64 + cc * 2; return st * 1024 + (ob ^ (((ob >> 9) & 1) << 5)); }
__host__ __device__ __forceinline__ void stage_rc(int b, int& R, int& C) { const int st = b / 1024, sb = b % 1024, swz = sb ^ (((sb >> 9) & 1) << 5); R = (st >> 1) * 16 + swz / 64; C = (st & 1) * 32 + (swz % 64) / 2; }
__host__ __device__ __forceinline__ int perm32(int rho) { const int n = rho >> 4, i = rho & 15; return 8 * (i >> 2) + 4 * n + (i & 3); }

struct Unit { int pm, pn; };
struct Gemm { const bf16_t* A; const bf16_t* Bt; int M, N, K; };

struct StaticOrder {
    int nM, nN, nwg, G, c;
    __host__ __device__ void init(int M, int N, int G_, int c_) { nM = M / BM; nN = N / BM; nwg = nM * nN; G = G_; c = c_; }
    __host__ __device__ bool next(int i, Unit& u) const {
        const long L = (long)i * G + c; if (L >= nwg) return false;
        int wgid = (int)L; { const int q = nwg / NXCD, r = nwg % NXCD, xcd = wgid % NXCD, off = wgid / NXCD; wgid = (xcd < r ? xcd * (q + 1) : r * (q + 1) + (xcd - r) * q) + off; }
        const int nig = WGM * nN, gid = wgid / nig, fm = gid * WGM, gsz = (nM - fm) < WGM ? (nM - fm) : WGM;
        u.pm = fm + ((wgid % nig) % gsz); u.pn = (wgid % nig) / gsz; return true;
    }
    __device__ __forceinline__ void a_ready(const Unit&) const {}
    __device__ __forceinline__ void done(const Unit&) const {}
};

__device__ __forceinline__ unsigned cvt_pk_bf16(float lo, float hi) { unsigned r; asm volatile("v_cvt_pk_bf16_f32 %0, %1, %2" : "=v"(r) : "v"(lo), "v"(hi)); return r; }
typedef float f32x2 __attribute__((ext_vector_type(2)));
__device__ __forceinline__ f32x2 gelu_pk(f32x2 v) {
    const f32x2 av = __builtin_elementwise_abs(v), d = av * 0.2316418882f + 1.0f;
    f32x2 t; t.x = __builtin_amdgcn_rcpf(d.x); t.y = __builtin_amdgcn_rcpf(d.y);
    f32x2 q = t * 0.5307027145f + (-0.7265760135f); q = q * t + 0.7107068705f; q = q * t + (-0.142248368f); q = q * t + 0.127414796f; q = q * t;
    const f32x2 s = (v * v) * (-0.72134752044f);
    f32x2 e; e.x = __builtin_amdgcn_exp2f(s.x); e.y = __builtin_amdgcn_exp2f(s.y);
    const f32x2 m = v * (q * e), r = v - m;
    f32x2 o; o.x = v.x < 0.f ? m.x : r.x; o.y = v.y < 0.f ? m.y : r.y; return o;
}

template <int ACT  > struct EpiBf16 {
    static constexpr bool PERM = true, AFTER_DRAIN = false; static_assert(ACT == 0 || ACT == 1, "EpiBf16: ACT is 0 (none) or 1 (gelu_pk)");
    bf16_t* O; int ldc; const float* bias; int split_cols; size_t split_stride; float scale0;
    __device__ __forceinline__ void operator()(const f32x4 (&acc)[2][2][4][2], const Unit& u, int wr, int wc, int fr, int fq) const {
        const int row0 = u.pm * BM + wr * 64 + fr; int colt = u.pn * BM; bf16_t* base = O;
        float sc = 1.f; if (split_cols) { const int t = colt / split_cols; base += (size_t)t * split_stride; colt -= t * split_cols; if (t == 0) sc = scale0; }
        const int col0 = colt + wc * 32 + 8 * fq, bcol0 = u.pn * BM + wc * 32 + 8 * fq;
        f32x4 bv[2][2];
#pragma unroll
        for (int bj = 0; bj < 2; ++bj)
#pragma unroll
            for (int n = 0; n < 2; ++n) bv[bj][n] = bias ? *(const f32x4*)(bias + bcol0 + bj * HALF + 4 * n) : (f32x4){0.f, 0.f, 0.f, 0.f};
#pragma unroll
        for (int ai = 0; ai < 2; ++ai)
#pragma unroll
            for (int m = 0; m < 4; ++m) { bf16_t* rowp = base + (size_t)(row0 + ai * HALF + m * 16) * ldc + col0;
#pragma unroll
                for (int bj = 0; bj < 2; ++bj) { f32x4 v0 = acc[ai][bj][m][0] + bv[bj][0], v1 = acc[ai][bj][m][1] + bv[bj][1];
                    if (ACT == 1) { f32x2 a = gelu_pk((f32x2){v0[0], v0[1]}), b = gelu_pk((f32x2){v0[2], v0[3]}), c = gelu_pk((f32x2){v1[0], v1[1]}), d = gelu_pk((f32x2){v1[2], v1[3]});
                        v0 = (f32x4){a.x, a.y, b.x, b.y}; v1 = (f32x4){c.x, c.y, d.x, d.y}; }
                    v0 = v0 * sc; v1 = v1 * sc; u32x4 w; w.x = cvt_pk_bf16(v0[0], v0[1]); w.y = cvt_pk_bf16(v0[2], v0[3]); w.z = cvt_pk_bf16(v1[0], v1[1]); w.w = cvt_pk_bf16(v1[2], v1[3]);
                    *(u32x4*)(rowp + bj * HALF) = w; } }
    }
};
struct EpiF32 {
    static constexpr bool PERM = false, AFTER_DRAIN = false;
    float* O; int ldc;
    __device__ __forceinline__ void operator()(const f32x4 (&acc)[2][2][4][2], const Unit& u, int wr, int wc, int fr, int fq) const {
        const int row0 = u.pm * BM + wr * 64 + fr, col0 = u.pn * BM + wc * 32 + 4 * fq;
#pragma unroll
        for (int ai = 0; ai < 2; ++ai)
#pragma unroll
            for (int m = 0; m < 4; ++m) { float* rowp = O + (size_t)(row0 + ai * HALF + m * 16) * ldc + col0;
#pragma unroll
                for (int bj = 0; bj < 2; ++bj)
#pragma unroll
                    for (int n = 0; n < 2; ++n) *(f32x4*)(rowp + bj * HALF + n * 16) = acc[ai][bj][m][n]; }
    }
};
struct EpiSwiGLU {
    static constexpr bool PERM = true, AFTER_DRAIN = false;
    bf16_t* O; int ldc; const float* rs;
    __device__ __forceinline__ void operator()(const f32x4 (&acc)[2][2][4][2], const Unit& u, int wr, int wc, int fr, int fq) const {
        const int row0 = u.pm * BM + wr * 64 + fr, col0 = u.pn * HALF + wc * 32 + 8 * fq;
#pragma unroll
        for (int ai = 0; ai < 2; ++ai)
#pragma unroll
            for (int m = 0; m < 4; ++m) { bf16_t* rowp = O + (size_t)(row0 + ai * HALF + m * 16) * ldc + col0;
                const float r = rs[row0 + ai * HALF + m * 16];
                float h[8];
#pragma unroll
                for (int n = 0; n < 2; ++n)
#pragma unroll
                    for (int e = 0; e < 4; ++e) { const float g = acc[ai][0][m][n][e] * r, up = acc[ai][1][m][n][e] * r;
                        h[n * 4 + e] = g * __builtin_amdgcn_rcpf(1.0f + __builtin_amdgcn_exp2f(-1.4426950408889634f * g)) * up; }
                u32x4 w; w.x = cvt_pk_bf16(h[0], h[1]); w.y = cvt_pk_bf16(h[2], h[3]); w.z = cvt_pk_bf16(h[4], h[5]); w.w = cvt_pk_bf16(h[6], h[7]);
                *(u32x4*)rowp = w; }
    }
};
struct EpiBf16RS {
    static constexpr bool PERM = true, AFTER_DRAIN = false;
    bf16_t* O; int ldc; const float* rs;
    __device__ __forceinline__ void operator()(const f32x4 (&acc)[2][2][4][2], const Unit& u, int wr, int wc, int fr, int fq) const {
        const int row0 = u.pm * BM + wr * 64 + fr, col0 = u.pn * BM + wc * 32 + 8 * fq;
#pragma unroll
        for (int ai = 0; ai < 2; ++ai)
#pragma unroll
            for (int m = 0; m < 4; ++m) { bf16_t* rowp = O + (size_t)(row0 + ai * HALF + m * 16) * ldc + col0; const float r = rs[row0 + ai * HALF + m * 16];
#pragma unroll
                for (int bj = 0; bj < 2; ++bj) { const f32x4 v0 = acc[ai][bj][m][0] * r, v1 = acc[ai][bj][m][1] * r;
                    u32x4 w; w.x = cvt_pk_bf16(v0[0], v0[1]); w.y = cvt_pk_bf16(v0[2], v0[3]); w.z = cvt_pk_bf16(v1[0], v1[1]); w.w = cvt_pk_bf16(v1[2], v1[3]);
                    *(u32x4*)(rowp + bj * HALF) = w; } }
    }
};
template <class Epi, class Sched, bool ALIGN_EPI = false, bool SP2 = false>
__device__ __forceinline__ void gemm_phase(PG8_LAS unsigned char* lds, const Gemm g, const Sched& S, const Epi& E) {
    const int tid = threadIdx.x, wid = __builtin_amdgcn_readfirstlane(tid >> 6), lane = tid & 63, wr = wid >> 2, wc = wid & 3, fr = lane & 15, fq = lane >> 4;
    const int K = g.K, nt = K / BK;
    unsigned voffA[2], voffB[2];
#pragma unroll
    for (int i = 0; i < 2; ++i) { int R, C; stage_rc(tid * 16 + i * 8192, R, C); const int Rb = Epi::PERM ? ((R & ~31) + perm32(R & 31)) : R;
        voffA[i] = (unsigned)(R * K + C) * 2u; voffB[i] = (unsigned)(Rb * K + C) * 2u; }
    const size_t kstep = (size_t)(BK * 2);
    const size_t hstep = (size_t)HALF * K * 2;
    const size_t tstep = 2 * hstep;
    const unsigned ldsw = (unsigned)wid * 1024u;
    const int aoff = lds_byte(wr * 64 + fr, fq * 8), boff = lds_byte(wc * 32 + fr, fq * 8);
#define PG8_SA(b, h) (((b) * 2 + (h)) * HTB)
#define PG8_SB(b, h) ((4 + (b) * 2 + (h)) * HTB)
#define PG8_STAGE(bufoff, gbase, voff) do { _Pragma("unroll") for (int _i = 0; _i < 2; ++_i) \
        __builtin_amdgcn_global_load_lds((const unsigned*)((const char*)(gbase) + (voff)[_i]), (PG8_LAS unsigned*)(lds + (bufoff) + ldsw + _i * 8192), 16, 0, 0); } while (0)
#define PG8_LDA(dst, b, h) do { _Pragma("unroll") for (int m = 0; m < 4; ++m) _Pragma("unroll") for (int k = 0; k < 2; ++k) dst[m][k] = *(const PG8_LAS bf16x8*)(lds + PG8_SA(b, h) + aoff + m * 2048 + k * 1024); } while (0)
#define PG8_LDB(dst, b, h) do { _Pragma("unroll") for (int n = 0; n < 2; ++n) _Pragma("unroll") for (int k = 0; k < 2; ++k) dst[n][k] = *(const PG8_LAS bf16x8*)(lds + PG8_SB(b, h) + boff + n * 2048 + k * 1024); } while (0)
#define PG8_MMA(ai, bj, At, Bt) do { __builtin_amdgcn_s_setprio(1); _Pragma("unroll") for (int m = 0; m < 4; ++m) _Pragma("unroll") for (int n = 0; n < 2; ++n) _Pragma("unroll") for (int k = 0; k < 2; ++k) \
        acc[ai][bj][m][n] = __builtin_amdgcn_mfma_f32_16x16x32_bf16(Bt[n][k], At[m][k], acc[ai][bj][m][n], 0, 0, 0); __builtin_amdgcn_s_setprio(0); } while (0)
#define PG8_WAIT_V(n) asm volatile("s_waitcnt vmcnt(" #n ")" ::: "memory")
#define PG8_WAIT_L(n) asm volatile("s_waitcnt lgkmcnt(" #n ")" ::: "memory")
#define PG8_BAR __builtin_amdgcn_s_barrier()
#define PG8_SCHED __builtin_amdgcn_sched_barrier(0)
    Unit cur, nxt; int ui = 0;
    if (!S.next(0, cur)) return;
    f32x4 acc[2][2][4][2];
#pragma unroll
    for (int a = 0; a < 2; ++a)
#pragma unroll
        for (int b = 0; b < 2; ++b)
#pragma unroll
            for (int m = 0; m < 4; ++m)
#pragma unroll
                for (int n = 0; n < 2; ++n) acc[a][b][m][n] = (f32x4){0.f, 0.f, 0.f, 0.f};
    bf16x8 At[4][2], B0[2][2], B1[2][2];
    const char* cA = (const char*)g.A + (size_t)cur.pm * tstep; const char* cB = (const char*)g.Bt + (size_t)cur.pn * tstep;
    S.a_ready(cur);
    if constexpr (SP2) {
        PG8_STAGE(PG8_SB(0, 0), cB, voffB); PG8_STAGE(PG8_SB(0, 1), cB + hstep, voffB); PG8_STAGE(PG8_SA(0, 0), cA, voffA); PG8_STAGE(PG8_SA(0, 1), cA + hstep, voffA);
        if (wr == 1) PG8_BAR;
        PG8_WAIT_V(2); PG8_BAR;
        PG8_STAGE(PG8_SB(1, 0), cB + kstep, voffB); PG8_STAGE(PG8_SA(1, 0), cA + kstep, voffA); PG8_STAGE(PG8_SB(1, 1), cB + hstep + kstep, voffB);
        PG8_WAIT_V(6); PG8_BAR;
    } else {
        PG8_STAGE(PG8_SB(0, 0), cB, voffB); PG8_STAGE(PG8_SA(0, 0), cA, voffA); PG8_STAGE(PG8_SB(0, 1), cB + hstep, voffB); PG8_STAGE(PG8_SA(0, 1), cA + hstep, voffA);
        if (wr == 1) PG8_BAR;
        PG8_WAIT_V(4); PG8_BAR;
        PG8_STAGE(PG8_SB(1, 0), cB + kstep, voffB); PG8_STAGE(PG8_SA(1, 0), cA + kstep, voffA); PG8_STAGE(PG8_SB(1, 1), cB + hstep + kstep, voffB);
        PG8_WAIT_V(6); PG8_BAR;
    }
    for (;;) {
        const bool has_next = S.next(ui + 1, nxt);
        const char* nA = has_next ? (const char*)g.A + (size_t)nxt.pm * tstep : cA; const char* nB = has_next ? (const char*)g.Bt + (size_t)nxt.pn * tstep : cB;
        for (int t = 0; t < nt; t += 2) {
            const bool last = (t == nt - 2);
            const char* a1 = cA + (size_t)(t + 1) * kstep;
            const char* a2 = last ? nA : cA + (size_t)(t + 2) * kstep; const char* b2 = last ? nB : cB + (size_t)(t + 2) * kstep;
            const char* a3 = a2 + kstep; const char* b3 = b2 + kstep;
            if (last && has_next) S.a_ready(nxt);
            if constexpr (SP2) {
            PG8_LDB(B0, 0, 0); PG8_LDB(B1, 0, 1); PG8_SCHED; PG8_LDA(At, 0, 0); PG8_STAGE(PG8_SA(1, 1), a1 + hstep, voffA);
            PG8_WAIT_V(8); PG8_WAIT_L(0); PG8_BAR; PG8_MMA(0, 0, At, B0); PG8_MMA(0, 1, At, B1); PG8_BAR; PG8_SCHED;
            PG8_LDA(At, 0, 1); PG8_STAGE(PG8_SB(0, 0), b2, voffB); PG8_STAGE(PG8_SB(0, 1), b2 + hstep, voffB); PG8_STAGE(PG8_SA(0, 0), a2, voffA);
            PG8_WAIT_V(8); PG8_WAIT_L(0); PG8_BAR; PG8_MMA(1, 0, At, B0); PG8_MMA(1, 1, At, B1); PG8_BAR; PG8_SCHED;
            PG8_LDB(B0, 1, 0); PG8_LDB(B1, 1, 1); PG8_SCHED; PG8_LDA(At, 1, 0); PG8_STAGE(PG8_SA(0, 1), a2 + hstep, voffA);
            PG8_WAIT_V(8); PG8_WAIT_L(0); PG8_BAR; PG8_MMA(0, 0, At, B0); PG8_MMA(0, 1, At, B1); PG8_BAR; PG8_SCHED;
            PG8_LDA(At, 1, 1); PG8_STAGE(PG8_SB(1, 0), b3, voffB); PG8_STAGE(PG8_SB(1, 1), b3 + hstep, voffB); PG8_STAGE(PG8_SA(1, 0), a3, voffA);
            PG8_WAIT_V(8); PG8_WAIT_L(0); PG8_BAR; PG8_MMA(1, 0, At, B0); PG8_MMA(1, 1, At, B1); PG8_BAR; PG8_SCHED;
            } else {
            PG8_LDB(B0, 0, 0); PG8_SCHED; PG8_LDA(At, 0, 0); PG8_STAGE(PG8_SA(1, 1), a1 + hstep, voffA);
            PG8_WAIT_L(8); PG8_BAR; PG8_WAIT_L(0); PG8_MMA(0, 0, At, B0); PG8_BAR; PG8_SCHED;
            PG8_LDB(B1, 0, 1); PG8_STAGE(PG8_SB(0, 0), b2, voffB);
            PG8_BAR; PG8_WAIT_L(0); PG8_MMA(0, 1, At, B1); PG8_BAR;
            PG8_LDA(At, 0, 1); PG8_STAGE(PG8_SA(0, 0), a2, voffA);
            PG8_BAR; PG8_WAIT_L(0); PG8_MMA(1, 0, At, B0); PG8_BAR; PG8_SCHED;
            PG8_STAGE(PG8_SB(0, 1), b2 + hstep, voffB);
            PG8_WAIT_V(6); PG8_BAR; PG8_MMA(1, 1, At, B1); PG8_BAR;
            PG8_LDB(B0, 1, 0); PG8_SCHED; PG8_LDA(At, 1, 0); PG8_STAGE(PG8_SA(0, 1), a2 + hstep, voffA);
            PG8_WAIT_L(8); PG8_BAR; PG8_WAIT_L(0); PG8_MMA(0, 0, At, B0); PG8_BAR; PG8_SCHED;
            PG8_LDB(B1, 1, 1); PG8_STAGE(PG8_SB(1, 0), b3, voffB);
            PG8_BAR; PG8_WAIT_L(0); PG8_MMA(0, 1, At, B1); PG8_BAR;
            PG8_LDA(At, 1, 1); PG8_STAGE(PG8_SA(1, 0), a3, voffA);
            PG8_BAR; PG8_WAIT_L(0); PG8_MMA(1, 0, At, B0); PG8_BAR; PG8_SCHED;
            PG8_STAGE(PG8_SB(1, 1), b3 + hstep, voffB);
            PG8_WAIT_V(6); PG8_BAR; PG8_MMA(1, 1, At, B1); PG8_BAR;
            }
        }
        if constexpr (ALIGN_EPI) { if (wr == 0) PG8_BAR; }
        if constexpr (!Epi::AFTER_DRAIN) { E(acc, cur, wr, wc, fr, fq); S.done(cur); }
        if (!has_next) break;
#pragma unroll
        for (int a = 0; a < 2; ++a)
#pragma unroll
            for (int b = 0; b < 2; ++b)
#pragma unroll
                for (int m = 0; m < 4; ++m)
#pragma unroll
                    for (int n = 0; n < 2; ++n) acc[a][b][m][n] = (f32x4){0.f, 0.f, 0.f, 0.f};
        cur = nxt; cA = nA; cB = nB; ++ui;
        if constexpr (ALIGN_EPI) { if (wr == 1) PG8_BAR; }
    }
    PG8_WAIT_V(0);
    if constexpr (!ALIGN_EPI) { if (wr == 0) PG8_BAR; }
    PG8_BAR;
    if constexpr (Epi::AFTER_DRAIN) { E.fused(acc, cur, wr, wc, fr, fq, lds, wid, lane); S.done(cur); }
#undef PG8_SA
#undef PG8_SB
#undef PG8_STAGE
#undef PG8_LDA
#undef PG8_LDB
#undef PG8_MMA
#undef PG8_WAIT_V
#undef PG8_WAIT_L
#undef PG8_BAR
#undef PG8_SCHED
}
}

#ifndef PG8_SP2
#define PG8_SP2 true
#endif
#ifndef PG8_ALIGN
#define PG8_ALIGN true
#endif

#define LAS __attribute__((address_space(3)))
typedef unsigned short bf16;
typedef unsigned v4u __attribute__((ext_vector_type(4)));
typedef unsigned v2u __attribute__((ext_vector_type(2)));
typedef float f32x4 __attribute__((ext_vector_type(4)));
typedef short bf16x8 __attribute__((ext_vector_type(8)));

constexpr int DM = 1024, NBATCH = 16, SEQ = 2048, DEPTH = 4, MROWS = NBATCH * SEQ, INC = 1932, ZC = 2048, FFH = 2816;
constexpr int NTHREADS = 512, NWAVES = 8;
constexpr int LDS_BYTES = 147456;
constexpr int ZC_AU = 0, ZC_AV = 256, ZC_BA = 512, ZC_BG = 768, ZC_Q = 1024, ZC_KC = 1280, ZC_VC = 1344, ZC_KS = 1408, ZC_VS = 1472, ZC_KW = 1536, ZC_VW = 1600, ZC_D = 1664, ZC_G = 1920;
constexpr size_t MiB = 1u << 20;
constexpr size_t WS_CTL = 0, CTL_BYTES = 16384;
constexpr size_t WS_W = 1 * MiB, WS_WL = 24 * MiB;
constexpr size_t WO_IN = 0, WO_OUT = 4 * MiB, WO_GU = 6 * MiB, WO_DN = 17 * MiB, WO_SG = 23 * MiB - 512 * 1024, WO_PW = WO_SG + 131072, WO_POOL = WO_PW + 131072, WO_W1K = WO_POOL + 32768, WO_W1V = WO_W1K + 262144;
static_assert(WO_DN + (size_t)1024 * 2816 * 2 <= WO_SG && WO_W1V + 262144 <= WS_WL, "weight map");
constexpr size_t WS_H = 98 * MiB, WS_Z = 162 * MiB, WS_MIX = 290 * MiB, WS_HID = 162 * MiB, WS_Y = 354 * MiB;
constexpr size_t WS_VTS = 482 * MiB, WS_VTW = 486 * MiB, WS_KC = 490 * MiB, WS_VCT = 490 * MiB + 262144, WS_R2 = 491 * MiB, WS_END = 493 * MiB;
static_assert(WS_HID + (size_t)MROWS * FFH * 2 <= WS_Y, "hid overlay");

#define LDS_WAIT() asm volatile("s_waitcnt lgkmcnt(0)" ::: "memory")
__device__ __forceinline__ float bflo(unsigned w) { return __uint_as_float(w << 16); }
__device__ __forceinline__ float bfhi(unsigned w) { return __uint_as_float(w & 0xffff0000u); }
__device__ __forceinline__ float bf2f(bf16 v) { return __uint_as_float((unsigned)v << 16); }
__device__ __forceinline__ unsigned f2bf(float f) { unsigned u = __float_as_uint(f); return (u + 0x7fffu + ((u >> 16) & 1u)) >> 16; }
__device__ __forceinline__ unsigned pk2(float lo, float hi) { unsigned r; asm("v_cvt_pk_bf16_f32 %0, %1, %2" : "=v"(r) : "v"(lo), "v"(hi)); return r; }
__device__ __forceinline__ float sigmoidf_(float x) { return __builtin_amdgcn_rcpf(1.0f + __builtin_amdgcn_exp2f(-1.4426950408889634f * x)); }
__device__ __forceinline__ float siluf_(float x) { return x * sigmoidf_(x); }
__device__ __forceinline__ float wave_sum(float v) {
#pragma unroll
    for (int o = 1; o < 64; o <<= 1) v += __shfl_xor(v, o);
    return v;
}
__device__ __forceinline__ f32x4 mfma16(v4u a, v4u b, f32x4 c) {
    return __builtin_amdgcn_mfma_f32_16x16x32_bf16(__builtin_bit_cast(bf16x8, a), __builtin_bit_cast(bf16x8, b), c, 0, 0, 0);
}

struct Args { const float* in[26]; float* out; unsigned char* ws; int ph_lo, ph_hi; };
typedef const __attribute__((address_space(4))) Args* ArgP;
enum { I_X = 0, I_GPM, I_GQM, I_GPF, I_GQF, I_WIN, I_SGLN, I_SGW, I_SGB, I_CVW, I_CVB, I_CVLG, I_CVLB, I_CVPW, I_CVPB, I_POSK, I_POSV, I_W1K, I_W2K, I_W1V, I_W2V, I_POOLW, I_POOLS, I_WOUT, I_GU, I_DN };

__device__ __forceinline__ void tr_item(const float* __restrict__ src, int Nsrc, int K, bf16* dst, int k0, int n0d, int nsrc0, int nvalid, LAS float* scr, int lane, const float* gk = nullptr) {
    const int kk8 = lane >> 3, n4 = (lane & 7) * 4; const bool ok = n4 < nvalid;
#pragma unroll
    for (int i = 0; i < 8; ++i) { const int kk = 8 * i + kk8; f32x4 v = (f32x4){0.f, 0.f, 0.f, 0.f};
        if (ok) { v = *(const f32x4*)(src + (size_t)(k0 + kk) * Nsrc + nsrc0 + n4); if (gk) v = v * gk[k0 + kk]; }
        LAS float* sp = scr + kk * 33 + n4; sp[0] = v.x; sp[1] = v.y; sp[2] = v.z; sp[3] = v.w; }
    LDS_WAIT();
    const int c = lane & 7;
#pragma unroll
    for (int j = 0; j < 4; ++j) { const int n = (lane >> 3) + 8 * j; const LAS float* s = scr + (8 * c) * 33 + n;
        v4u o; o.x = pk2(s[0 * 33], s[1 * 33]); o.y = pk2(s[2 * 33], s[3 * 33]); o.z = pk2(s[4 * 33], s[5 * 33]); o.w = pk2(s[6 * 33], s[7 * 33]);
        *(v4u*)(dst + (size_t)(n0d + n) * K + k0 + 8 * c) = o; }
    LDS_WAIT();
}
constexpr int TI_IN = 1024, TI_OUT = 512, TI_GU = 2816, TI_DN = 1408, TI_PW = 32, TI_POOL = 8, TI_W1 = 64;
constexpr int TI_LAYER = TI_IN + TI_OUT + TI_GU + TI_DN + TI_PW + TI_POOL + 2 * TI_W1;

__device__ __forceinline__ void prologue_item(ArgP A, int it, LAS float* scr, int lane) {
    const int l = it / TI_LAYER; int r = it % TI_LAYER;
    unsigned char* wl = A->ws + WS_W + (size_t)l * WS_WL;
    if (r < TI_IN) { const int kb = r >> 6, nb = r & 63, n0d = 32 * nb; int ns = n0d, nv = 32;
        if (n0d >= ZC_D && n0d < ZC_G) ns = n0d + 12; else if (n0d == ZC_G) { ns = 1664; nv = 12; } else if (n0d > ZC_G) { ns = 0; nv = 0; }
        tr_item(A->in[I_WIN] + (size_t)l * DM * INC, INC, DM, (bf16*)(wl + WO_IN), 64 * kb, n0d, ns, nv, scr, lane, A->in[I_GPM] + l * DM); return; }
    r -= TI_IN;
    if (r < TI_OUT) { const int kb = r >> 5, nb = r & 31;
        tr_item(A->in[I_WOUT] + (size_t)l * DM * DM, DM, DM, (bf16*)(wl + WO_OUT), 64 * kb, 32 * nb, 32 * nb, 32, scr, lane); return; }
    r -= TI_OUT;
    if (r < TI_GU) { const int kb = r / 176, nb = r % 176, n0d = 32 * nb, pn = n0d >> 8, bj = (n0d >> 7) & 1, i0 = n0d & 127;
        tr_item(A->in[I_GU] + (size_t)l * DM * 2 * FFH, 2 * FFH, DM, (bf16*)(wl + WO_GU), 64 * kb, n0d, bj * FFH + 128 * pn + i0, 32, scr, lane, A->in[I_GPF] + l * DM); return; }
    r -= TI_GU;
    if (r < TI_DN) { const int kb = r >> 5, nb = r & 31;
        tr_item(A->in[I_DN] + (size_t)l * FFH * DM, DM, FFH, (bf16*)(wl + WO_DN), 64 * kb, 32 * nb, 32 * nb, 32, scr, lane); return; }
    r -= TI_DN;
    if (r < TI_PW) { const int kb = r >> 3, nb = r & 7;
        tr_item(A->in[I_CVPW] + (size_t)l * 65536, 256, 256, (bf16*)(wl + WO_PW), 64 * kb, 32 * nb, 32 * nb, 32, scr, lane); return; }
    r -= TI_PW;
    if (r < TI_POOL) { const int g = r >> 1, nb = r & 1;
        tr_item(A->in[I_POOLW] + (size_t)l * 16384 + g * 4096, 64, 64, (bf16*)(wl + WO_POOL) + g * 4096, 0, 32 * nb, 32 * nb, 32, scr, lane); return; }
    r -= TI_POOL;
    if (r < TI_W1) { const int kb = r >> 1, nb = r & 1;
        tr_item(A->in[I_W1K] + (size_t)l * 131072, 64, 2048, (bf16*)(wl + WO_W1K), 64 * kb, 32 * nb, 32 * nb, 32, scr, lane); return; }
    r -= TI_W1;
    { const int kb = r >> 1, nb = r & 1;
        tr_item(A->in[I_W1V] + (size_t)l * 131072, 64, 2048, (bf16*)(wl + WO_W1V), 64 * kb, 32 * nb, 32 * nb, 32, scr, lane); }
}

struct NRow { f32x4 x[4], y[4]; };
template <bool HASY>
__device__ __forceinline__ void nr_load(NRow& r, const float* xin, const float* y, int m, int lane) {
    const f32x4* xr = (const f32x4*)(xin + (size_t)m * DM) + lane;
#pragma unroll
    for (int j = 0; j < 4; ++j) r.x[j] = xr[64 * j];
    if (HASY) { const f32x4* yr = (const f32x4*)(y + (size_t)m * DM) + lane;
#pragma unroll
        for (int j = 0; j < 4; ++j) r.y[j] = yr[64 * j]; }
}
template <bool HASY, bool HASH>
__device__ __forceinline__ void nr_proc(NRow& r, const float* g1, float* xout, const float* g2, bf16* Hout, int m, int lane) {
    if (HASY) { float ss = 0.f;
#pragma unroll
        for (int j = 0; j < 4; ++j) ss += (r.y[j].x * r.y[j].x + r.y[j].y * r.y[j].y) + (r.y[j].z * r.y[j].z + r.y[j].w * r.y[j].w);
        const float rr = 1.0f / sqrtf(wave_sum(ss) * (1.0f / DM) + 1e-6f);
        f32x4* xo = (f32x4*)(xout + (size_t)m * DM) + lane;
#pragma unroll
        for (int j = 0; j < 4; ++j) { const f32x4 g = ((const f32x4*)g1)[lane + 64 * j]; r.x[j] = r.x[j] + (r.y[j] * rr) * g; xo[64 * j] = r.x[j]; } }
    if (HASH) { float ss = 0.f;
#pragma unroll
        for (int j = 0; j < 4; ++j) ss += (r.x[j].x * r.x[j].x + r.x[j].y * r.x[j].y) + (r.x[j].z * r.x[j].z + r.x[j].w * r.x[j].w);
        const float rr = 1.0f / sqrtf(wave_sum(ss) * (1.0f / DM) + 1e-6f);
        v2u* ho = (v2u*)(Hout + (size_t)m * DM) + lane;
#pragma unroll
        for (int j = 0; j < 4; ++j) { const f32x4 g = ((const f32x4*)g2)[lane + 64 * j]; const f32x4 o = (r.x[j] * rr) * g; v2u w; w.x = pk2(o.x, o.y); w.y = pk2(o.z, o.w); ho[64 * j] = w; } }
}
template <bool HASY, bool HASH>
__device__ __forceinline__ void norm_rows(const float* xin, const float* y, const float* g1, float* xout, const float* g2, bf16* Hout, int gw, int ngw, int lane) {
    if ((MROWS % (2 * ngw)) == 0) {
        for (int m = gw; m < MROWS; m += 2 * ngw) {
            NRow ra, rb;
            nr_load<HASY>(ra, xin, y, m, lane); nr_load<HASY>(rb, xin, y, m + ngw, lane);
            nr_proc<HASY, HASH>(ra, g1, xout, g2, Hout, m, lane); nr_proc<HASY, HASH>(rb, g1, xout, g2, Hout, m + ngw, lane);
        }
    } else {
        for (int m = gw; m < MROWS; m += ngw) { NRow ra; nr_load<HASY>(ra, xin, y, m, lane); nr_proc<HASY, HASH>(ra, g1, xout, g2, Hout, m, lane); }
    }
}

__device__ __forceinline__ void norm_first(const float* xin, bf16* XB, float* R2, int bid, int G, int wave, int lane) {
    for (int c = bid; c < MROWS / 32; c += G)
        for (int i = 0; i < 4; ++i) { const int m = 32 * c + wave + 8 * i;
            const f32x4* xr = (const f32x4*)(xin + (size_t)m * DM) + lane; f32x4 xv[4]; float ss = 0.f;
#pragma unroll
            for (int j = 0; j < 4; ++j) { xv[j] = xr[64 * j]; ss += (xv[j].x * xv[j].x + xv[j].y * xv[j].y) + (xv[j].z * xv[j].z + xv[j].w * xv[j].w); }
            const float r = 1.0f / sqrtf(wave_sum(ss) * (1.0f / DM) + 1e-6f);
            if (lane == 0) R2[m] = r;
            v2u* ho = (v2u*)(XB + (size_t)m * DM) + lane;
#pragma unroll
            for (int j = 0; j < 4; ++j) { v2u w; w.x = pk2(xv[j].x, xv[j].y); w.y = pk2(xv[j].z, xv[j].w); ho[64 * j] = w; }
        }
}
template <bool LAST, int NR>
__device__ __forceinline__ void norm_bf_rows(const bf16* XB, bf16* XO, const bf16* Yb, const f32x4 (&g)[2][2], float* R2, float* out, int m0, int ngw, int lane) {
    v4u xw[NR][2], yw[NR][2];
#pragma unroll
    for (int r = 0; r < NR; ++r)
#pragma unroll
        for (int j = 0; j < 2; ++j) { const size_t o = (size_t)(m0 + r * ngw) * DM + 8 * lane + 512 * j; xw[r][j] = *(const v4u*)(XB + o); yw[r][j] = *(const v4u*)(Yb + o); }
#pragma unroll
    for (int r = 0; r < NR; ++r) { const int m = m0 + r * ngw;
        float xv[2][8], yv[2][8]; float ss = 0.f;
#pragma unroll
        for (int j = 0; j < 2; ++j) {
            xv[j][0] = bflo(xw[r][j].x); xv[j][1] = bfhi(xw[r][j].x); xv[j][2] = bflo(xw[r][j].y); xv[j][3] = bfhi(xw[r][j].y); xv[j][4] = bflo(xw[r][j].z); xv[j][5] = bfhi(xw[r][j].z); xv[j][6] = bflo(xw[r][j].w); xv[j][7] = bfhi(xw[r][j].w);
            yv[j][0] = bflo(yw[r][j].x); yv[j][1] = bfhi(yw[r][j].x); yv[j][2] = bflo(yw[r][j].y); yv[j][3] = bfhi(yw[r][j].y); yv[j][4] = bflo(yw[r][j].z); yv[j][5] = bfhi(yw[r][j].z); yv[j][6] = bflo(yw[r][j].w); yv[j][7] = bfhi(yw[r][j].w);
#pragma unroll
            for (int e = 0; e < 8; ++e) ss += yv[j][e] * yv[j][e]; }
        const float rr = 1.0f / sqrtf(wave_sum(ss) * (1.0f / DM) + 1e-6f);
        float s2 = 0.f;
#pragma unroll
        for (int j = 0; j < 2; ++j)
#pragma unroll
            for (int e = 0; e < 8; ++e) { xv[j][e] = xv[j][e] + (yv[j][e] * rr) * g[j][e >> 2][e & 3]; s2 += xv[j][e] * xv[j][e]; }
        if (LAST) {
#pragma unroll
            for (int j = 0; j < 2; ++j) { f32x4* op = (f32x4*)(out + (size_t)m * DM + 8 * lane + 512 * j); op[0] = (f32x4){xv[j][0], xv[j][1], xv[j][2], xv[j][3]}; op[1] = (f32x4){xv[j][4], xv[j][5], xv[j][6], xv[j][7]}; }
        } else {
            const float r2 = 1.0f / sqrtf(wave_sum(s2) * (1.0f / DM) + 1e-6f);
            if (lane == 0) R2[m] = r2;
#pragma unroll
            for (int j = 0; j < 2; ++j) { v4u w; w.x = pk2(xv[j][0], xv[j][1]); w.y = pk2(xv[j][2], xv[j][3]); w.z = pk2(xv[j][4], xv[j][5]); w.w = pk2(xv[j][6], xv[j][7]);
                *(v4u*)(XO + (size_t)m * DM + 8 * lane + 512 * j) = w; }
        }
    }
}
template <bool LAST>
__device__ __forceinline__ void norm_bf(const bf16* XB, bf16* XO, const bf16* Yb, const float* g1, float* R2, float* out, int bid, int G, int wave, int lane) {
    f32x4 g[2][2];
#pragma unroll
    for (int j = 0; j < 2; ++j) { g[j][0] = *(const f32x4*)(g1 + 8 * lane + 512 * j); g[j][1] = *(const f32x4*)(g1 + 8 * lane + 512 * j + 4); }
    for (int c = bid; c < MROWS / 32; c += G) norm_bf_rows<LAST, 4>(XB, XO, Yb, g, R2, out, 32 * c + wave, 8, lane);
}

__device__ __forceinline__ void mixer_a(ArgP A, int l, int item, LAS unsigned char* lds, int tid, int wave, int lane) {
    const bf16* Z = (const bf16*)(A->ws + WS_Z); bf16* MIX = (bf16*)(A->ws + WS_MIX);
    const bf16* sgw = (const bf16*)(A->ws + WS_W + (size_t)l * WS_WL + WO_SG);
    const int b = item >> 4, ch = item & 15; const size_t r0 = (size_t)b * SEQ + 128 * ch;
    LAS bf16* VT = (LAS bf16*)lds;
    LAS float* ST = (LAS float*)(lds + 69632);
    { const int s = tid >> 2, qd = tid & 3; float sm = 0.f, sq = 0.f;
#pragma unroll
        for (int i = 0; i < 8; ++i) { const v4u w = *(const v4u*)(Z + (r0 + s) * ZC + ZC_AV + 64 * qd + 8 * i);
            const float a0 = bflo(w.x), a1 = bfhi(w.x), a2 = bflo(w.y), a3 = bfhi(w.y), a4 = bflo(w.z), a5 = bfhi(w.z), a6 = bflo(w.w), a7 = bfhi(w.w);
            sm += ((a0 + a1) + (a2 + a3)) + ((a4 + a5) + (a6 + a7)); sq += ((a0 * a0 + a1 * a1) + (a2 * a2 + a3 * a3)) + ((a4 * a4 + a5 * a5) + (a6 * a6 + a7 * a7)); }
        sm += __shfl_xor(sm, 1); sq += __shfl_xor(sq, 1); sm += __shfl_xor(sm, 2); sq += __shfl_xor(sq, 2);
        const float mu = sm * (1.0f / 256.0f), var = fmaxf(sq * (1.0f / 256.0f) - mu * mu, 0.f);
        if (qd == 0) { ST[2 * s] = mu; ST[2 * s + 1] = 1.0f / sqrtf(var + 1e-5f); } }
    __syncthreads();
    { const int s = tid & 127, og = tid >> 7; const float mu = ST[2 * s], rs = ST[2 * s + 1];
        const float* gp = A->in[I_SGLN] + l * 256;
#pragma unroll 2
        for (int i = 0; i < 8; ++i) { const int oct = og + 4 * i;
            const v4u w = *(const v4u*)(Z + (r0 + s) * ZC + ZC_AV + 8 * oct);
            const f32x4 g0 = *(const f32x4*)(gp + 8 * oct), g1 = *(const f32x4*)(gp + 8 * oct + 4);
            LAS bf16* vp = VT + (8 * oct) * 136 + s;
            vp[0 * 136] = (bf16)f2bf((bflo(w.x) - mu) * rs * g0.x); vp[1 * 136] = (bf16)f2bf((bfhi(w.x) - mu) * rs * g0.y);
            vp[2 * 136] = (bf16)f2bf((bflo(w.y) - mu) * rs * g0.z); vp[3 * 136] = (bf16)f2bf((bfhi(w.y) - mu) * rs * g0.w);
            vp[4 * 136] = (bf16)f2bf((bflo(w.z) - mu) * rs * g1.x); vp[5 * 136] = (bf16)f2bf((bfhi(w.z) - mu) * rs * g1.y);
            vp[6 * 136] = (bf16)f2bf((bflo(w.w) - mu) * rs * g1.z); vp[7 * 136] = (bf16)f2bf((bfhi(w.w) - mu) * rs * g1.w); } }
    __syncthreads();
    const int h = wave >> 1, th = wave & 1, fr = lane & 15, q = lane >> 4;
    f32x4 acc[4][4];
#pragma unroll
    for (int a = 0; a < 4; ++a)
#pragma unroll
        for (int c = 0; c < 4; ++c) acc[a][c] = (f32x4){0.f, 0.f, 0.f, 0.f};
    const bf16* Wb = sgw + (size_t)h * 128 * 128;
#pragma unroll 2
    for (int ks = 0; ks < 4; ++ks) {
        v4u vf[4];
#pragma unroll
        for (int nt = 0; nt < 4; ++nt) vf[nt] = *(const LAS v4u*)(VT + (64 * h + 16 * nt + fr) * 136 + 32 * ks + 8 * q);
#pragma unroll
        for (int mt = 0; mt < 4; ++mt) { const int t = 64 * th + 16 * mt + fr; const v4u wf = *(const v4u*)(Wb + t * 128 + 32 * ks + 8 * q);
#pragma unroll
            for (int nt = 0; nt < 4; ++nt) acc[mt][nt] = mfma16(vf[nt], wf, acc[mt][nt]); }
    }
#pragma unroll
    for (int mt = 0; mt < 4; ++mt) { const int t = 64 * th + 16 * mt + fr; const float bias = A->in[I_SGB][l * 512 + h * 128 + t];
#pragma unroll
        for (int nt = 0; nt < 4; ++nt) { const int d0 = 64 * h + 16 * nt + 4 * q;
            const v2u uw = *(const v2u*)(Z + (r0 + t) * ZC + ZC_AU + d0); const f32x4 a = acc[mt][nt];
            v2u o; o.x = pk2(bflo(uw.x) * (a.x + bias), bfhi(uw.x) * (a.y + bias)); o.y = pk2(bflo(uw.y) * (a.z + bias), bfhi(uw.y) * (a.w + bias));
            *(v2u*)(MIX + (r0 + t) * DM + d0) = o; } }
    __syncthreads();
}

__device__ __forceinline__ void mixer_b(ArgP A, int l, int item, LAS unsigned char* lds, int tid, int wave, int lane) {
    const bf16* Z = (const bf16*)(A->ws + WS_Z); bf16* MIX = (bf16*)(A->ws + WS_MIX);
    const bf16* pwt = (const bf16*)(A->ws + WS_W + (size_t)l * WS_WL + WO_PW);
    const int b = item >> 5, tau = item & 31, t0 = 64 * tau; const size_t r0 = (size_t)b * SEQ + t0;
    LAS bf16* Ht = (LAS bf16*)lds;
    LAS float* CO = (LAS float*)(lds + 49152);
    LAS bf16* AT = (LAS bf16*)lds;
#pragma unroll
    for (int it_ = 0; it_ < 6; ++it_) { const int idx = tid + it_ * NTHREADS; if (idx >= 94 * 32) break; const int i = idx >> 5, oct = idx & 31, t = t0 - 30 + i; v4u o = (v4u){0u, 0u, 0u, 0u};
        if (t >= 0) { const bf16* zp = Z + ((size_t)b * SEQ + t) * ZC; const v4u a = *(const v4u*)(zp + ZC_BA + 8 * oct), g = *(const v4u*)(zp + ZC_BG + 8 * oct);
            o.x = pk2(bflo(a.x) * sigmoidf_(bflo(g.x)), bfhi(a.x) * sigmoidf_(bfhi(g.x))); o.y = pk2(bflo(a.y) * sigmoidf_(bflo(g.y)), bfhi(a.y) * sigmoidf_(bfhi(g.y)));
            o.z = pk2(bflo(a.z) * sigmoidf_(bflo(g.z)), bfhi(a.z) * sigmoidf_(bfhi(g.z))); o.w = pk2(bflo(a.w) * sigmoidf_(bflo(g.w)), bfhi(a.w) * sigmoidf_(bfhi(g.w))); }
        *(LAS v4u*)(Ht + i * 256 + 8 * oct) = o; }
    __syncthreads();
    { const int c = tid & 255, half = tid >> 8; float wt[31];
#pragma unroll
        for (int w = 0; w < 31; ++w) wt[w] = A->in[I_CVW][(size_t)l * 31 * 256 + w * 256 + c];
        const float bias = A->in[I_CVB][l * 256 + c];
#pragma unroll 1
        for (int tg = 0; tg < 4; ++tg) { const int tb = 32 * half + 8 * tg; float ac[8];
#pragma unroll
            for (int j = 0; j < 8; ++j) ac[j] = bias;
#pragma unroll
            for (int i = 0; i < 38; ++i) { const float hv = bf2f(Ht[(tb + i) * 256 + c]);
#pragma unroll
                for (int j = 0; j < 8; ++j) if (i - j >= 0 && i - j < 31) ac[j] += hv * wt[i - j]; }
#pragma unroll
            for (int j = 0; j < 8; ++j) CO[(tb + j) * 256 + c] = ac[j]; } }
    __syncthreads();
    v4u bpf[8][2];
#pragma unroll
    for (int ks = 0; ks < 8; ++ks)
#pragma unroll
        for (int nt = 0; nt < 2; ++nt) bpf[ks][nt] = *(const v4u*)(pwt + (32 * wave + 16 * nt + (lane & 15)) * 256 + 32 * ks + 8 * (lane >> 4));
    { const f32x4 g = *(const f32x4*)(A->in[I_CVLG] + l * 256 + 4 * lane), bb = *(const f32x4*)(A->in[I_CVLB] + l * 256 + 4 * lane);
#if MIXB_LNNEW
        f32x4 v[8]; float sm[8];
#pragma unroll
        for (int i = 0; i < 8; ++i) { v[i] = *(const LAS f32x4*)(CO + (8 * wave + i) * 256 + 4 * lane); sm[i] = (v[i].x + v[i].y) + (v[i].z + v[i].w); }
#pragma unroll
        for (int o = 1; o < 64; o <<= 1)
#pragma unroll
            for (int i = 0; i < 8; ++i) sm[i] += __shfl_xor(sm[i], o);
#pragma unroll
        for (int i = 0; i < 8; ++i) { v[i] = v[i] - sm[i] * (1.0f / 256.0f); sm[i] = (v[i].x * v[i].x + v[i].y * v[i].y) + (v[i].z * v[i].z + v[i].w * v[i].w); }
#pragma unroll
        for (int o = 1; o < 64; o <<= 1)
#pragma unroll
            for (int i = 0; i < 8; ++i) sm[i] += __shfl_xor(sm[i], o);
#pragma unroll
        for (int i = 0; i < 8; ++i) { const float rs = 1.0f / sqrtf(sm[i] * (1.0f / 256.0f) + 1e-5f);
            const f32x4 y = (v[i] * rs) * g + bb; v2u o; o.x = pk2(siluf_(y.x), siluf_(y.y)); o.y = pk2(siluf_(y.z), siluf_(y.w));
            *(LAS v2u*)(AT + (8 * wave + i) * 264 + 4 * lane) = o; } }
#else
        for (int i = 0; i < 8; ++i) { const int t = 8 * wave + i; const f32x4 v = *(const LAS f32x4*)(CO + t * 256 + 4 * lane);
            const float mu = wave_sum((v.x + v.y) + (v.z + v.w)) * (1.0f / 256.0f); const f32x4 d = v - mu;
            const float var = wave_sum((d.x * d.x + d.y * d.y) + (d.z * d.z + d.w * d.w)) * (1.0f / 256.0f); const float rs = 1.0f / sqrtf(var + 1e-5f);
            const f32x4 y = (d * rs) * g + bb; v2u o; o.x = pk2(siluf_(y.x), siluf_(y.y)); o.y = pk2(siluf_(y.z), siluf_(y.w));
            *(LAS v2u*)(AT + t * 264 + 4 * lane) = o; } }
#endif
    __syncthreads();
    const int fr = lane & 15, q = lane >> 4;
    f32x4 acc[4][2];
#pragma unroll
    for (int a = 0; a < 4; ++a)
#pragma unroll
        for (int c = 0; c < 2; ++c) acc[a][c] = (f32x4){0.f, 0.f, 0.f, 0.f};
#pragma unroll
    for (int ks = 0; ks < 8; ++ks) {
#pragma unroll
        for (int mt = 0; mt < 4; ++mt) { const v4u af = *(const LAS v4u*)(AT + (16 * mt + fr) * 264 + 32 * ks + 8 * q);
#pragma unroll
            for (int nt = 0; nt < 2; ++nt) acc[mt][nt] = mfma16(bpf[ks][nt], af, acc[mt][nt]); } }
#pragma unroll
    for (int mt = 0; mt < 4; ++mt)
#pragma unroll
        for (int nt = 0; nt < 2; ++nt) { const int n0 = 32 * wave + 16 * nt + 4 * q; const f32x4 pb = *(const f32x4*)(A->in[I_CVPB] + l * 256 + n0); const f32x4 o = acc[mt][nt] + pb;
            v2u w; w.x = pk2(o.x, o.y); w.y = pk2(o.z, o.w); *(v2u*)(MIX + (r0 + 16 * mt + fr) * DM + 256 + n0) = w; }
    __syncthreads();
}

template <int W>
__device__ __forceinline__ void pool_means(const LAS bf16* Xt, LAS bf16* AT, int c, int half, int t0) {
    float xv[47];
#pragma unroll
    for (int i = 0; i < 47; ++i) xv[i] = (i >= 16 - W) ? bf2f(Xt[(32 * half + i) * 256 + c]) : 0.f;
    float s = 0.f;
#pragma unroll
    for (int i = 0; i < W; ++i) s += xv[15 - i];
#pragma unroll
    for (int j = 0; j < 32; ++j) { const int jj = 32 * half + j, t = t0 + jj;
        if (j > 0) s += xv[15 + j] - xv[15 + j - W];
        const int cnt = (t + 1 < W) ? (t + 1) : W;
        AT[jj * 264 + c] = (bf16)f2bf(s / (float)cnt - xv[15 + j]); }
}

__device__ __forceinline__ void mixer_d(ArgP A, int l, int item, LAS unsigned char* lds, int tid, int wave, int lane) {
    const bf16* Z = (const bf16*)(A->ws + WS_Z); bf16* MIX = (bf16*)(A->ws + WS_MIX);
    const bf16* poolt = (const bf16*)(A->ws + WS_W + (size_t)l * WS_WL + WO_POOL);
    bf16* VTS = (bf16*)(A->ws + WS_VTS); bf16* VTW = (bf16*)(A->ws + WS_VTW);
    const int b = item >> 5, tau = item & 31, t0 = 64 * tau; const size_t r0 = (size_t)b * SEQ + t0;
    LAS bf16* Xt = (LAS bf16*)lds;
    LAS bf16* AT = (LAS bf16*)(lds + 40960);
    LAS bf16* TS = (LAS bf16*)(lds + 75776);
#pragma unroll
    for (int it_ = 0; it_ < 5; ++it_) { const int idx = tid + it_ * NTHREADS; if (idx >= 79 * 32) break; const int i = idx >> 5, oct = idx & 31, t = t0 - 15 + i; v4u o = (v4u){0u, 0u, 0u, 0u};
        if (t >= 0) o = *(const v4u*)(Z + ((size_t)b * SEQ + t) * ZC + ZC_D + 8 * oct);
        *(LAS v4u*)(Xt + i * 256 + 8 * oct) = o; }
    { const int tok = tid & 63, oct = tid >> 6; const bf16* zp = Z + (r0 + tok) * ZC;
        const v4u a = *(const v4u*)(zp + ZC_VS + 8 * oct), c = *(const v4u*)(zp + ZC_VW + 8 * oct);
        LAS bf16* p0 = TS + (8 * oct) * 72 + tok; LAS bf16* p1 = p0 + 4608;
        p0[0] = (bf16)(a.x & 0xffffu); p0[72] = (bf16)(a.x >> 16); p0[144] = (bf16)(a.y & 0xffffu); p0[216] = (bf16)(a.y >> 16);
        p0[288] = (bf16)(a.z & 0xffffu); p0[360] = (bf16)(a.z >> 16); p0[432] = (bf16)(a.w & 0xffffu); p0[504] = (bf16)(a.w >> 16);
        p1[0] = (bf16)(c.x & 0xffffu); p1[72] = (bf16)(c.x >> 16); p1[144] = (bf16)(c.y & 0xffffu); p1[216] = (bf16)(c.y >> 16);
        p1[288] = (bf16)(c.z & 0xffffu); p1[360] = (bf16)(c.z >> 16); p1[432] = (bf16)(c.w & 0xffffu); p1[504] = (bf16)(c.w >> 16); }
    __syncthreads();
#if MIXD_NEW
    { const int c = tid & 255, half = tid >> 8, g = c >> 6;
        if (g == 0) pool_means<2>(Xt, AT, c, half, t0); else if (g == 1) pool_means<4>(Xt, AT, c, half, t0); else if (g == 2) pool_means<8>(Xt, AT, c, half, t0); else pool_means<16>(Xt, AT, c, half, t0); }
#else
    { const int c = tid & 255, half = tid >> 8, g = c >> 6, w = 2 << g;
        for (int j = 0; j < 32; ++j) { const int jj = 32 * half + j, t = t0 + jj; float s = 0.f;
            for (int i = 0; i < w; ++i) s += bf2f(Xt[(15 + jj - i) * 256 + c]);
            const int cnt = (t + 1 < w) ? (t + 1) : w;
            const float mval = s / (float)cnt - bf2f(Xt[(15 + jj) * 256 + c]);
            AT[jj * 264 + c] = (bf16)f2bf(mval); } }
#endif
    { const int d = tid >> 3, pc = tid & 7;
        *(v4u*)(VTS + ((size_t)b * 64 + d) * SEQ + t0 + 8 * pc) = *(const LAS v4u*)(TS + d * 72 + 8 * pc);
        *(v4u*)(VTW + ((size_t)b * 64 + d) * SEQ + t0 + 8 * pc) = *(const LAS v4u*)(TS + 4608 + d * 72 + 8 * pc); }
    __syncthreads();
    const int fr = lane & 15, q = lane >> 4, g = wave >> 1, nh = wave & 1;
    f32x4 acc[4][2];
#pragma unroll
    for (int a = 0; a < 4; ++a)
#pragma unroll
        for (int c = 0; c < 2; ++c) acc[a][c] = (f32x4){0.f, 0.f, 0.f, 0.f};
#pragma unroll
    for (int ks = 0; ks < 2; ++ks) { v4u bfr[2];
#pragma unroll
        for (int nt = 0; nt < 2; ++nt) bfr[nt] = *(const v4u*)(poolt + g * 4096 + (32 * nh + 16 * nt + fr) * 64 + 32 * ks + 8 * q);
#pragma unroll
        for (int mt = 0; mt < 4; ++mt) { const v4u af = *(const LAS v4u*)(AT + (16 * mt + fr) * 264 + 64 * g + 32 * ks + 8 * q);
#pragma unroll
            for (int nt = 0; nt < 2; ++nt) acc[mt][nt] = mfma16(bfr[nt], af, acc[mt][nt]); } }
#pragma unroll
    for (int mt = 0; mt < 4; ++mt)
#pragma unroll
        for (int nt = 0; nt < 2; ++nt) { const int n0 = 64 * g + 32 * nh + 16 * nt + 4 * q; const f32x4 sc = *(const f32x4*)(A->in[I_POOLS] + l * 256 + n0); const f32x4 o = acc[mt][nt] * sc;
            v2u w; w.x = pk2(o.x, o.y); w.y = pk2(o.z, o.w); *(v2u*)(MIX + (r0 + 16 * mt + fr) * DM + 768 + n0) = w; }
    __syncthreads();
}

__device__ __forceinline__ void nsa_compress(ArgP A, int l, int item, LAS unsigned char* lds, int tid, int wave, int lane) {
    const bf16* Z = (const bf16*)(A->ws + WS_Z);
    bf16* KC = (bf16*)(A->ws + WS_KC); bf16* VCT = (bf16*)(A->ws + WS_VCT);
    const int b = item >> 4, kv = (item >> 3) & 1, mt = item & 7;
    const int colb = kv ? ZC_VC : ZC_KC;
    const float* pos = A->in[kv ? I_POSV : I_POSK] + l * 2048;
    const bf16* w1t = (const bf16*)(A->ws + WS_W + (size_t)l * WS_WL + (kv ? WO_W1V : WO_W1K));
    const float* w2 = A->in[kv ? I_W2V : I_W2K] + l * 4096;
    LAS float* RED = (LAS float*)lds;
    LAS float* H1 = (LAS float*)(lds + 32768);
    const int fr = lane & 15, q = lane >> 4, c = 16 * mt + fr; const bool cok = c < 127;
    f32x4 acc[4];
#pragma unroll
    for (int n = 0; n < 4; ++n) acc[n] = (f32x4){0.f, 0.f, 0.f, 0.f};
#pragma unroll 4
    for (int kk = 0; kk < 8; ++kk) { const int ks = 8 * wave + kk, ltok = ks >> 1, dd = 32 * (ks & 1) + 8 * q;
        v4u af = (v4u){0u, 0u, 0u, 0u};
        if (cok) { const v4u zw = *(const v4u*)(Z + ((size_t)b * SEQ + 16 * c + ltok) * ZC + colb + dd);
            const f32x4 p0 = *(const f32x4*)(pos + ltok * 64 + dd), p1 = *(const f32x4*)(pos + ltok * 64 + dd + 4);
            af.x = pk2(bflo(zw.x) + p0.x, bfhi(zw.x) + p0.y); af.y = pk2(bflo(zw.y) + p0.z, bfhi(zw.y) + p0.w);
            af.z = pk2(bflo(zw.z) + p1.x, bfhi(zw.z) + p1.y); af.w = pk2(bflo(zw.w) + p1.z, bfhi(zw.w) + p1.w); }
#pragma unroll
        for (int nt = 0; nt < 4; ++nt) { const v4u bfr = *(const v4u*)(w1t + (16 * nt + fr) * 2048 + 32 * ks + 8 * q); acc[nt] = mfma16(af, bfr, acc[nt]); } }
#pragma unroll
    for (int nt = 0; nt < 4; ++nt)
#pragma unroll
        for (int rg = 0; rg < 4; ++rg) RED[(wave * 16 + 4 * q + rg) * 64 + 16 * nt + fr] = acc[nt][rg];
    __syncthreads();
#pragma unroll
    for (int x = 0; x < 2; ++x) { const int o = tid + 512 * x, cc = o >> 6, n = o & 63; float s = 0.f;
#pragma unroll
        for (int w = 0; w < 8; ++w) s += RED[(w * 16 + cc) * 64 + n];
        H1[o] = siluf_(s); }
    __syncthreads();
#pragma unroll
    for (int x = 0; x < 2; ++x) { const int o = tid + 512 * x, cc = o >> 6, n2 = o & 63; float s = 0.f;
        for (int n = 0; n < 64; ++n) s += H1[cc * 64 + n] * w2[n * 64 + n2];
        const int cg_ = 16 * mt + cc;
        (kv == 0 ? KC : VCT)[((size_t)b * 128 + cg_) * 64 + n2] = (bf16)f2bf(s); }
    __syncthreads();
}

template <int HA, int HB, class MaskA, class MaskB>
__device__ __forceinline__ void attn_pair(const LAS bf16* KT, const LAS bf16* VT, const v4u (&qf)[2], int fr, int q, float& m_run, f32x4& o5, f32x4 (&o)[4],
                                          float rba, float rbb, bool ma, bool mb, MaskA okA, MaskB okB) {
    constexpr int N0 = HA ? 0 : 4, N1 = HB ? 8 : 4, K0 = HA ? 0 : 2, K1 = HB ? 4 : 2;
    v4u kf0[8], kf1[8];
#pragma unroll
    for (int nt = N0; nt < N1; ++nt) { kf0[nt] = *(const LAS v4u*)(KT + (16 * nt + fr) * 72 + 8 * q); kf1[nt] = *(const LAS v4u*)(KT + (16 * nt + fr) * 72 + 32 + 8 * q); }
    __builtin_amdgcn_sched_barrier(0);
    f32x4 s[8];
#pragma unroll
    for (int nt = N0; nt < N1; ++nt) { const float rb = nt < 4 ? rba : rbb;
        s[nt] = mfma16(kf0[nt], qf[0], (f32x4){rb, rb, rb, rb}); s[nt] = mfma16(kf1[nt], qf[1], s[nt]); }
    __builtin_amdgcn_sched_barrier(0);
    v2u vfa[4][4], vfb[4][4];
#pragma unroll
    for (int k2 = K0; k2 < K1; ++k2)
#pragma unroll
        for (int dt = 0; dt < 4; ++dt) { vfa[k2][dt] = *(const LAS v2u*)(VT + (16 * dt + fr) * 136 + 32 * k2 + 4 * q); vfb[k2][dt] = *(const LAS v2u*)(VT + (16 * dt + fr) * 136 + 32 * k2 + 16 + 4 * q); }
    __builtin_amdgcn_sched_barrier(0);
    if (HA && ma) {
#pragma unroll
        for (int nt = 0; nt < 4; ++nt)
#pragma unroll
            for (int rg = 0; rg < 4; ++rg) s[nt][rg] = okA(16 * nt + 4 * q + rg) ? s[nt][rg] : -1e30f; }
    if (HB && mb) {
#pragma unroll
        for (int nt = 0; nt < 4; ++nt)
#pragma unroll
            for (int rg = 0; rg < 4; ++rg) s[4 + nt][rg] = okB(16 * nt + 4 * q + rg) ? s[4 + nt][rg] : -1e30f; }
    float mx = m_run;
#pragma unroll
    for (int nt = N0; nt < N1; ++nt)
#pragma unroll
        for (int rg = 0; rg < 4; ++rg) mx = fmaxf(mx, s[nt][rg]);
    mx = fmaxf(mx, __shfl_xor(mx, 16)); mx = fmaxf(mx, __shfl_xor(mx, 32));
    if (__ballot(mx != m_run) != 0ull) {
        const float sc = __builtin_amdgcn_exp2f(m_run - mx); m_run = mx; o5 = o5 * sc;
#pragma unroll
        for (int dt = 0; dt < 4; ++dt) o[dt] = o[dt] * sc; }
#pragma unroll
    for (int nt = N0; nt < N1; ++nt)
#pragma unroll
        for (int rg = 0; rg < 4; ++rg) s[nt][rg] = __builtin_amdgcn_exp2f(s[nt][rg] - mx);
    const unsigned onesw = (fr == 0) ? 0x3f803f80u : 0u; const v4u vones = (v4u){onesw, onesw, onesw, onesw};
#pragma unroll
    for (int k2 = K0; k2 < K1; ++k2) { v4u pf; pf.x = pk2(s[2 * k2][0], s[2 * k2][1]); pf.y = pk2(s[2 * k2][2], s[2 * k2][3]); pf.z = pk2(s[2 * k2 + 1][0], s[2 * k2 + 1][1]); pf.w = pk2(s[2 * k2 + 1][2], s[2 * k2 + 1][3]);
        o5 = mfma16(vones, pf, o5);
#pragma unroll
        for (int dt = 0; dt < 4; ++dt) { v4u vf; vf.x = vfa[k2][dt].x; vf.y = vfa[k2][dt].y; vf.z = vfb[k2][dt].x; vf.w = vfb[k2][dt].y; o[dt] = mfma16(vf, pf, o[dt]); } }
}

__device__ __forceinline__ void nsa_attn(ArgP A, int l, int item, LAS unsigned char* lds, int tid, int wave, int lane, int dry = 0) {
    const bf16* Z = (const bf16*)(A->ws + WS_Z); bf16* MIX = (bf16*)(A->ws + WS_MIX);
    const bf16* VTS = (const bf16*)(A->ws + WS_VTS); const bf16* VTW = (const bf16*)(A->ws + WS_VTW);
    const bf16* KC = (const bf16*)(A->ws + WS_KC); const bf16* VCT = (const bf16*)(A->ws + WS_VCT);
    const int jq = item >> 8, ib = item & 255, b = 2 * (ib & 7) + ((ib >> 3) & 1), a = ib >> 4;
    const int tau = (jq == 0) ? a : (jq == 1) ? 31 - a : (jq == 2) ? 32 + a : 63 - a;
    const int t0 = 32 * tau;
    LAS bf16* TB = (LAS bf16*)lds;
    LAS bf16* KT = TB; LAS bf16* VT = TB + 9216;
    LAS float* PS = (LAS float*)(lds + 71680) + wave * (16 * 132);
    LAS float* IMP = (LAS float*)(lds + 139264) + wave * 128;
    LAS unsigned* WANY = (LAS unsigned*)(lds + 143360);
    const int fr = lane & 15, q = lane >> 4, tt = fr >> 2, hh = fr & 3;
    const int t = t0 + 4 * wave + tt; const size_t grow = (size_t)b * SEQ + t;
    const int skey = tid >> 3, spc = tid & 7;
    const int curb = t0 >> 6, wlo = (t0 >= 511) ? ((t0 - 511) >> 6) : 0;
    const bf16* kbase = Z + ((size_t)b * SEQ + skey) * ZC + 8 * spc;
    const size_t vbase = ((size_t)b * 64 + skey) * SEQ + 8 * spc;
    const v4u zero4 = (v4u){0u, 0u, 0u, 0u};
    v4u kr[2], vr[2];
    kr[0] = *(const v4u*)(kbase + ZC_KS); vr[0] = *(const v4u*)(VTS + vbase);
    if (curb > 0) { kr[1] = *(const v4u*)(kbase + (size_t)(64 * curb) * ZC + ZC_KS); vr[1] = *(const v4u*)(VTS + vbase + 64 * curb); } else { kr[1] = zero4; vr[1] = zero4; }
    v4u qf[2];
#pragma unroll
    for (int ks = 0; ks < 2; ++ks) { const v4u w = *(const v4u*)(Z + grow * ZC + ZC_Q + 64 * hh + 32 * ks + 8 * q);
        const float qs = 0.125f * 1.4426950408889634f;
        qf[ks].x = pk2(bflo(w.x) * qs, bfhi(w.x) * qs); qf[ks].y = pk2(bflo(w.y) * qs, bfhi(w.y) * qs);
        qf[ks].z = pk2(bflo(w.z) * qs, bfhi(w.z) * qs); qf[ks].w = pk2(bflo(w.w) * qs, bfhi(w.w) * qs); }
    const float g0 = sigmoidf_(bf2f(Z[grow * ZC + ZC_G + 3 * hh + 0])), g1 = sigmoidf_(bf2f(Z[grow * ZC + ZC_G + 3 * hh + 1])), g2 = sigmoidf_(bf2f(Z[grow * ZC + ZC_G + 3 * hh + 2]));
#pragma unroll
    for (int x = 0; x < 2; ++x) { const int pi = tid + 512 * x;
        { const int c = pi >> 3, pc = pi & 7; *(LAS v4u*)(KT + c * 72 + 8 * pc) = *(const v4u*)(KC + ((size_t)b * 128 + c) * 64 + 8 * pc); }
        { const int c = pi >> 3, pc = pi & 7; const v4u w = *(const v4u*)(VCT + ((size_t)b * 128 + c) * 64 + 8 * pc); LAS bf16* vp = VT + (8 * pc) * 136 + c;
            vp[0] = (bf16)(w.x & 0xffffu); vp[136] = (bf16)(w.x >> 16); vp[272] = (bf16)(w.y & 0xffffu); vp[408] = (bf16)(w.y >> 16);
            vp[544] = (bf16)(w.z & 0xffffu); vp[680] = (bf16)(w.z >> 16); vp[816] = (bf16)(w.w & 0xffffu); vp[952] = (bf16)(w.w >> 16); } }
    __syncthreads();
    f32x4 facc[4];
    unsigned long long bal0, bal1;
    {
        f32x4 s[8];
#pragma unroll
        for (int nt = 0; nt < 8; ++nt) { const v4u k0 = *(const LAS v4u*)(KT + (16 * nt + fr) * 72 + 8 * q), k1 = *(const LAS v4u*)(KT + (16 * nt + fr) * 72 + 32 + 8 * q);
            s[nt] = mfma16(k0, qf[0], (f32x4){0.f, 0.f, 0.f, 0.f}); s[nt] = mfma16(k1, qf[1], s[nt]); }
        float mx = -1e30f;
#pragma unroll
        for (int nt = 0; nt < 8; ++nt)
#pragma unroll
            for (int rg = 0; rg < 4; ++rg) { const int c = 16 * nt + 4 * q + rg; const float v = (16 * c + 31 <= t) ? s[nt][rg] : -1e30f; s[nt][rg] = v; mx = fmaxf(mx, v); }
        mx = fmaxf(mx, __shfl_xor(mx, 16)); mx = fmaxf(mx, __shfl_xor(mx, 32));
        float sum = 0.f;
#pragma unroll
        for (int nt = 0; nt < 8; ++nt)
#pragma unroll
            for (int rg = 0; rg < 4; ++rg) { const float p = (s[nt][rg] > -5e29f) ? __builtin_amdgcn_exp2f(s[nt][rg] - mx) : 0.f; s[nt][rg] = p; sum += p; }
        sum += __shfl_xor(sum, 16); sum += __shfl_xor(sum, 32);
        const float inv = (t >= 31) ? 1.0f / sum : 0.f;
#pragma unroll
        for (int nt = 0; nt < 8; ++nt) { s[nt] = s[nt] * inv; *(LAS f32x4*)(PS + fr * 132 + 16 * nt + 4 * q) = s[nt]; }
        f32x4 oc[4];
#pragma unroll
        for (int dt = 0; dt < 4; ++dt) oc[dt] = (f32x4){0.f, 0.f, 0.f, 0.f};
#pragma unroll
        for (int k2 = 0; k2 < 4; ++k2) { v4u pf; pf.x = pk2(s[2 * k2][0], s[2 * k2][1]); pf.y = pk2(s[2 * k2][2], s[2 * k2][3]); pf.z = pk2(s[2 * k2 + 1][0], s[2 * k2 + 1][1]); pf.w = pk2(s[2 * k2 + 1][2], s[2 * k2 + 1][3]);
#pragma unroll
            for (int dt = 0; dt < 4; ++dt) { const v2u va = *(const LAS v2u*)(VT + (16 * dt + fr) * 136 + 32 * k2 + 4 * q), vb = *(const LAS v2u*)(VT + (16 * dt + fr) * 136 + 32 * k2 + 16 + 4 * q);
                v4u vf; vf.x = va.x; vf.y = va.y; vf.z = vb.x; vf.w = vb.y; oc[dt] = mfma16(vf, pf, oc[dt]); } }
#pragma unroll
        for (int dt = 0; dt < 4; ++dt) facc[dt] = oc[dt] * g0;
        LDS_WAIT();
        const int tt2 = lane >> 4, jl = lane & 15, t2 = t0 + 4 * wave + tt2, cur = t2 >> 6;
        float key[2];
#pragma unroll
        for (int x = 0; x < 2; ++x) { const int j = jl + 16 * x; float im = 0.f;
#pragma unroll
            for (int i = 0; i < 5; ++i) { const int c = 4 * j - 1 + i;
                if (c >= 0 && c <= 126) { im += PS[(4 * tt2 + 0) * 132 + c]; im += PS[(4 * tt2 + 1) * 132 + c]; im += PS[(4 * tt2 + 2) * 132 + c]; im += PS[(4 * tt2 + 3) * 132 + c]; } }
            const bool valid = j <= cur, forced = (j == 0) | (j == cur) | (j == cur - 1);
            key[x] = valid ? (forced ? im + 1e4f : im) : -1e30f; IMP[tt2 * 32 + j] = key[x]; }
        LDS_WAIT();
        int rk0 = 0, rk1 = 0;
        f32x4 kq[8];
#pragma unroll
        for (int i = 0; i < 8; ++i) kq[i] = *(const LAS f32x4*)(IMP + tt2 * 32 + 4 * i);
#pragma unroll
        for (int j2 = 0; j2 < 32; ++j2) { const float k2 = kq[j2 >> 2][j2 & 3];
            rk0 += ((k2 > key[0]) || (k2 == key[0] && j2 < jl)) ? 1 : 0; rk1 += ((k2 > key[1]) || (k2 == key[1] && j2 < jl + 16)) ? 1 : 0; }
        const bool sel0 = (jl <= cur) && rk0 < 8, sel1 = (jl + 16 <= cur) && rk1 < 8;
        bal0 = __ballot(sel0); bal1 = __ballot(sel1);
    }
    const unsigned msk = (unsigned)((bal0 >> (16 * tt)) & 0xffffull) | ((unsigned)((bal1 >> (16 * tt)) & 0xffffull) << 16);
    unsigned wany = 0;
#pragma unroll
    for (int x = 0; x < 4; ++x) wany |= (unsigned)((bal0 >> (16 * x)) & 0xffffull) | ((unsigned)((bal1 >> (16 * x)) & 0xffffull) << 16);
    if (lane == 0) WANY[wave] = wany;
#define ATT_PUT(buf) do { LAS bf16* Kn_ = TB + (buf) * 17920; LAS bf16* Vn_ = Kn_ + 9216; \
        *(LAS v4u*)(Kn_ + skey * 72 + 8 * spc) = kr[0]; *(LAS v4u*)(Kn_ + (64 + skey) * 72 + 8 * spc) = kr[1]; \
        *(LAS v4u*)(Vn_ + skey * 136 + 8 * spc) = vr[0]; *(LAS v4u*)(Vn_ + skey * 136 + 64 + 8 * spc) = vr[1]; } while (0)
    ATT_PUT(1);
    __syncthreads();
    unsigned uni = 0;
#pragma unroll
    for (int w = 0; w < 8; ++w) uni |= WANY[w];
    if (dry & 2) return;
    unsigned rem = uni & ~1u & ~(1u << curb); int gph = 0, gj = wlo;
    int cph = 0, cja = 0, cjb = (curb > 0) ? curb : -1, tb = 1;
    int nph, nja, njb;
#define ATT_NEXT() do { if (gph == 0 && rem == 0u) gph = 1; \
        if (gph == 0) { nph = 0; nja = __builtin_ctz(rem); rem &= rem - 1u; if (rem) { njb = __builtin_ctz(rem); rem &= rem - 1u; } else njb = -1; } \
        else if (gph == 1 && gj <= curb) { nph = 1; nja = gj++; if (gj <= curb) njb = gj++; else njb = -1; } \
        else { gph = 2; nph = 2; nja = 0; njb = -1; } } while (0)
    ATT_NEXT();
    float m_run = -1e4f; f32x4 o5 = (f32x4){0.f, 0.f, 0.f, 0.f}; f32x4 o[4];
#pragma unroll
    for (int dt = 0; dt < 4; ++dt) o[dt] = (f32x4){0.f, 0.f, 0.f, 0.f};
    while (cph != 2) {
        if (nph != 2) { const int kc = nph ? ZC_KW : ZC_KS; const bf16* vsrc = nph ? VTW : VTS;
            kr[0] = *(const v4u*)(kbase + (size_t)(64 * nja) * ZC + kc); vr[0] = *(const v4u*)(vsrc + vbase + 64 * nja);
            if (njb >= 0) { kr[1] = *(const v4u*)(kbase + (size_t)(64 * njb) * ZC + kc); vr[1] = *(const v4u*)(vsrc + vbase + 64 * njb); } else { kr[1] = zero4; vr[1] = zero4; } }
        const LAS bf16* Kb = TB + tb * 17920; const LAS bf16* Vb = Kb + 9216; const int ka = 64 * cja, kb2 = 64 * cjb;
        {
            const bool selA = (msk >> cja) & 1u, selB = (cjb >= 0) && ((msk >> cjb) & 1u);
            const bool ua = cph ? true : ((wany >> cja) & 1u), ub = (cjb >= 0) && (cph ? true : ((wany >> cjb) & 1u));
            if ((ua || ub) && !(dry & 1)) { const float rba = (cph || selA) ? 0.f : -1e30f, rbb = (cph || selB) ? 0.f : -1e30f; const int tlo = cph ? t - 512 : -(1 << 30);
                const bool ma = (cja == curb) || (cph && cja <= wlo + 1), mb = (cjb == curb) || (cph && cjb <= wlo + 1);
                auto okA = [=](int kk) { const int kp = ka + kk; return (kp <= t) && (kp > tlo); }; auto okB = [=](int kk) { const int kp = kb2 + kk; return (kp <= t) && (kp > tlo); };
                if (ua && ub) attn_pair<1, 1>(Kb, Vb, qf, fr, q, m_run, o5, o, rba, rbb, ma, mb, okA, okB);
                else if (ua) attn_pair<1, 0>(Kb, Vb, qf, fr, q, m_run, o5, o, rba, rbb, ma, mb, okA, okB);
                else attn_pair<0, 1>(Kb, Vb, qf, fr, q, m_run, o5, o, rba, rbb, ma, mb, okA, okB); } }
        if (nph != 2) ATT_PUT(tb ^ 1);
        if (cph == 0 && nph != 0) {
            const float lt = __shfl(o5[0], fr); const float sc = g1 / lt;
#pragma unroll
            for (int dt = 0; dt < 4; ++dt) { facc[dt] = facc[dt] + o[dt] * sc; o[dt] = (f32x4){0.f, 0.f, 0.f, 0.f}; }
            m_run = -1e4f; o5 = (f32x4){0.f, 0.f, 0.f, 0.f}; }
        __syncthreads();
        cph = nph; cja = nja; cjb = njb; tb ^= 1; ATT_NEXT();
    }
#undef ATT_NEXT
#undef ATT_PUT
    { const float lt = __shfl(o5[0], fr); const float sc = g2 / lt;
#pragma unroll
        for (int dt = 0; dt < 4; ++dt) facc[dt] = facc[dt] + o[dt] * sc; }
    if (!dry) {
#pragma unroll
    for (int dt = 0; dt < 4; ++dt) { v2u w; w.x = pk2(facc[dt].x, facc[dt].y); w.y = pk2(facc[dt].z, facc[dt].w);
        *(v2u*)(MIX + grow * DM + 512 + 64 * hh + 16 * dt + 4 * q) = w; } }
}

#define XB_TMO      128
#define XB_XCNT(j)  (256  + 64 * (j))
#define XB_XSUB(j)  (1280 + 64 * (j))
#define XB_XGEN(j)  (2304 + 64 * (j))
#define XB_TOP      3328
#define XB_TOPGEN   3392
#define XCD_BAR_WORDS 3456
#define XB_SPIN_CAP (1u << 18)

__device__ __forceinline__ unsigned xb_ld(unsigned* p)              { return __hip_atomic_load(p, __ATOMIC_RELAXED, __HIP_MEMORY_SCOPE_AGENT); }
__device__ __forceinline__ unsigned xb_add(unsigned* p, unsigned v) { return __hip_atomic_fetch_add(p, v, __ATOMIC_RELAXED, __HIP_MEMORY_SCOPE_AGENT); }
__device__ __forceinline__ unsigned xb_xcc_id() { return (unsigned)__builtin_amdgcn_s_getreg((3 << 11) | 20) & 0xFu; }
#define XB_SPIN(cond, bar) do { unsigned _sp = 0; while (cond) { __builtin_amdgcn_s_sleep(1); \
    if ((++_sp & 255u) == 0u) { if (xb_ld(&(bar)[XB_TMO])) break; if (_sp > XB_SPIN_CAP) { atomicAdd(&(bar)[XB_TMO], 1u); break; } } } } while (0)

struct XcdBarrier {
    unsigned* bar; unsigned x;
    volatile LAS unsigned* st;
};

__device__ __forceinline__ XcdBarrier xcd_barrier_post(unsigned* bar, volatile LAS unsigned* st) {
    XcdBarrier b; b.bar = bar; b.x = xb_xcc_id(); b.st = st;
    if (threadIdx.x == 0) (void)xb_add(&bar[XB_XCNT(b.x)], 1u);
    return b;
}
__device__ __forceinline__ void xcd_barrier_complete(unsigned* bar, unsigned x, unsigned& nloc, unsigned& nx) {
    const unsigned G = gridDim.x * gridDim.y * gridDim.z;
    unsigned sum, cnt, mine, sp = 0u;
    for (;;) {
        sum = 0u; cnt = 0u; mine = 0u;
#pragma unroll
        for (unsigned j = 0; j < 16; ++j) { const unsigned c = xb_ld(&bar[XB_XCNT(j)]); sum += c; cnt += (c > 0u) ? 1u : 0u; mine = (j == x) ? c : mine; }
        if (sum == G) break;
        __builtin_amdgcn_s_sleep(1);
        if ((++sp & 255u) == 0u) { if (xb_ld(&bar[XB_TMO])) break; if (sp > XB_SPIN_CAP) { atomicAdd(&bar[XB_TMO], 1u); break; } }
    }
    nloc = mine > 0u ? mine : 1u; nx = cnt > 0u ? cnt : 1u;
}

__device__ __forceinline__ void xcd_barrier(const XcdBarrier& b) {
    asm volatile("s_waitcnt vmcnt(0)" ::: "memory");
    __syncthreads();
    if (threadIdx.x == 0) {
        unsigned* bar = b.bar;
        __builtin_amdgcn_s_waitcnt(0);
        unsigned nloc = b.st[0], nx = b.st[1];
        if (nloc == 0u) { xcd_barrier_complete(bar, b.x, nloc, nx); b.st[0] = nloc; b.st[1] = nx; }
        const unsigned old = xb_add(&bar[XB_XSUB(b.x)], 1u);
        const unsigned gen = old / nloc;
        if (old + 1u == (gen + 1u) * nloc) {
            __builtin_amdgcn_fence(__ATOMIC_RELEASE, "agent");
            asm volatile("s_waitcnt vmcnt(0)" ::: "memory");
            const unsigned og = xb_add(&bar[XB_TOP], 1u);
            const unsigned tg = og / nx;
            if (og + 1u == (tg + 1u) * nx) xb_add(&bar[XB_TOPGEN], 1u);
            else XB_SPIN(xb_ld(&bar[XB_TOPGEN]) == tg, bar);
            __builtin_amdgcn_fence(__ATOMIC_ACQUIRE, "agent");
            xb_add(&bar[XB_XGEN(b.x)], 1u);
            asm volatile("s_waitcnt vmcnt(0)" ::: "memory");
        } else {
            XB_SPIN(xb_ld(&bar[XB_XGEN(b.x)]) == gen, bar);
            __builtin_amdgcn_fence(__ATOMIC_ACQUIRE, "agent");
            asm volatile("s_waitcnt vmcnt(0)" ::: "memory");
        }
    }
    __syncthreads();
}

#ifndef POSTBAR_SLEEP
#define POSTBAR_SLEEP do {} while (0)
#endif
#ifndef MIXD_NEW
#define MIXD_NEW 1
#endif
#ifndef MIXB_LNNEW
#define MIXB_LNNEW 1
#endif
#ifndef ATDRY
#define ATDRY 0
#endif
#ifndef ITREP
#define ITREP 0
#endif
#ifndef REPMASK
#define REPMASK 0
#endif
#ifndef PHSEL
#define PHSEL 0xfff
#endif
constexpr int N_PHASES = 1 + 8 * DEPTH;
__global__ void __launch_bounds__(NTHREADS) hybrid_fwd(Args KA) {
    extern __shared__ __attribute__((aligned(16))) unsigned char lds_raw[];
    LAS unsigned char* lds = (LAS unsigned char*)lds_raw;
    cg::grid_group grid = cg::this_grid();
    volatile LAS unsigned* MISC = (volatile LAS unsigned*)(lds + LDS_BYTES - 64);
    if (threadIdx.x < 16) MISC[threadIdx.x] = 0u;
    __syncthreads();
    const XcdBarrier bar = xcd_barrier_post((unsigned*)(KA.ws + WS_CTL), MISC);
#define SEAM(first) do { if (first) { __threadfence(); asm volatile("s_waitcnt vmcnt(0)" ::: "memory"); grid.sync(); __builtin_amdgcn_fence(__ATOMIC_ACQUIRE, "agent"); asm volatile("s_waitcnt vmcnt(0)" ::: "memory"); __syncthreads(); } else { xcd_barrier(bar); POSTBAR_SLEEP; } } while (0)
#if REPMASK
    for (int ph2 = 2 * KA.ph_lo; ph2 < 2 * KA.ph_hi; ++ph2) {
        const int ph = ph2 >> 1;
        if (ph2 & 1) { const int stx = (ph == 0) ? 8 : ((ph - 1) & 7); if (!(((REPMASK & ~0x90) >> stx) & 1) && !((REPMASK >> 9) & 1)) continue; }
        if (ph2 > 2 * KA.ph_lo) SEAM(ph2 == 2 * KA.ph_lo + 2);
        if (ph2 & 1) { const int stx = (ph == 0) ? 8 : ((ph - 1) & 7); if (!(((REPMASK & ~0x90) >> stx) & 1)) continue; }
#else
    for (int ph = KA.ph_lo; ph < KA.ph_hi; ++ph) {
        if (ph > KA.ph_lo) SEAM(ph == KA.ph_lo + 1);
#endif
        ArgP A = (ArgP)__builtin_amdgcn_kernarg_segment_ptr(); asm volatile("" : "+s"(A));
        int tid = threadIdx.x; asm volatile("" : "+v"(tid));
        int G = gridDim.x, bid = blockIdx.x; asm volatile("" : "+s"(G), "+s"(bid));
        const int ngw = G * NWAVES;
        const int lane = tid & 63, wave = __builtin_amdgcn_readfirstlane(tid >> 6), gw = bid * NWAVES + wave;
        unsigned char* ws = A->ws;
        bf16* H = (bf16*)(ws + WS_H); bf16* Zb = (bf16*)(ws + WS_Z); bf16* MIX = (bf16*)(ws + WS_MIX); bf16* HID = (bf16*)(ws + WS_HID); bf16* Y = (bf16*)(ws + WS_Y); float* R2 = (float*)(ws + WS_R2);
        if (ph == 0) {
#if PHSEL & 1
            LAS float* scr = (LAS float*)(lds + wave * 16384);
            for (int it = gw; it < DEPTH * TI_LAYER; it += ngw) prologue_item(A, it, scr, lane);
            for (int idx = bid * NTHREADS + tid; idx < DEPTH * 65536; idx += G * NTHREADS) { const int l = idx >> 16, rem = idx & 65535, tq = (rem >> 7) & 127, sq = rem & 127;
                ((bf16*)(ws + WS_W + (size_t)l * WS_WL + WO_SG))[rem] = (sq <= tq) ? (bf16)f2bf(A->in[I_SGW][idx]) : (bf16)0; }
            norm_first(A->in[I_X], H, R2, bid, G, wave, lane);
#endif
            continue;
        }
        const int l = (ph - 1) >> 3, st = (ph - 1) & 7;
        unsigned char* wl = ws + WS_W + (size_t)l * WS_WL;
        if (st == 0) {
#if PHSEL & 2
            pg8::Gemm g{H, (const bf16*)(wl + WO_IN), MROWS, ZC, DM}; pg8::StaticOrder S; S.init(MROWS, ZC, G, bid);
            pg8::EpiBf16RS E{Zb, ZC, R2 + (size_t)(2 * l) * MROWS};
            pg8::gemm_phase<pg8::EpiBf16RS, pg8::StaticOrder, PG8_ALIGN, PG8_SP2>(lds, g, S, E);
#endif
        } else if (st == 1) {
#if PHSEL & 4
            for (int it0 = bid; it0 < 1536 + (ITREP ? 512 : 0); it0 += G) {
                int it = it0; int tid_i = tid; ArgP A_i = A; asm volatile("" : "+v"(tid_i), "+s"(A_i));
                const int lane_i = tid_i & 63, wave_i = __builtin_amdgcn_readfirstlane(tid_i >> 6);
                if (it0 >= 1536) { const int e = it0 - 1536; if (ITREP == 1) { if (e >= 256) continue; it = e; } else if (ITREP == 2) it = 256 + e; else if (ITREP == 4) it = 768 + e; else { if (e >= 256) continue; it = 1280 + e; } }
                if (it < 256) {
#if PHSEL & 256
                    mixer_a(A_i, l, it, lds, tid_i, wave_i, lane_i);
#endif
                } else if (it < 768) {
#if PHSEL & 512
                    mixer_b(A_i, l, it - 256, lds, tid_i, wave_i, lane_i);
#endif
                } else if (it < 1280) {
#if PHSEL & 1024
                    mixer_d(A_i, l, it - 768, lds, tid_i, wave_i, lane_i);
#endif
                } else {
#if PHSEL & 2048
                    nsa_compress(A_i, l, it - 1280, lds, tid_i, wave_i, lane_i);
#endif
                }
            }
#endif
        } else if (st == 2) {
#if PHSEL & 8
            for (int it0 = bid; it0 < 1024 + (ATDRY ? 1024 : 0); it0 += G) { const int it = it0 & 1023; const int dry_ = (it0 >= 1024) ? ATDRY : 0; int tid_i = tid; ArgP A_i = A; asm volatile("" : "+v"(tid_i), "+s"(A_i));
                nsa_attn(A_i, l, it, lds, tid_i, __builtin_amdgcn_readfirstlane(tid_i >> 6), tid_i & 63, dry_); }
#endif
        } else if (st == 3 || st == 6) {
#if PHSEL & 16
            pg8::Gemm g{st == 3 ? MIX : HID, (const bf16*)(wl + (st == 3 ? WO_OUT : WO_DN)), MROWS, DM, st == 3 ? DM : FFH}; pg8::StaticOrder S; S.init(MROWS, DM, G, bid);
            pg8::EpiBf16<0> E{Y, DM, nullptr, 0, 0, 1.f};
            pg8::gemm_phase<pg8::EpiBf16<0>, pg8::StaticOrder, PG8_ALIGN, PG8_SP2>(lds, g, S, E);
#endif
        } else if (st == 4) {
#if PHSEL & 32
#if (REPMASK >> 4) & 1
            norm_bf<false>(H, HID, Y, A->in[I_GQM] + l * DM, (float*)(ws + WS_MIX), nullptr, bid, G, wave, lane);
#endif
            norm_bf<false>(H, H, Y, A->in[I_GQM] + l * DM, R2 + (size_t)(2 * l + 1) * MROWS, nullptr, bid, G, wave, lane);
#endif
        } else if (st == 5) {
#if PHSEL & 64
            pg8::Gemm g{H, (const bf16*)(wl + WO_GU), MROWS, 2 * FFH, DM}; pg8::StaticOrder S; S.init(MROWS, 2 * FFH, G, bid);
            pg8::EpiSwiGLU E{HID, FFH, R2 + (size_t)(2 * l + 1) * MROWS};
            pg8::gemm_phase<pg8::EpiSwiGLU, pg8::StaticOrder, PG8_ALIGN, PG8_SP2>(lds, g, S, E);
#endif
        } else {
#if PHSEL & 128
            const bool last = (l == DEPTH - 1);
#if (REPMASK >> 7) & 1
            norm_bf<false>(H, HID, Y, A->in[I_GQF] + l * DM, (float*)(ws + WS_MIX), nullptr, bid, G, wave, lane);
#endif
            if (last) norm_bf<true>(H, H, Y, A->in[I_GQF] + l * DM, nullptr, A->out, bid, G, wave, lane);
            else norm_bf<false>(H, H, Y, A->in[I_GQF] + l * DM, R2 + (size_t)(2 * l + 2) * MROWS, nullptr, bid, G, wave, lane);
#endif
        }
    }
}

#ifndef MK_MULTI
#define MK_MULTI 0
#endif
extern "C" void kernel_launch(void* const* d_in, const int* in_sizes, int n_in, void* d_out, int out_size, void* d_ws, size_t ws_size, hipStream_t stream) {
    static int grid = 0;
    if (grid == 0) {
        if (n_in != 26 || out_size != MROWS * DM || ws_size < WS_END) { fprintf(stderr, "kernel_launch: unexpected shapes (n_in %d out %d ws %zu)\n", n_in, out_size, ws_size); grid = -1; return; }
        int dev = 0, cus = 0, per_cu = 0;
        hipGetDevice(&dev); hipDeviceGetAttribute(&cus, hipDeviceAttributeMultiprocessorCount, dev);
        hipFuncSetAttribute((const void*)hybrid_fwd, hipFuncAttributeMaxDynamicSharedMemorySize, LDS_BYTES);
        hipOccupancyMaxActiveBlocksPerMultiprocessor(&per_cu, (const void*)hybrid_fwd, NTHREADS, LDS_BYTES);
        if (per_cu < 1) per_cu = 1;
        grid = cus * per_cu;
        (void)hipGetLastError();
    }
    if (grid < 0) return;
    Args a{};
    for (int i = 0; i < 26; ++i) a.in[i] = (const float*)d_in[i];
    a.out = (float*)d_out; a.ws = (unsigned char*)d_ws;
    if (hipMemsetAsync((char*)d_ws + WS_CTL, 0, CTL_BYTES, stream) != hipSuccess) { fprintf(stderr, "kernel_launch: memset of the barrier words failed\n"); return; }
#if MK_MULTI
    for (int ph = 0; ph < N_PHASES; ++ph) { a.ph_lo = ph; a.ph_hi = ph + 1; hipLaunchKernelGGL(hybrid_fwd, dim3(grid), dim3(NTHREADS), LDS_BYTES, stream, a); }
#else
    a.ph_lo = 0; a.ph_hi = N_PHASES;
    void* args[] = {&a};
    hipError_t e = hipLaunchCooperativeKernel((const void*)hybrid_fwd, dim3(grid), dim3(NTHREADS), args, LDS_BYTES, stream);
    if (e != hipSuccess) fprintf(stderr, "cooperative launch failed: %s (grid %d)\n", hipGetErrorString(e), grid);
#endif
}
```

```cpp
#include <hip/hip_runtime.h>
#include <hip/hip_cooperative_groups.h>
#include <cstdio>
#include <cstdint>
namespace cg = cooperative_groups;
namespace pg8 {
#define PG8_LAS __attribute__((address_space(3)))
typedef unsigned short bf16_t;
typedef short bf16x8 __attribute__((ext_vector_type(8)));
typedef float f32x4 __attribute__((ext_vector_type(4)));
typedef unsigned u32x4 __attribute__((ext_vector_type(4)));
constexpr int BM = 256, BK = 64, HALF = 128, HTB = HALF * BK * 2  , STAGE_BYTES = 8 * HTB, NXCD = 8, WGM = 8;

__host__ __device__ __forceinline__ int lds_byte(int r, int c) { const int st = (r >> 4) * 2 + (c >> 5), rr = r & 15, cc = c & 31, ob = rr * 64 + cc * 2; return st * 1024 + (ob ^ (((ob >> 9) & 1) << 5)); }
__host__ __device__ __forceinline__ void stage_rc(int b, int& R, int& C) { const int st = b / 1024, sb = b % 1024, swz = sb ^ (((sb >> 9) & 1) << 5); R = (st >> 1) * 16 + swz / 64; C = (st & 1) * 32 + (swz % 64) / 2; }
__host__ __device__ __forceinline__ int perm32(int rho) { const int n = rho >> 4, i = rho & 15; return 8 * (i >> 2) + 4 * n + (i & 3); }

struct Unit { int pm, pn; };
struct Gemm { const bf16_t* A; const bf16_t* Bt; int M, N, K; };

struct StaticOrder {
    int nM, nN, nwg, G, c;
    __host__ __device__ void init(int M, int N, int G_, int c_) { nM = M / BM; nN = N / BM; nwg = nM * nN; G = G_; c = c_; }
    __host__ __device__ bool next(int i, Unit& u) const {
        const long L = (long)i * G + c; if (L >= nwg) return false;
        int wgid = (int)L; { const int q = nwg / NXCD, r = nwg % NXCD, xcd = wgid % NXCD, off = wgid / NXCD; wgid = (xcd < r ? xcd * (q + 1) : r * (q + 1) + (xcd - r) * q) + off; }
        const int nig = WGM * nN, gid = wgid / nig, fm = gid * WGM, gsz = (nM - fm) < WGM ? (nM - fm) : WGM;
        u.pm = fm + ((wgid % nig) % gsz); u.pn = (wgid % nig) / gsz; return true;
    }
    __device__ __forceinline__ void a_ready(const Unit&) const {}
    __device__ __forceinline__ void done(const Unit&) const {}
};

__device__ __forceinline__ unsigned cvt_pk_bf16(float lo, float hi) { unsigned r; asm volatile("v_cvt_pk_bf16_f32 %0, %1, %2" : "=v"(r) : "v"(lo), "v"(hi)); return r; }
typedef float f32x2 __attribute__((ext_vector_type(2)));
__device__ __forceinline__ f32x2 gelu_pk(f32x2 v) {
    const f32x2 av = __builtin_elementwise_abs(v), d = av * 0.2316418882f + 1.0f;
    f32x2 t; t.x = __builtin_amdgcn_rcpf(d.x); t.y = __builtin_amdgcn_rcpf(d.y);
    f32x2 q = t * 0.5307027145f + (-0.7265760135f); q = q * t + 0.7107068705f; q = q * t + (-0.142248368f); q = q * t + 0.127414796f; q = q * t;
    const f32x2 s = (v * v) * (-0.72134752044f);
    f32x2 e; e.x = __builtin_amdgcn_exp2f(s.x); e.y = __builtin_amdgcn_exp2f(s.y);
    const f32x2 m = v * (q * e), r = v - m;
    f32x2 o; o.x = v.x < 0.f ? m.x : r.x; o.y = v.y < 0.f ? m.y : r.y; return o;
}

template <int ACT  > struct EpiBf16 {
    static constexpr bool PERM = true, AFTER_DRAIN = false; static_assert(ACT == 0 || ACT == 1, "EpiBf16: ACT is 0 (none) or 1 (gelu_pk)");
    bf16_t* O; int ldc; const float* bias; int split_cols; size_t split_stride; float scale0;
    __device__ __forceinline__ void operator()(const f32x4 (&acc)[2][2][4][2], const Unit& u, int wr, int wc, int fr, int fq) const {
        const int row0 = u.pm * BM + wr * 64 + fr; int colt = u.pn * BM; bf16_t* base = O;
        float sc = 1.f; if (split_cols) { const int t = colt / split_cols; base += (size_t)t * split_stride; colt -= t * split_cols; if (t == 0) sc = scale0; }
        const int col0 = colt + wc * 32 + 8 * fq, bcol0 = u.pn * BM + wc * 32 + 8 * fq;
        f32x4 bv[2][2];
#pragma unroll
        for (int bj = 0; bj < 2; ++bj)
#pragma unroll
            for (int n = 0; n < 2; ++n) bv[bj][n] = bias ? *(const f32x4*)(bias + bcol0 + bj * HALF + 4 * n) : (f32x4){0.f, 0.f, 0.f, 0.f};
#pragma unroll
        for (int ai = 0; ai < 2; ++ai)
#pragma unroll
            for (int m = 0; m < 4; ++m) { bf16_t* rowp = base + (size_t)(row0 + ai * HALF + m * 16) * ldc + col0;
#pragma unroll
                for (int bj = 0; bj < 2; ++bj) { f32x4 v0 = acc[ai][bj][m][0] + bv[bj][0], v1 = acc[ai][bj][m][1] + bv[bj][1];
                    if (ACT == 1) { f32x2 a = gelu_pk((f32x2){v0[0], v0[1]}), b = gelu_pk((f32x2){v0[2], v0[3]}), c = gelu_pk((f32x2){v1[0], v1[1]}), d = gelu_pk((f32x2){v1[2], v1[3]});
                        v0 = (f32x4){a.x, a.y, b.x, b.y}; v1 = (f32x4){c.x, c.y, d.x, d.y}; }
                    v0 = v0 * sc; v1 = v1 * sc; u32x4 w; w.x = cvt_pk_bf16(v0[0], v0[1]); w.y = cvt_pk_bf16(v0[2], v0[3]); w.z = cvt_pk_bf16(v1[0], v1[1]); w.w = cvt_pk_bf16(v1[2], v1[3]);
                    *(u32x4*)(rowp + bj * HALF) = w; } }
    }
};
struct EpiF32 {
    static constexpr bool PERM = false, AFTER_DRAIN = false;
    float* O; int ldc;
    __device__ __forceinline__ void operator()(const f32x4 (&acc)[2][2][4][2], const Unit& u, int wr, int wc, int fr, int fq) const {
        const int row0 = u.pm * BM + wr * 64 + fr, col0 = u.pn * BM + wc * 32 + 4 * fq;
#pragma unroll
        for (int ai = 0; ai < 2; ++ai)
#pragma unroll
            for (int m = 0; m < 4; ++m) { float* rowp = O + (size_t)(row0 + ai * HALF + m * 16) * ldc + col0;
#pragma unroll
                for (int bj = 0; bj < 2; ++bj)
#pragma unroll
                    for (int n = 0; n < 2; ++n) *(f32x4*)(rowp + bj * HALF + n * 16) = acc[ai][bj][m][n]; }
    }
};
struct EpiSwiGLU {
    static constexpr bool PERM = true, AFTER_DRAIN = false;
    bf16_t* O; int ldc; const float* rs;
    __device__ __forceinline__ void operator()(const f32x4 (&acc)[2][2][4][2], const Unit& u, int wr, int wc, int fr, int fq) const {
        const int row0 = u.pm * BM + wr * 64 + fr, col0 = u.pn * HALF + wc * 32 + 8 * fq;
#pragma unroll
        for (int ai = 0; ai < 2; ++ai)
#pragma unroll
            for (int m = 0; m < 4; ++m) { bf16_t* rowp = O + (size_t)(row0 + ai * HALF + m * 16) * ldc + col0;
                const float r = rs[row0 + ai * HALF + m * 16];
                float h[8];
#pragma unroll
                for (int n = 0; n < 2; ++n)
#pragma unroll
                    for (int e = 0; e < 4; ++e) { const float g = acc[ai][0][m][n][e] * r, up = acc[ai][1][m][n][e] * r;
                        h[n * 4 + e] = g * __builtin_amdgcn_rcpf(1.0f + __builtin_amdgcn_exp2f(-1.4426950408889634f * g)) * up; }
                u32x4 w; w.x = cvt_pk_bf16(h[0], h[1]); w.y = cvt_pk_bf16(h[2], h[3]); w.z = cvt_pk_bf16(h[4], h[5]); w.w = cvt_pk_bf16(h[6], h[7]);
                *(u32x4*)rowp = w; }
    }
};
struct EpiBf16RS {
    static constexpr bool PERM = true, AFTER_DRAIN = false;
    bf16_t* O; int ldc; const float* rs;
    __device__ __forceinline__ void operator()(const f32x4 (&acc)[2][2][4][2], const Unit& u, int wr, int wc, int fr, int fq) const {
        const int row0 = u.pm * BM + wr * 64 + fr, col0 = u.pn * BM + wc * 32 + 8 * fq;
#pragma unroll
        for (int ai = 0; ai < 2; ++ai)
#pragma unroll
            for (int m = 0; m < 4; ++m) { bf16_t* rowp = O + (size_t)(row0 + ai * HALF + m * 16) * ldc + col0; const float r = rs[row0 + ai * HALF + m * 16];
#pragma unroll
                for (int bj = 0; bj < 2; ++bj) { const f32x4 v0 = acc[ai][bj][m][0] * r, v1 = acc[ai][bj][m][1] * r;
                    u32x4 w; w.x = cvt_pk_bf16(v0[0], v0[1]); w.y = cvt_pk_bf16(v0[2], v0[3]); w.z = cvt_pk_bf16(v1[0], v1[1]); w.w = cvt_pk_bf16(v1[2], v1[3]);
                    *(u32x4*)(rowp + bj * HALF) = w; } }
    }
};
template <class Epi, class Sched, bool ALIGN_EPI = false, bool SP2 = false>
__device__ __forceinline__ void gemm_phase(PG8_LAS unsigned char* lds, const Gemm g, const Sched& S, const Epi& E) {
    int tid_l = threadIdx.x; asm volatile("" : "+v"(tid_l));
    const int tid = tid_l, wid = __builtin_amdgcn_readfirstlane(tid >> 6), lane = tid & 63, wr = wid >> 2, wc = wid & 3, fr = lane & 15, fq = lane >> 4;
    const int K = g.K, nt = K / BK;
    unsigned voffA[2], voffB[2];
#pragma unroll
    for (int i = 0; i < 2; ++i) { int R, C; stage_rc(tid * 16 + i * 8192, R, C); const int Rb = Epi::PERM ? ((R & ~31) + perm32(R & 31)) : R;
        voffA[i] = (unsigned)(R * K + C) * 2u; voffB[i] = (unsigned)(Rb * K + C) * 2u; }
    const size_t kstep = (size_t)(BK * 2);
    const size_t hstep = (size_t)HALF * K * 2;
    const size_t tstep = 2 * hstep;
    const unsigned ldsw = (unsigned)wid * 1024u;
    const int aoff = lds_byte(wr * 64 + fr, fq * 8), boff = lds_byte(wc * 32 + fr, fq * 8);
#define PG8_SA(b, h) (((b) * 2 + (h)) * HTB)
#define PG8_SB(b, h) ((4 + (b) * 2 + (h)) * HTB)
#define PG8_STAGE(bufoff, gbase, voff) do { _Pragma("unroll") for (int _i = 0; _i < 2; ++_i) \
        __builtin_amdgcn_global_load_lds((const unsigned*)((const char*)(gbase) + (voff)[_i]), (PG8_LAS unsigned*)(lds + (bufoff) + ldsw + _i * 8192), 16, 0, 0); } while (0)
#define PG8_LDA(dst, b, h) do { _Pragma("unroll") for (int m = 0; m < 4; ++m) _Pragma("unroll") for (int k = 0; k < 2; ++k) dst[m][k] = *(const PG8_LAS bf16x8*)(lds + PG8_SA(b, h) + aoff + m * 2048 + k * 1024); } while (0)
#define PG8_LDB(dst, b, h) do { _Pragma("unroll") for (int n = 0; n < 2; ++n) _Pragma("unroll") for (int k = 0; k < 2; ++k) dst[n][k] = *(const PG8_LAS bf16x8*)(lds + PG8_SB(b, h) + boff + n * 2048 + k * 1024); } while (0)
#define PG8_MMA(ai, bj, At, Bt) do { __builtin_amdgcn_s_setprio(1); _Pragma("unroll") for (int m = 0; m < 4; ++m) _Pragma("unroll") for (int n = 0; n < 2; ++n) _Pragma("unroll") for (int k = 0; k < 2; ++k) \
        acc[ai][bj][m][n] = __builtin_amdgcn_mfma_f32_16x16x32_bf16(Bt[n][k], At[m][k], acc[ai][bj][m][n], 0, 0, 0); __builtin_amdgcn_s_setprio(0); } while (0)
#define PG8_WAIT_V(n) asm volatile("s_waitcnt vmcnt(" #n ")" ::: "memory")
#define PG8_WAIT_L(n) asm volatile("s_waitcnt lgkmcnt(" #n ")" ::: "memory")
#define PG8_BAR __builtin_amdgcn_s_barrier()
#define PG8_SCHED __builtin_amdgcn_sched_barrier(0)
    Unit cur, nxt; int ui = 0;
    if (!S.next(0, cur)) return;
    f32x4 acc[2][2][4][2];
#pragma unroll
    for (int a = 0; a < 2; ++a)
#pragma unroll
        for (int b = 0; b < 2; ++b)
#pragma unroll
            for (int m = 0; m < 4; ++m)
#pragma unroll
                for (int n = 0; n < 2; ++n) acc[a][b][m][n] = (f32x4){0.f, 0.f, 0.f, 0.f};
    bf16x8 At[4][2], B0[2][2], B1[2][2];
    const char* cA = (const char*)g.A + (size_t)cur.pm * tstep; const char* cB = (const char*)g.Bt + (size_t)cur.pn * tstep;
    S.a_ready(cur);
    if constexpr (SP2) {
        PG8_STAGE(PG8_SB(0, 0), cB, voffB); PG8_STAGE(PG8_SB(0, 1), cB + hstep, voffB); PG8_STAGE(PG8_SA(0, 0), cA, voffA); PG8_STAGE(PG8_SA(0, 1), cA + hstep, voffA);
        if (wr == 1) PG8_BAR;
        PG8_WAIT_V(2); PG8_BAR;
        PG8_STAGE(PG8_SB(1, 0), cB + kstep, voffB); PG8_STAGE(PG8_SA(1, 0), cA + kstep, voffA); PG8_STAGE(PG8_SB(1, 1), cB + hstep + kstep, voffB);
        PG8_WAIT_V(6); PG8_BAR;
    } else {
        PG8_STAGE(PG8_SB(0, 0), cB, voffB); PG8_STAGE(PG8_SA(0, 0), cA, voffA); PG8_STAGE(PG8_SB(0, 1), cB + hstep, voffB); PG8_STAGE(PG8_SA(0, 1), cA + hstep, voffA);
        if (wr == 1) PG8_BAR;
        PG8_WAIT_V(4); PG8_BAR;
        PG8_STAGE(PG8_SB(1, 0), cB + kstep, voffB); PG8_STAGE(PG8_SA(1, 0), cA + kstep, voffA); PG8_STAGE(PG8_SB(1, 1), cB + hstep + kstep, voffB);
        PG8_WAIT_V(6); PG8_BAR;
    }
    for (;;) {
        const bool has_next = S.next(ui + 1, nxt);
        const char* nA = has_next ? (const char*)g.A + (size_t)nxt.pm * tstep : cA; const char* nB = has_next ? (const char*)g.Bt + (size_t)nxt.pn * tstep : cB;
        for (int t = 0; t < nt; t += 2) {
            const bool last = (t == nt - 2);
            const char* a1 = cA + (size_t)(t + 1) * kstep;
            const char* a2 = last ? nA : cA + (size_t)(t + 2) * kstep; const char* b2 = last ? nB : cB + (size_t)(t + 2) * kstep;
            const char* a3 = a2 + kstep; const char* b3 = b2 + kstep;
            if (last && has_next) S.a_ready(nxt);
            if constexpr (SP2) {
            PG8_LDB(B0, 0, 0); PG8_LDB(B1, 0, 1); PG8_SCHED; PG8_LDA(At, 0, 0); PG8_STAGE(PG8_SA(1, 1), a1 + hstep, voffA);
            PG8_WAIT_V(8); PG8_WAIT_L(0); PG8_BAR; PG8_MMA(0, 0, At, B0); PG8_MMA(0, 1, At, B1); PG8_BAR; PG8_SCHED;
            PG8_LDA(At, 0, 1); PG8_STAGE(PG8_SB(0, 0), b2, voffB); PG8_STAGE(PG8_SB(0, 1), b2 + hstep, voffB); PG8_STAGE(PG8_SA(0, 0), a2, voffA);
            PG8_WAIT_V(8); PG8_WAIT_L(0); PG8_BAR; PG8_MMA(1, 0, At, B0); PG8_MMA(1, 1, At, B1); PG8_BAR; PG8_SCHED;
            PG8_LDB(B0, 1, 0); PG8_LDB(B1, 1, 1); PG8_SCHED; PG8_LDA(At, 1, 0); PG8_STAGE(PG8_SA(0, 1), a2 + hstep, voffA);
            PG8_WAIT_V(8); PG8_WAIT_L(0); PG8_BAR; PG8_MMA(0, 0, At, B0); PG8_MMA(0, 1, At, B1); PG8_BAR; PG8_SCHED;
            PG8_LDA(At, 1, 1); PG8_STAGE(PG8_SB(1, 0), b3, voffB); PG8_STAGE(PG8_SB(1, 1), b3 + hstep, voffB); PG8_STAGE(PG8_SA(1, 0), a3, voffA);
            PG8_WAIT_V(8); PG8_WAIT_L(0); PG8_BAR; PG8_MMA(1, 0, At, B0); PG8_MMA(1, 1, At, B1); PG8_BAR; PG8_SCHED;
            } else {
            PG8_LDB(B0, 0, 0); PG8_SCHED; PG8_LDA(At, 0, 0); PG8_STAGE(PG8_SA(1, 1), a1 + hstep, voffA);
            PG8_WAIT_L(8); PG8_BAR; PG8_WAIT_L(0); PG8_MMA(0, 0, At, B0); PG8_BAR; PG8_SCHED;
            PG8_LDB(B1, 0, 1); PG8_STAGE(PG8_SB(0, 0), b2, voffB);
            PG8_BAR; PG8_WAIT_L(0); PG8_MMA(0, 1, At, B1); PG8_BAR;
            PG8_LDA(At, 0, 1); PG8_STAGE(PG8_SA(0, 0), a2, voffA);
            PG8_BAR; PG8_WAIT_L(0); PG8_MMA(1, 0, At, B0); PG8_BAR; PG8_SCHED;
            PG8_STAGE(PG8_SB(0, 1), b2 + hstep, voffB);
            PG8_WAIT_V(6); PG8_BAR; PG8_MMA(1, 1, At, B1); PG8_BAR;
            PG8_LDB(B0, 1, 0); PG8_SCHED; PG8_LDA(At, 1, 0); PG8_STAGE(PG8_SA(0, 1), a2 + hstep, voffA);
            PG8_WAIT_L(8); PG8_BAR; PG8_WAIT_L(0); PG8_MMA(0, 0, At, B0); PG8_BAR; PG8_SCHED;
            PG8_LDB(B1, 1, 1); PG8_STAGE(PG8_SB(1, 0), b3, voffB);
            PG8_BAR; PG8_WAIT_L(0); PG8_MMA(0, 1, At, B1); PG8_BAR;
            PG8_LDA(At, 1, 1); PG8_STAGE(PG8_SA(1, 0), a3, voffA);
            PG8_BAR; PG8_WAIT_L(0); PG8_MMA(1, 0, At, B0); PG8_BAR; PG8_SCHED;
            PG8_STAGE(PG8_SB(1, 1), b3 + hstep, voffB);
            PG8_WAIT_V(6); PG8_BAR; PG8_MMA(1, 1, At, B1); PG8_BAR;
            }
        }
        if constexpr (ALIGN_EPI) { if (wr == 0) PG8_BAR; }
        if constexpr (!Epi::AFTER_DRAIN) { E(acc, cur, wr, wc, fr, fq); S.done(cur); }
        if (!has_next) break;
#pragma unroll
        for (int a = 0; a < 2; ++a)
#pragma unroll
            for (int b = 0; b < 2; ++b)
#pragma unroll
                for (int m = 0; m < 4; ++m)
#pragma unroll
                    for (int n = 0; n < 2; ++n) acc[a][b][m][n] = (f32x4){0.f, 0.f, 0.f, 0.f};
        cur = nxt; cA = nA; cB = nB; ++ui;
        if constexpr (ALIGN_EPI) { if (wr == 1) PG8_BAR; }
    }
    PG8_WAIT_V(0);
    if constexpr (!ALIGN_EPI) { if (wr == 0) PG8_BAR; }
    PG8_BAR;
    if constexpr (Epi::AFTER_DRAIN) { E.fused(acc, cur, wr, wc, fr, fq, lds, wid, lane); S.done(cur); }
#undef PG8_SA
#undef PG8_SB
#undef PG8_STAGE
#undef PG8_LDA
#undef PG8_LDB
#undef PG8_MMA
#undef PG8_WAIT_V
#undef PG8_WAIT_L
#undef PG8_BAR
#undef PG8_SCHED
}
}

#ifndef PG8_SP2
#define PG8_SP2 true
#endif
#ifndef PG8_ALIGN
#define PG8_ALIGN true
#endif

#define LAS __attribute__((address_space(3)))
typedef unsigned short bf16;
typedef unsigned v4u __attribute__((ext_vector_type(4)));
typedef unsigned v2u __attribute__((ext_vector_type(2)));
typedef float f32x4 __attribute__((ext_vector_type(4)));
typedef short bf16x8 __attribute__((ext_vector_type(8)));

constexpr int DM = 1024, NBATCH = 16, SEQ = 2048, DEPTH = 4, MROWS = NBATCH * SEQ, INC = 1932, ZC = 2048, FFH = 2816;
constexpr int NTHREADS = 512, NWAVES = 8;
constexpr int LDS_BYTES = 147456;
constexpr int ZC_AU = 0, ZC_AV = 256, ZC_BA = 512, ZC_BG = 768, ZC_Q = 1024, ZC_KC = 1280, ZC_VC = 1344, ZC_KS = 1408, ZC_VS = 1472, ZC_KW = 1536, ZC_VW = 1600, ZC_D = 1664, ZC_G = 1920;
constexpr size_t MiB = 1u << 20;
constexpr size_t WS_CTL = 0, CTL_BYTES = 16384;
constexpr size_t WS_W = 1 * MiB, WS_WL = 24 * MiB;
constexpr size_t WO_IN = 0, WO_OUT = 4 * MiB, WO_GU = 6 * MiB, WO_DN = 17 * MiB, WO_SG = 23 * MiB - 512 * 1024, WO_PW = WO_SG + 131072, WO_POOL = WO_PW + 131072, WO_W1K = WO_POOL + 32768, WO_W1V = WO_W1K + 262144;
static_assert(WO_DN + (size_t)1024 * 2816 * 2 <= WO_SG && WO_W1V + 262144 <= WS_WL, "weight map");
constexpr size_t WS_H = 98 * MiB, WS_Z = 162 * MiB, WS_MIX = 290 * MiB, WS_HID = 162 * MiB, WS_Y = 354 * MiB;
constexpr size_t WS_VTS = 482 * MiB, WS_VTW = 486 * MiB, WS_KC = 490 * MiB, WS_VCT = 490 * MiB + 262144, WS_R2 = 491 * MiB, WS_END = 493 * MiB;
static_assert(WS_HID + (size_t)MROWS * FFH * 2 <= WS_Y, "hid overlay");

#define LDS_WAIT() asm volatile("s_waitcnt lgkmcnt(0)" ::: "memory")
__device__ __forceinline__ float bflo(unsigned w) { return __uint_as_float(w << 16); }
__device__ __forceinline__ float bfhi(unsigned w) { return __uint_as_float(w & 0xffff0000u); }
__device__ __forceinline__ float bf2f(bf16 v) { return __uint_as_float((unsigned)v << 16); }
__device__ __forceinline__ unsigned f2bf(float f) { unsigned u = __float_as_uint(f); return (u + 0x7fffu + ((u >> 16) & 1u)) >> 16; }
__device__ __forceinline__ unsigned pk2(float lo, float hi) { unsigned r; asm("v_cvt_pk_bf16_f32 %0, %1, %2" : "=v"(r) : "v"(lo), "v"(hi)); return r; }
__device__ __forceinline__ float sigmoidf_(float x) { return __builtin_amdgcn_rcpf(1.0f + __builtin_amdgcn_exp2f(-1.4426950408889634f * x)); }
__device__ __forceinline__ float siluf_(float x) { return x * sigmoidf_(x); }
__device__ __forceinline__ float wave_sum(float v) {
#pragma unroll
    for (int o = 1; o < 64; o <<= 1) v += __shfl_xor(v, o);
    return v;
}
__device__ __forceinline__ f32x4 mfma16(v4u a, v4u b, f32x4 c) {
    return __builtin_amdgcn_mfma_f32_16x16x32_bf16(__builtin_bit_cast(bf16x8, a), __builtin_bit_cast(bf16x8, b), c, 0, 0, 0);
}

struct Args { const float* in[26]; float* out; unsigned char* ws; int ph_lo, ph_hi; };
typedef const __attribute__((address_space(4))) Args* ArgP;
enum { I_X = 0, I_GPM, I_GQM, I_GPF, I_GQF, I_WIN, I_SGLN, I_SGW, I_SGB, I_CVW, I_CVB, I_CVLG, I_CVLB, I_CVPW, I_CVPB, I_POSK, I_POSV, I_W1K, I_W2K, I_W1V, I_W2V, I_POOLW, I_POOLS, I_WOUT, I_GU, I_DN };

__device__ __forceinline__ void tr_item(const float* __restrict__ src, int Nsrc, int K, bf16* dst, int k0, int n0d, int nsrc0, int nvalid, LAS float* scr, int lane, const float* gk = nullptr) {
    const int kk8 = lane >> 3, n4 = (lane & 7) * 4; const bool ok = n4 < nvalid;
#pragma unroll
    for (int i = 0; i < 8; ++i) { const int kk = 8 * i + kk8; f32x4 v = (f32x4){0.f, 0.f, 0.f, 0.f};
        if (ok) { v = *(const f32x4*)(src + (size_t)(k0 + kk) * Nsrc + nsrc0 + n4); if (gk) v = v * gk[k0 + kk]; }
        LAS float* sp = scr + kk * 33 + n4; sp[0] = v.x; sp[1] = v.y; sp[2] = v.z; sp[3] = v.w; }
    LDS_WAIT();
    const int c = lane & 7;
#pragma unroll
    for (int j = 0; j < 4; ++j) { const int n = (lane >> 3) + 8 * j; const LAS float* s = scr + (8 * c) * 33 + n;
        v4u o; o.x = pk2(s[0 * 33], s[1 * 33]); o.y = pk2(s[2 * 33], s[3 * 33]); o.z = pk2(s[4 * 33], s[5 * 33]); o.w = pk2(s[6 * 33], s[7 * 33]);
        *(v4u*)(dst + (size_t)(n0d + n) * K + k0 + 8 * c) = o; }
    LDS_WAIT();
}
constexpr int TI_IN = 1024, TI_OUT = 512, TI_GU = 2816, TI_DN = 1408, TI_PW = 32, TI_POOL = 8, TI_W1 = 64;
constexpr int TI_LAYER = TI_IN + TI_OUT + TI_GU + TI_DN + TI_PW + TI_POOL + 2 * TI_W1;

__device__ __forceinline__ void prologue_item(ArgP A, int it, LAS float* scr, int lane) {
    const int l = it / TI_LAYER; int r = it % TI_LAYER;
    unsigned char* wl = A->ws + WS_W + (size_t)l * WS_WL;
    if (r < TI_IN) { const int kb = r >> 6, nb = r & 63, n0d = 32 * nb; int ns = n0d, nv = 32;
        if (n0d >= ZC_D && n0d < ZC_G) ns = n0d + 12; else if (n0d == ZC_G) { ns = 1664; nv = 12; } else if (n0d > ZC_G) { ns = 0; nv = 0; }
        tr_item(A->in[I_WIN] + (size_t)l * DM * INC, INC, DM, (bf16*)(wl + WO_IN), 64 * kb, n0d, ns, nv, scr, lane, A->in[I_GPM] + l * DM); return; }
    r -= TI_IN;
    if (r < TI_OUT) { const int kb = r >> 5, nb = r & 31;
        tr_item(A->in[I_WOUT] + (size_t)l * DM * DM, DM, DM, (bf16*)(wl + WO_OUT), 64 * kb, 32 * nb, 32 * nb, 32, scr, lane); return; }
    r -= TI_OUT;
    if (r < TI_GU) { const int kb = r / 176, nb = r % 176, n0d = 32 * nb, pn = n0d >> 8, bj = (n0d >> 7) & 1, i0 = n0d & 127;
        tr_item(A->in[I_GU] + (size_t)l * DM * 2 * FFH, 2 * FFH, DM, (bf16*)(wl + WO_GU), 64 * kb, n0d, bj * FFH + 128 * pn + i0, 32, scr, lane, A->in[I_GPF] + l * DM); return; }
    r -= TI_GU;
    if (r < TI_DN) { const int kb = r >> 5, nb = r & 31;
        tr_item(A->in[I_DN] + (size_t)l * FFH * DM, DM, FFH, (bf16*)(wl + WO_DN), 64 * kb, 32 * nb, 32 * nb, 32, scr, lane); return; }
    r -= TI_DN;
    if (r < TI_PW) { const int kb = r >> 3, nb = r & 7;
        tr_item(A->in[I_CVPW] + (size_t)l * 65536, 256, 256, (bf16*)(wl + WO_PW), 64 * kb, 32 * nb, 32 * nb, 32, scr, lane); return; }
    r -= TI_PW;
    if (r < TI_POOL) { const int g = r >> 1, nb = r & 1;
        tr_item(A->in[I_POOLW] + (size_t)l * 16384 + g * 4096, 64, 64, (bf16*)(wl + WO_POOL) + g * 4096, 0, 32 * nb, 32 * nb, 32, scr, lane); return; }
    r -= TI_POOL;
    if (r < TI_W1) { const int kb = r >> 1, nb = r & 1;
        tr_item(A->in[I_W1K] + (size_t)l * 131072, 64, 2048, (bf16*)(wl + WO_W1K), 64 * kb, 32 * nb, 32 * nb, 32, scr, lane); return; }
    r -= TI_W1;
    { const int kb = r >> 1, nb = r & 1;
        tr_item(A->in[I_W1V] + (size_t)l * 131072, 64, 2048, (bf16*)(wl + WO_W1V), 64 * kb, 32 * nb, 32 * nb, 32, scr, lane); }
}

struct NRow { f32x4 x[4], y[4]; };
template <bool HASY>
__device__ __forceinline__ void nr_load(NRow& r, const float* xin, const float* y, int m, int lane) {
    const f32x4* xr = (const f32x4*)(xin + (size_t)m * DM) + lane;
#pragma unroll
    for (int j = 0; j < 4; ++j) r.x[j] = xr[64 * j];
    if (HASY) { const f32x4* yr = (const f32x4*)(y + (size_t)m * DM) + lane;
#pragma unroll
        for (int j = 0; j < 4; ++j) r.y[j] = yr[64 * j]; }
}
template <bool HASY, bool HASH>
__device__ __forceinline__ void nr_proc(NRow& r, const float* g1, float* xout, const float* g2, bf16* Hout, int m, int lane) {
    if (HASY) { float ss = 0.f;
#pragma unroll
        for (int j = 0; j < 4; ++j) ss += (r.y[j].x * r.y[j].x + r.y[j].y * r.y[j].y) + (r.y[j].z * r.y[j].z + r.y[j].w * r.y[j].w);
        const float rr = 1.0f / sqrtf(wave_sum(ss) * (1.0f / DM) + 1e-6f);
        f32x4* xo = (f32x4*)(xout + (size_t)m * DM) + lane;
#pragma unroll
        for (int j = 0; j < 4; ++j) { const f32x4 g = ((const f32x4*)g1)[lane + 64 * j]; r.x[j] = r.x[j] + (r.y[j] * rr) * g; xo[64 * j] = r.x[j]; } }
    if (HASH) { float ss = 0.f;
#pragma unroll
        for (int j = 0; j < 4; ++j) ss += (r.x[j].x * r.x[j].x + r.x[j].y * r.x[j].y) + (r.x[j].z * r.x[j].z + r.x[j].w * r.x[j].w);
        const float rr = 1.0f / sqrtf(wave_sum(ss) * (1.0f / DM) + 1e-6f);
        v2u* ho = (v2u*)(Hout + (size_t)m * DM) + lane;
#pragma unroll
        for (int j = 0; j < 4; ++j) { const f32x4 g = ((const f32x4*)g2)[lane + 64 * j]; const f32x4 o = (r.x[j] * rr) * g; v2u w; w.x = pk2(o.x, o.y); w.y = pk2(o.z, o.w); ho[64 * j] = w; } }
}
template <bool HASY, bool HASH>
__device__ __forceinline__ void norm_rows(const float* xin, const float* y, const float* g1, float* xout, const float* g2, bf16* Hout, int gw, int ngw, int lane) {
    if ((MROWS % (2 * ngw)) == 0) {
        for (int m = gw; m < MROWS; m += 2 * ngw) {
            NRow ra, rb;
            nr_load<HASY>(ra, xin, y, m, lane); nr_load<HASY>(rb, xin, y, m + ngw, lane);
            nr_proc<HASY, HASH>(ra, g1, xout, g2, Hout, m, lane); nr_proc<HASY, HASH>(rb, g1, xout, g2, Hout, m + ngw, lane);
        }
    } else {
        for (int m = gw; m < MROWS; m += ngw) { NRow ra; nr_load<HASY>(ra, xin, y, m, lane); nr_proc<HASY, HASH>(ra, g1, xout, g2, Hout, m, lane); }
    }
}

__device__ __forceinline__ void norm_first(const float* xin, bf16* XB, float* R2, int bid, int G, int wave, int lane) {
    for (int c = bid; c < MROWS / 32; c += G)
        for (int i = 0; i < 4; ++i) { const int m = 32 * c + wave + 8 * i;
            const f32x4* xr = (const f32x4*)(xin + (size_t)m * DM) + lane; f32x4 xv[4]; float ss = 0.f;
#pragma unroll
            for (int j = 0; j < 4; ++j) { xv[j] = xr[64 * j]; ss += (xv[j].x * xv[j].x + xv[j].y * xv[j].y) + (xv[j].z * xv[j].z + xv[j].w * xv[j].w); }
            const float r = 1.0f / sqrtf(wave_sum(ss) * (1.0f / DM) + 1e-6f);
            if (lane == 0) R2[m] = r;
            v2u* ho = (v2u*)(XB + (size_t)m * DM) + lane;
#pragma unroll
            for (int j = 0; j < 4; ++j) { v2u w; w.x = pk2(xv[j].x, xv[j].y); w.y = pk2(xv[j].z, xv[j].w); ho[64 * j] = w; }
        }
}
template <bool LAST, int NR>
__device__ __forceinline__ void norm_bf_rows(const bf16* XB, bf16* XO, const bf16* Yb, const f32x4 (&g)[2][2], float* R2, float* out, int m0, int ngw, int lane) {
    v4u xw[NR][2], yw[NR][2];
#pragma unroll
    for (int r = 0; r < NR; ++r)
#pragma unroll
        for (int j = 0; j < 2; ++j) { const size_t o = (size_t)(m0 + r * ngw) * DM + 8 * lane + 512 * j; xw[r][j] = *(const v4u*)(XB + o); yw[r][j] = *(const v4u*)(Yb + o); }
#pragma unroll
    for (int r = 0; r < NR; ++r) { const int m = m0 + r * ngw;
        float xv[2][8], yv[2][8]; float ss = 0.f;
#pragma unroll
        for (int j = 0; j < 2; ++j) {
            xv[j][0] = bflo(xw[r][j].x); xv[j][1] = bfhi(xw[r][j].x); xv[j][2] = bflo(xw[r][j].y); xv[j][3] = bfhi(xw[r][j].y); xv[j][4] = bflo(xw[r][j].z); xv[j][5] = bfhi(xw[r][j].z); xv[j][6] = bflo(xw[r][j].w); xv[j][7] = bfhi(xw[r][j].w);
            yv[j][0] = bflo(yw[r][j].x); yv[j][1] = bfhi(yw[r][j].x); yv[j][2] = bflo(yw[r][j].y); yv[j][3] = bfhi(yw[r][j].y); yv[j][4] = bflo(yw[r][j].z); yv[j][5] = bfhi(yw[r][j].z); yv[j][6] = bflo(yw[r][j].w); yv[j][7] = bfhi(yw[r][j].w);
#pragma unroll
            for (int e = 0; e < 8; ++e) ss += yv[j][e] * yv[j][e]; }
        const float rr = 1.0f / sqrtf(wave_sum(ss) * (1.0f / DM) + 1e-6f);
        float s2 = 0.f;
#pragma unroll
        for (int j = 0; j < 2; ++j)
#pragma unroll
            for (int e = 0; e < 8; ++e) { xv[j][e] = xv[j][e] + (yv[j][e] * rr) * g[j][e >> 2][e & 3]; s2 += xv[j][e] * xv[j][e]; }
        if (LAST) {
#pragma unroll
            for (int j = 0; j < 2; ++j) { f32x4* op = (f32x4*)(out + (size_t)m * DM + 8 * lane + 512 * j); op[0] = (f32x4){xv[j][0], xv[j][1], xv[j][2], xv[j][3]}; op[1] = (f32x4){xv[j][4], xv[j][5], xv[j][6], xv[j][7]}; }
        } else {
            const float r2 = 1.0f / sqrtf(wave_sum(s2) * (1.0f / DM) + 1e-6f);
            if (lane == 0) R2[m] = r2;
#pragma unroll
            for (int j = 0; j < 2; ++j) { v4u w; w.x = pk2(xv[j][0], xv[j][1]); w.y = pk2(xv[j][2], xv[j][3]); w.z = pk2(xv[j][4], xv[j][5]); w.w = pk2(xv[j][6], xv[j][7]);
                *(v4u*)(XO + (size_t)m * DM + 8 * lane + 512 * j) = w; }
        }
    }
}
template <bool LAST>
__device__ __forceinline__ void norm_bf(const bf16* XB, bf16* XO, const bf16* Yb, const float* g1, float* R2, float* out, int bid, int G, int wave, int lane) {
    f32x4 g[2][2];
#pragma unroll
    for (int j = 0; j < 2; ++j) { g[j][0] = *(const f32x4*)(g1 + 8 * lane + 512 * j); g[j][1] = *(const f32x4*)(g1 + 8 * lane + 512 * j + 4); }
    for (int c = bid; c < MROWS / 32; c += G) norm_bf_rows<LAST, 4>(XB, XO, Yb, g, R2, out, 32 * c + wave, 8, lane);
}

__device__ __forceinline__ void mixer_a(ArgP A, int l, int item, LAS unsigned char* lds, int tid, int wave, int lane) {
    const bf16* Z = (const bf16*)(A->ws + WS_Z); bf16* MIX = (bf16*)(A->ws + WS_MIX);
    const bf16* sgw = (const bf16*)(A->ws + WS_W + (size_t)l * WS_WL + WO_SG);
    const int b = item >> 4, ch = item & 15; const size_t r0 = (size_t)b * SEQ + 128 * ch;
    LAS bf16* VT = (LAS bf16*)lds;
    LAS float* ST = (LAS float*)(lds + 69632);
    { const int s = tid >> 2, qd = tid & 3; float sm = 0.f, sq = 0.f;
#pragma unroll
        for (int i = 0; i < 8; ++i) { const v4u w = *(const v4u*)(Z + (r0 + s) * ZC + ZC_AV + 64 * qd + 8 * i);
            const float a0 = bflo(w.x), a1 = bfhi(w.x), a2 = bflo(w.y), a3 = bfhi(w.y), a4 = bflo(w.z), a5 = bfhi(w.z), a6 = bflo(w.w), a7 = bfhi(w.w);
            sm += ((a0 + a1) + (a2 + a3)) + ((a4 + a5) + (a6 + a7)); sq += ((a0 * a0 + a1 * a1) + (a2 * a2 + a3 * a3)) + ((a4 * a4 + a5 * a5) + (a6 * a6 + a7 * a7)); }
        sm += __shfl_xor(sm, 1); sq += __shfl_xor(sq, 1); sm += __shfl_xor(sm, 2); sq += __shfl_xor(sq, 2);
        const float mu = sm * (1.0f / 256.0f), var = fmaxf(sq * (1.0f / 256.0f) - mu * mu, 0.f);
        if (qd == 0) { ST[2 * s] = mu; ST[2 * s + 1] = 1.0f / sqrtf(var + 1e-5f); } }
    __syncthreads();
    { const int s = tid & 127, og = tid >> 7; const float mu = ST[2 * s], rs = ST[2 * s + 1];
        const float* gp = A->in[I_SGLN] + l * 256;
#pragma unroll 2
        for (int i = 0; i < 8; ++i) { const int oct = og + 4 * i;
            const v4u w = *(const v4u*)(Z + (r0 + s) * ZC + ZC_AV + 8 * oct);
            const f32x4 g0 = *(const f32x4*)(gp + 8 * oct), g1 = *(const f32x4*)(gp + 8 * oct + 4);
            LAS bf16* vp = VT + (8 * oct) * 136 + s;
            vp[0 * 136] = (bf16)f2bf((bflo(w.x) - mu) * rs * g0.x); vp[1 * 136] = (bf16)f2bf((bfhi(w.x) - mu) * rs * g0.y);
            vp[2 * 136] = (bf16)f2bf((bflo(w.y) - mu) * rs * g0.z); vp[3 * 136] = (bf16)f2bf((bfhi(w.y) - mu) * rs * g0.w);
            vp[4 * 136] = (bf16)f2bf((bflo(w.z) - mu) * rs * g1.x); vp[5 * 136] = (bf16)f2bf((bfhi(w.z) - mu) * rs * g1.y);
            vp[6 * 136] = (bf16)f2bf((bflo(w.w) - mu) * rs * g1.z); vp[7 * 136] = (bf16)f2bf((bfhi(w.w) - mu) * rs * g1.w); } }
    __syncthreads();
    const int h = wave >> 1, th = wave & 1, fr = lane & 15, q = lane >> 4;
    f32x4 acc[4][4];
#pragma unroll
    for (int a = 0; a < 4; ++a)
#pragma unroll
        for (int c = 0; c < 4; ++c) acc[a][c] = (f32x4){0.f, 0.f, 0.f, 0.f};
    const bf16* Wb = sgw + (size_t)h * 128 * 128;
#pragma unroll 2
    for (int ks = 0; ks < 4; ++ks) {
        v4u vf[4];
#pragma unroll
        for (int nt = 0; nt < 4; ++nt) vf[nt] = *(const LAS v4u*)(VT + (64 * h + 16 * nt + fr) * 136 + 32 * ks + 8 * q);
#pragma unroll
        for (int mt = 0; mt < 4; ++mt) { const int t = 64 * th + 16 * mt + fr; const v4u wf = *(const v4u*)(Wb + t * 128 + 32 * ks + 8 * q);
#pragma unroll
            for (int nt = 0; nt < 4; ++nt) acc[mt][nt] = mfma16(vf[nt], wf, acc[mt][nt]); }
    }
#pragma unroll
    for (int mt = 0; mt < 4; ++mt) { const int t = 64 * th + 16 * mt + fr; const float bias = A->in[I_SGB][l * 512 + h * 128 + t];
#pragma unroll
        for (int nt = 0; nt < 4; ++nt) { const int d0 = 64 * h + 16 * nt + 4 * q;
            const v2u uw = *(const v2u*)(Z + (r0 + t) * ZC + ZC_AU + d0); const f32x4 a = acc[mt][nt];
            v2u o; o.x = pk2(bflo(uw.x) * (a.x + bias), bfhi(uw.x) * (a.y + bias)); o.y = pk2(bflo(uw.y) * (a.z + bias), bfhi(uw.y) * (a.w + bias));
            *(v2u*)(MIX + (r0 + t) * DM + d0) = o; } }
    __syncthreads();
}

__device__ __forceinline__ void mixer_b(ArgP A, int l, int item, LAS unsigned char* lds, int tid, int wave, int lane) {
    const bf16* Z = (const bf16*)(A->ws + WS_Z); bf16* MIX = (bf16*)(A->ws + WS_MIX);
    const bf16* pwt = (const bf16*)(A->ws + WS_W + (size_t)l * WS_WL + WO_PW);
    const int b = item >> 5, tau = item & 31, t0 = 64 * tau; const size_t r0 = (size_t)b * SEQ + t0;
    LAS bf16* Ht = (LAS bf16*)lds;
    LAS float* CO = (LAS float*)(lds + 49152);
    LAS bf16* AT = (LAS bf16*)lds;
#pragma unroll
    for (int it_ = 0; it_ < 6; ++it_) { const int idx = tid + it_ * NTHREADS; if (idx >= 94 * 32) break; const int i = idx >> 5, oct = idx & 31, t = t0 - 30 + i; v4u o = (v4u){0u, 0u, 0u, 0u};
        if (t >= 0) { const bf16* zp = Z + ((size_t)b * SEQ + t) * ZC; const v4u a = *(const v4u*)(zp + ZC_BA + 8 * oct), g = *(const v4u*)(zp + ZC_BG + 8 * oct);
            o.x = pk2(bflo(a.x) * sigmoidf_(bflo(g.x)), bfhi(a.x) * sigmoidf_(bfhi(g.x))); o.y = pk2(bflo(a.y) * sigmoidf_(bflo(g.y)), bfhi(a.y) * sigmoidf_(bfhi(g.y)));
            o.z = pk2(bflo(a.z) * sigmoidf_(bflo(g.z)), bfhi(a.z) * sigmoidf_(bfhi(g.z))); o.w = pk2(bflo(a.w) * sigmoidf_(bflo(g.w)), bfhi(a.w) * sigmoidf_(bfhi(g.w))); }
        *(LAS v4u*)(Ht + i * 256 + 8 * oct) = o; }
    __syncthreads();
    { const int c = tid & 255, half = tid >> 8; float wt[31];
#pragma unroll
        for (int w = 0; w < 31; ++w) wt[w] = A->in[I_CVW][(size_t)l * 31 * 256 + w * 256 + c];
        const float bias = A->in[I_CVB][l * 256 + c];
#pragma unroll 1
        for (int tg = 0; tg < 4; ++tg) { const int tb = 32 * half + 8 * tg; float ac[8];
#pragma unroll
            for (int j = 0; j < 8; ++j) ac[j] = bias;
#pragma unroll
            for (int i = 0; i < 38; ++i) { const float hv = bf2f(Ht[(tb + i) * 256 + c]);
#pragma unroll
                for (int j = 0; j < 8; ++j) if (i - j >= 0 && i - j < 31) ac[j] += hv * wt[i - j]; }
#pragma unroll
            for (int j = 0; j < 8; ++j) CO[(tb + j) * 256 + c] = ac[j]; } }
    __syncthreads();
    v4u bpf[8][2];
#pragma unroll
    for (int ks = 0; ks < 8; ++ks)
#pragma unroll
        for (int nt = 0; nt < 2; ++nt) bpf[ks][nt] = *(const v4u*)(pwt + (32 * wave + 16 * nt + (lane & 15)) * 256 + 32 * ks + 8 * (lane >> 4));
    { const f32x4 g = *(const f32x4*)(A->in[I_CVLG] + l * 256 + 4 * lane), bb = *(const f32x4*)(A->in[I_CVLB] + l * 256 + 4 * lane);
#if MIXB_LNNEW
        f32x4 v[8]; float sm[8];
#pragma unroll
        for (int i = 0; i < 8; ++i) { v[i] = *(const LAS f32x4*)(CO + (8 * wave + i) * 256 + 4 * lane); sm[i] = (v[i].x + v[i].y) + (v[i].z + v[i].w); }
#pragma unroll
        for (int o = 1; o < 64; o <<= 1)
#pragma unroll
            for (int i = 0; i < 8; ++i) sm[i] += __shfl_xor(sm[i], o);
#pragma unroll
        for (int i = 0; i < 8; ++i) { v[i] = v[i] - sm[i] * (1.0f / 256.0f); sm[i] = (v[i].x * v[i].x + v[i].y * v[i].y) + (v[i].z * v[i].z + v[i].w * v[i].w); }
#pragma unroll
        for (int o = 1; o < 64; o <<= 1)
#pragma unroll
            for (int i = 0; i < 8; ++i) sm[i] += __shfl_xor(sm[i], o);
#pragma unroll
        for (int i = 0; i < 8; ++i) { const float rs = 1.0f / sqrtf(sm[i] * (1.0f / 256.0f) + 1e-5f);
            const f32x4 y = (v[i] * rs) * g + bb; v2u o; o.x = pk2(siluf_(y.x), siluf_(y.y)); o.y = pk2(siluf_(y.z), siluf_(y.w));
            *(LAS v2u*)(AT + (8 * wave + i) * 264 + 4 * lane) = o; } }
#else
        for (int i = 0; i < 8; ++i) { const int t = 8 * wave + i; const f32x4 v = *(const LAS f32x4*)(CO + t * 256 + 4 * lane);
            const float mu = wave_sum((v.x + v.y) + (v.z + v.w)) * (1.0f / 256.0f); const f32x4 d = v - mu;
            const float var = wave_sum((d.x * d.x + d.y * d.y) + (d.z * d.z + d.w * d.w)) * (1.0f / 256.0f); const float rs = 1.0f / sqrtf(var + 1e-5f);
            const f32x4 y = (d * rs) * g + bb; v2u o; o.x = pk2(siluf_(y.x), siluf_(y.y)); o.y = pk2(siluf_(y.z), siluf_(y.w));
            *(LAS v2u*)(AT + t * 264 + 4 * lane) = o; } }
#endif
    __syncthreads();
    const int fr = lane & 15, q = lane >> 4;
    f32x4 acc[4][2];
#pragma unroll
    for (int a = 0; a < 4; ++a)
#pragma unroll
        for (int c = 0; c < 2; ++c) acc[a][c] = (f32x4){0.f, 0.f, 0.f, 0.f};
#pragma unroll
    for (int ks = 0; ks < 8; ++ks) {
#pragma unroll
        for (int mt = 0; mt < 4; ++mt) { const v4u af = *(const LAS v4u*)(AT + (16 * mt + fr) * 264 + 32 * ks + 8 * q);
#pragma unroll
            for (int nt = 0; nt < 2; ++nt) acc[mt][nt] = mfma16(bpf[ks][nt], af, acc[mt][nt]); } }
#pragma unroll
    for (int mt = 0; mt < 4; ++mt)
#pragma unroll
        for (int nt = 0; nt < 2; ++nt) { const int n0 = 32 * wave + 16 * nt + 4 * q; const f32x4 pb = *(const f32x4*)(A->in[I_CVPB] + l * 256 + n0); const f32x4 o = acc[mt][nt] + pb;
            v2u w; w.x = pk2(o.x, o.y); w.y = pk2(o.z, o.w); *(v2u*)(MIX + (r0 + 16 * mt + fr) * DM + 256 + n0) = w; }
    __syncthreads();
}

template <int W>
__device__ __forceinline__ void pool_means(const LAS bf16* Xt, LAS bf16* AT, int c, int half, int t0) {
    float xv[47];
#pragma unroll
    for (int i = 0; i < 47; ++i) xv[i] = (i >= 16 - W) ? bf2f(Xt[(32 * half + i) * 256 + c]) : 0.f;
    float s = 0.f;
#pragma unroll
    for (int i = 0; i < W; ++i) s += xv[15 - i];
#pragma unroll
    for (int j = 0; j < 32; ++j) { const int jj = 32 * half + j, t = t0 + jj;
        if (j > 0) s += xv[15 + j] - xv[15 + j - W];
        const int cnt = (t + 1 < W) ? (t + 1) : W;
        AT[jj * 264 + c] = (bf16)f2bf(s / (float)cnt - xv[15 + j]); }
}

__device__ __forceinline__ void mixer_d(ArgP A, int l, int item, LAS unsigned char* lds, int tid, int wave, int lane) {
    const bf16* Z = (const bf16*)(A->ws + WS_Z); bf16* MIX = (bf16*)(A->ws + WS_MIX);
    const bf16* poolt = (const bf16*)(A->ws + WS_W + (size_t)l * WS_WL + WO_POOL);
    bf16* VTS = (bf16*)(A->ws + WS_VTS); bf16* VTW = (bf16*)(A->ws + WS_VTW);
    const int b = item >> 5, tau = item & 31, t0 = 64 * tau; const size_t r0 = (size_t)b * SEQ + t0;
    LAS bf16* Xt = (LAS bf16*)lds;
    LAS bf16* AT = (LAS bf16*)(lds + 40960);
    LAS bf16* TS = (LAS bf16*)(lds + 75776);
#pragma unroll
    for (int it_ = 0; it_ < 5; ++it_) { const int idx = tid + it_ * NTHREADS; if (idx >= 79 * 32) break; const int i = idx >> 5, oct = idx & 31, t = t0 - 15 + i; v4u o = (v4u){0u, 0u, 0u, 0u};
        if (t >= 0) o = *(const v4u*)(Z + ((size_t)b * SEQ + t) * ZC + ZC_D + 8 * oct);
        *(LAS v4u*)(Xt + i * 256 + 8 * oct) = o; }
    { const int tok = tid & 63, oct = tid >> 6; const bf16* zp = Z + (r0 + tok) * ZC;
        const v4u a = *(const v4u*)(zp + ZC_VS + 8 * oct), c = *(const v4u*)(zp + ZC_VW + 8 * oct);
        LAS bf16* p0 = TS + (8 * oct) * 72 + tok; LAS bf16* p1 = p0 + 4608;
        p0[0] = (bf16)(a.x & 0xffffu); p0[72] = (bf16)(a.x >> 16); p0[144] = (bf16)(a.y & 0xffffu); p0[216] = (bf16)(a.y >> 16);
        p0[288] = (bf16)(a.z & 0xffffu); p0[360] = (bf16)(a.z >> 16); p0[432] = (bf16)(a.w & 0xffffu); p0[504] = (bf16)(a.w >> 16);
        p1[0] = (bf16)(c.x & 0xffffu); p1[72] = (bf16)(c.x >> 16); p1[144] = (bf16)(c.y & 0xffffu); p1[216] = (bf16)(c.y >> 16);
        p1[288] = (bf16)(c.z & 0xffffu); p1[360] = (bf16)(c.z >> 16); p1[432] = (bf16)(c.w & 0xffffu); p1[504] = (bf16)(c.w >> 16); }
    __syncthreads();
#if MIXD_NEW
    { const int c = tid & 255, half = tid >> 8, g = c >> 6;
        if (g == 0) pool_means<2>(Xt, AT, c, half, t0); else if (g == 1) pool_means<4>(Xt, AT, c, half, t0); else if (g == 2) pool_means<8>(Xt, AT, c, half, t0); else pool_means<16>(Xt, AT, c, half, t0); }
#else
    { const int c = tid & 255, half = tid >> 8, g = c >> 6, w = 2 << g;
        for (int j = 0; j < 32; ++j) { const int jj = 32 * half + j, t = t0 + jj; float s = 0.f;
            for (int i = 0; i < w; ++i) s += bf2f(Xt[(15 + jj - i) * 256 + c]);
            const int cnt = (t + 1 < w) ? (t + 1) : w;
            const float mval = s / (float)cnt - bf2f(Xt[(15 + jj) * 256 + c]);
            AT[jj * 264 + c] = (bf16)f2bf(mval); } }
#endif
    { const int d = tid >> 3, pc = tid & 7;
        *(v4u*)(VTS + ((size_t)b * 64 + d) * SEQ + t0 + 8 * pc) = *(const LAS v4u*)(TS + d * 72 + 8 * pc);
        *(v4u*)(VTW + ((size_t)b * 64 + d) * SEQ + t0 + 8 * pc) = *(const LAS v4u*)(TS + 4608 + d * 72 + 8 * pc); }
    __syncthreads();
    const int fr = lane & 15, q = lane >> 4, g = wave >> 1, nh = wave & 1;
    f32x4 acc[4][2];
#pragma unroll
    for (int a = 0; a < 4; ++a)
#pragma unroll
        for (int c = 0; c < 2; ++c) acc[a][c] = (f32x4){0.f, 0.f, 0.f, 0.f};
#pragma unroll
    for (int ks = 0; ks < 2; ++ks) { v4u bfr[2];
#pragma unroll
        for (int nt = 0; nt < 2; ++nt) bfr[nt] = *(const v4u*)(poolt + g * 4096 + (32 * nh + 16 * nt + fr) * 64 + 32 * ks + 8 * q);
#pragma unroll
        for (int mt = 0; mt < 4; ++mt) { const v4u af = *(const LAS v4u*)(AT + (16 * mt + fr) * 264 + 64 * g + 32 * ks + 8 * q);
#pragma unroll
            for (int nt = 0; nt < 2; ++nt) acc[mt][nt] = mfma16(bfr[nt], af, acc[mt][nt]); } }
#pragma unroll
    for (int mt = 0; mt < 4; ++mt)
#pragma unroll
        for (int nt = 0; nt < 2; ++nt) { const int n0 = 64 * g + 32 * nh + 16 * nt + 4 * q; const f32x4 sc = *(const f32x4*)(A->in[I_POOLS] + l * 256 + n0); const f32x4 o = acc[mt][nt] * sc;
            v2u w; w.x = pk2(o.x, o.y); w.y = pk2(o.z, o.w); *(v2u*)(MIX + (r0 + 16 * mt + fr) * DM + 768 + n0) = w; }
    __syncthreads();
}

__device__ __forceinline__ void nsa_compress(ArgP A, int l, int item, LAS unsigned char* lds, int tid, int wave, int lane) {
    const bf16* Z = (const bf16*)(A->ws + WS_Z);
    bf16* KC = (bf16*)(A->ws + WS_KC); bf16* VCT = (bf16*)(A->ws + WS_VCT);
    const int b = item >> 4, kv = (item >> 3) & 1, mt = item & 7;
    const int colb = kv ? ZC_VC : ZC_KC;
    const float* pos = A->in[kv ? I_POSV : I_POSK] + l * 2048;
    const bf16* w1t = (const bf16*)(A->ws + WS_W + (size_t)l * WS_WL + (kv ? WO_W1V : WO_W1K));
    const float* w2 = A->in[kv ? I_W2V : I_W2K] + l * 4096;
    LAS float* RED = (LAS float*)lds;
    LAS float* H1 = (LAS float*)(lds + 32768);
    const int fr = lane & 15, q = lane >> 4, c = 16 * mt + fr; const bool cok = c < 127;
    f32x4 acc[4];
#pragma unroll
    for (int n = 0; n < 4; ++n) acc[n] = (f32x4){0.f, 0.f, 0.f, 0.f};
#pragma unroll 4
    for (int kk = 0; kk < 8; ++kk) { const int ks = 8 * wave + kk, ltok = ks >> 1, dd = 32 * (ks & 1) + 8 * q;
        v4u af = (v4u){0u, 0u, 0u, 0u};
        if (cok) { const v4u zw = *(const v4u*)(Z + ((size_t)b * SEQ + 16 * c + ltok) * ZC + colb + dd);
            const f32x4 p0 = *(const f32x4*)(pos + ltok * 64 + dd), p1 = *(const f32x4*)(pos + ltok * 64 + dd + 4);
            af.x = pk2(bflo(zw.x) + p0.x, bfhi(zw.x) + p0.y); af.y = pk2(bflo(zw.y) + p0.z, bfhi(zw.y) + p0.w);
            af.z = pk2(bflo(zw.z) + p1.x, bfhi(zw.z) + p1.y); af.w = pk2(bflo(zw.w) + p1.z, bfhi(zw.w) + p1.w); }
#pragma unroll
        for (int nt = 0; nt < 4; ++nt) { const v4u bfr = *(const v4u*)(w1t + (16 * nt + fr) * 2048 + 32 * ks + 8 * q); acc[nt] = mfma16(af, bfr, acc[nt]); } }
#pragma unroll
    for (int nt = 0; nt < 4; ++nt)
#pragma unroll
        for (int rg = 0; rg < 4; ++rg) RED[(wave * 16 + 4 * q + rg) * 64 + 16 * nt + fr] = acc[nt][rg];
    __syncthreads();
#pragma unroll
    for (int x = 0; x < 2; ++x) { const int o = tid + 512 * x, cc = o >> 6, n = o & 63; float s = 0.f;
#pragma unroll
        for (int w = 0; w < 8; ++w) s += RED[(w * 16 + cc) * 64 + n];
        H1[o] = siluf_(s); }
    __syncthreads();
#pragma unroll
    for (int x = 0; x < 2; ++x) { const int o = tid + 512 * x, cc = o >> 6, n2 = o & 63; float s = 0.f;
        for (int n = 0; n < 64; ++n) s += H1[cc * 64 + n] * w2[n * 64 + n2];
        const int cg_ = 16 * mt + cc;
        (kv == 0 ? KC : VCT)[((size_t)b * 128 + cg_) * 64 + n2] = (bf16)f2bf(s); }
    __syncthreads();
}

template <int HA, int HB, class MaskA, class MaskB>
__device__ __forceinline__ void attn_pair(const LAS bf16* KT, const LAS bf16* VT, const v4u (&qf)[2], int fr, int q, float& m_run, f32x4& o5, f32x4 (&o)[4],
                                          float rba, float rbb, bool ma, bool mb, MaskA okA, MaskB okB) {
    constexpr int N0 = HA ? 0 : 4, N1 = HB ? 8 : 4, K0 = HA ? 0 : 2, K1 = HB ? 4 : 2;
    v4u kf0[8], kf1[8];
#pragma unroll
    for (int nt = N0; nt < N1; ++nt) { kf0[nt] = *(const LAS v4u*)(KT + (16 * nt + fr) * 72 + 8 * q); kf1[nt] = *(const LAS v4u*)(KT + (16 * nt + fr) * 72 + 32 + 8 * q); }
    __builtin_amdgcn_sched_barrier(0);
    f32x4 s[8];
#pragma unroll
    for (int nt = N0; nt < N1; ++nt) { const float rb = nt < 4 ? rba : rbb;
        s[nt] = mfma16(kf0[nt], qf[0], (f32x4){rb, rb, rb, rb}); s[nt] = mfma16(kf1[nt], qf[1], s[nt]); }
    __builtin_amdgcn_sched_barrier(0);
    v2u vfa[4][4], vfb[4][4];
#pragma unroll
    for (int k2 = K0; k2 < K1; ++k2)
#pragma unroll
        for (int dt = 0; dt < 4; ++dt) { vfa[k2][dt] = *(const LAS v2u*)(VT + (16 * dt + fr) * 136 + 32 * k2 + 4 * q); vfb[k2][dt] = *(const LAS v2u*)(VT + (16 * dt + fr) * 136 + 32 * k2 + 16 + 4 * q); }
    __builtin_amdgcn_sched_barrier(0);
    if (HA && ma) {
#pragma unroll
        for (int nt = 0; nt < 4; ++nt)
#pragma unroll
            for (int rg = 0; rg < 4; ++rg) s[nt][rg] = okA(16 * nt + 4 * q + rg) ? s[nt][rg] : -1e30f; }
    if (HB && mb) {
#pragma unroll
        for (int nt = 0; nt < 4; ++nt)
#pragma unroll
            for (int rg = 0; rg < 4; ++rg) s[4 + nt][rg] = okB(16 * nt + 4 * q + rg) ? s[4 + nt][rg] : -1e30f; }
    float mx = m_run;
#pragma unroll
    for (int nt = N0; nt < N1; ++nt)
#pragma unroll
        for (int rg = 0; rg < 4; ++rg) mx = fmaxf(mx, s[nt][rg]);
    mx = fmaxf(mx, __shfl_xor(mx, 16)); mx = fmaxf(mx, __shfl_xor(mx, 32));
    if (__ballot(mx != m_run) != 0ull) {
        const float sc = __builtin_amdgcn_exp2f(m_run - mx); m_run = mx; o5 = o5 * sc;
#pragma unroll
        for (int dt = 0; dt < 4; ++dt) o[dt] = o[dt] * sc; }
#pragma unroll
    for (int nt = N0; nt < N1; ++nt)
#pragma unroll
        for (int rg = 0; rg < 4; ++rg) s[nt][rg] = __builtin_amdgcn_exp2f(s[nt][rg] - mx);
    const unsigned onesw = (fr == 0) ? 0x3f803f80u : 0u; const v4u vones = (v4u){onesw, onesw, onesw, onesw};
#pragma unroll
    for (int k2 = K0; k2 < K1; ++k2) { v4u pf; pf.x = pk2(s[2 * k2][0], s[2 * k2][1]); pf.y = pk2(s[2 * k2][2], s[2 * k2][3]); pf.z = pk2(s[2 * k2 + 1][0], s[2 * k2 + 1][1]); pf.w = pk2(s[2 * k2 + 1][2], s[2 * k2 + 1][3]);
        o5 = mfma16(vones, pf, o5);
#pragma unroll
        for (int dt = 0; dt < 4; ++dt) { v4u vf; vf.x = vfa[k2][dt].x; vf.y = vfa[k2][dt].y; vf.z = vfb[k2][dt].x; vf.w = vfb[k2][dt].y; o[dt] = mfma16(vf, pf, o[dt]); } }
}

template <class MaskF>
__device__ __forceinline__ void attn_tile2(const LAS bf16* KT, const LAS bf16* VT, const v4u (&qf)[2][2], int fr, int q, float (&m_run)[2], f32x4 (&o5)[2], f32x4 (&o)[2][4],
                                           const bool (&need)[2], const float (&rb)[2], bool masked, MaskF okf) {
    v4u kf0[4], kf1[4];
#pragma unroll
    for (int nt = 0; nt < 4; ++nt) { kf0[nt] = *(const LAS v4u*)(KT + (16 * nt + fr) * 72 + 8 * q); kf1[nt] = *(const LAS v4u*)(KT + (16 * nt + fr) * 72 + 32 + 8 * q); }
    __builtin_amdgcn_sched_barrier(0);
    f32x4 s[2][4];
#pragma unroll
    for (int g = 0; g < 2; ++g) if (need[g]) {
#pragma unroll
        for (int nt = 0; nt < 4; ++nt) { s[g][nt] = mfma16(kf0[nt], qf[g][0], (f32x4){rb[g], rb[g], rb[g], rb[g]}); s[g][nt] = mfma16(kf1[nt], qf[g][1], s[g][nt]); } }
    __builtin_amdgcn_sched_barrier(0);
    v2u vfa[2][4], vfb[2][4];
#pragma unroll
    for (int k2 = 0; k2 < 2; ++k2)
#pragma unroll
        for (int dt = 0; dt < 4; ++dt) { vfa[k2][dt] = *(const LAS v2u*)(VT + (16 * dt + fr) * 72 + 32 * k2 + 4 * q); vfb[k2][dt] = *(const LAS v2u*)(VT + (16 * dt + fr) * 72 + 32 * k2 + 16 + 4 * q); }
    __builtin_amdgcn_sched_barrier(0);
    const unsigned onesw = (fr == 0) ? 0x3f803f80u : 0u; const v4u vones = (v4u){onesw, onesw, onesw, onesw};
#pragma unroll
    for (int g = 0; g < 2; ++g) if (need[g]) {
        if (masked) {
#pragma unroll
            for (int nt = 0; nt < 4; ++nt)
#pragma unroll
                for (int rg = 0; rg < 4; ++rg) s[g][nt][rg] = okf(g, 16 * nt + 4 * q + rg) ? s[g][nt][rg] : -1e30f; }
        float mx = m_run[g];
#pragma unroll
        for (int nt = 0; nt < 4; ++nt)
#pragma unroll
            for (int rg = 0; rg < 4; ++rg) mx = fmaxf(mx, s[g][nt][rg]);
        mx = fmaxf(mx, __shfl_xor(mx, 16)); mx = fmaxf(mx, __shfl_xor(mx, 32));
        if (__ballot(mx != m_run[g]) != 0ull) { const float sc = __builtin_amdgcn_exp2f(m_run[g] - mx); m_run[g] = mx; o5[g] = o5[g] * sc;
#pragma unroll
            for (int dt = 0; dt < 4; ++dt) o[g][dt] = o[g][dt] * sc; }
#pragma unroll
        for (int nt = 0; nt < 4; ++nt)
#pragma unroll
            for (int rg = 0; rg < 4; ++rg) s[g][nt][rg] = __builtin_amdgcn_exp2f(s[g][nt][rg] - mx);
#pragma unroll
        for (int k2 = 0; k2 < 2; ++k2) { v4u pf; pf.x = pk2(s[g][2 * k2][0], s[g][2 * k2][1]); pf.y = pk2(s[g][2 * k2][2], s[g][2 * k2][3]); pf.z = pk2(s[g][2 * k2 + 1][0], s[g][2 * k2 + 1][1]); pf.w = pk2(s[g][2 * k2 + 1][2], s[g][2 * k2 + 1][3]);
            o5[g] = mfma16(vones, pf, o5[g]);
#pragma unroll
            for (int dt = 0; dt < 4; ++dt) { v4u vf; vf.x = vfa[k2][dt].x; vf.y = vfa[k2][dt].y; vf.z = vfb[k2][dt].x; vf.w = vfb[k2][dt].y; o[g][dt] = mfma16(vf, pf, o[g][dt]); } } }
}

__device__ __forceinline__ void nsa_attn(ArgP A, int l, int item, LAS unsigned char* lds, int tid, int wave, int lane) {
#define Z ((const bf16*)(A->ws + WS_Z))
#define MIX ((bf16*)(A->ws + WS_MIX))
#define VTS ((const bf16*)(A->ws + WS_VTS))
#define VTW ((const bf16*)(A->ws + WS_VTW))
#define KC ((const bf16*)(A->ws + WS_KC))
#define VCT ((const bf16*)(A->ws + WS_VCT))
    const int jq = item >> 8, ib = item & 255, b = 2 * (ib & 7) + ((ib >> 3) & 1), a = ib >> 4;
    const int tau = jq ? 31 - a : a;
    const int t0 = 64 * tau, curb = tau, wlo = (tau >= 8) ? tau - 8 : 0;
    LAS bf16* KT = (LAS bf16*)lds; LAS bf16* VT = KT + 9216;
    LAS bf16* TB = (LAS bf16*)(lds + 35840);
    LAS float* PS = (LAS float*)(lds + 72704) + wave * (16 * 132);
    LAS float* IMP = (LAS float*)(lds + 140288) + wave * 128;
    LAS unsigned* WANY = (LAS unsigned*)(lds + 144384);
    const int fr = lane & 15, q = lane >> 4, tt = fr >> 2, hh = fr & 3;
    const int skey = tid >> 3, spc = tid & 7;
    const bf16* kbase = Z + ((size_t)b * SEQ + skey) * ZC + 8 * spc;
    const size_t vbase = ((size_t)b * 64 + skey) * SEQ + 8 * spc;
    v4u kr = *(const v4u*)(kbase + ZC_KS), vr = *(const v4u*)(VTS + vbase);
    int tq[2]; size_t grow[2]; v4u qf[2][2]; float g0[2], g1[2], g2[2];
#pragma unroll
    for (int g = 0; g < 2; ++g) { tq[g] = t0 + 8 * wave + 4 * g + tt; grow[g] = (size_t)b * SEQ + tq[g];
#pragma unroll
        for (int ks = 0; ks < 2; ++ks) { const v4u w = *(const v4u*)(Z + grow[g] * ZC + ZC_Q + 64 * hh + 32 * ks + 8 * q);
            const float qs = 0.125f * 1.4426950408889634f;
            qf[g][ks].x = pk2(bflo(w.x) * qs, bfhi(w.x) * qs); qf[g][ks].y = pk2(bflo(w.y) * qs, bfhi(w.y) * qs);
            qf[g][ks].z = pk2(bflo(w.z) * qs, bfhi(w.z) * qs); qf[g][ks].w = pk2(bflo(w.w) * qs, bfhi(w.w) * qs); }
        g0[g] = sigmoidf_(bf2f(Z[grow[g] * ZC + ZC_G + 3 * hh + 0])); g1[g] = sigmoidf_(bf2f(Z[grow[g] * ZC + ZC_G + 3 * hh + 1])); g2[g] = sigmoidf_(bf2f(Z[grow[g] * ZC + ZC_G + 3 * hh + 2])); }
#pragma unroll
    for (int x = 0; x < 2; ++x) { const int pi = tid + 512 * x;
        { const int c = pi >> 3, pc = pi & 7; *(LAS v4u*)(KT + c * 72 + 8 * pc) = *(const v4u*)(KC + ((size_t)b * 128 + c) * 64 + 8 * pc); }
        { const int c = pi >> 3, pc = pi & 7; const v4u w = *(const v4u*)(VCT + ((size_t)b * 128 + c) * 64 + 8 * pc); LAS bf16* vp = VT + (8 * pc) * 136 + c;
            vp[0] = (bf16)(w.x & 0xffffu); vp[136] = (bf16)(w.x >> 16); vp[272] = (bf16)(w.y & 0xffffu); vp[408] = (bf16)(w.y >> 16);
            vp[544] = (bf16)(w.z & 0xffffu); vp[680] = (bf16)(w.z >> 16); vp[816] = (bf16)(w.w & 0xffffu); vp[952] = (bf16)(w.w >> 16); } }
    __syncthreads();
    f32x4 facc[2][4];
    unsigned msk[2], wny[2];
#pragma unroll 1
    for (int g = 0; g < 2; ++g) {
        const int t = t0 + 8 * wave + 4 * g + tt;
        const v4u q0 = g ? qf[1][0] : qf[0][0], q1 = g ? qf[1][1] : qf[0][1];
        f32x4 s[8];
#pragma unroll
        for (int nt = 0; nt < 8; ++nt) { const v4u k0 = *(const LAS v4u*)(KT + (16 * nt + fr) * 72 + 8 * q), k1 = *(const LAS v4u*)(KT + (16 * nt + fr) * 72 + 32 + 8 * q);
            s[nt] = mfma16(k0, q0, (f32x4){0.f, 0.f, 0.f, 0.f}); s[nt] = mfma16(k1, q1, s[nt]); }
        float mx = -1e30f;
#pragma unroll
        for (int nt = 0; nt < 8; ++nt)
#pragma unroll
            for (int rg = 0; rg < 4; ++rg) { const int c = 16 * nt + 4 * q + rg; const float v = (16 * c + 31 <= t) ? s[nt][rg] : -1e30f; s[nt][rg] = v; mx = fmaxf(mx, v); }
        mx = fmaxf(mx, __shfl_xor(mx, 16)); mx = fmaxf(mx, __shfl_xor(mx, 32));
        float sum = 0.f;
#pragma unroll
        for (int nt = 0; nt < 8; ++nt)
#pragma unroll
            for (int rg = 0; rg < 4; ++rg) { const float p = (s[nt][rg] > -5e29f) ? __builtin_amdgcn_exp2f(s[nt][rg] - mx) : 0.f; s[nt][rg] = p; sum += p; }
        sum += __shfl_xor(sum, 16); sum += __shfl_xor(sum, 32);
        const float inv = (t >= 31) ? 1.0f / sum : 0.f;
#pragma unroll
        for (int nt = 0; nt < 8; ++nt) { s[nt] = s[nt] * inv; *(LAS f32x4*)(PS + fr * 132 + 16 * nt + 4 * q) = s[nt]; }
        f32x4 oc[4];
#pragma unroll
        for (int dt = 0; dt < 4; ++dt) oc[dt] = (f32x4){0.f, 0.f, 0.f, 0.f};
#pragma unroll
        for (int k2 = 0; k2 < 4; ++k2) { v4u pf; pf.x = pk2(s[2 * k2][0], s[2 * k2][1]); pf.y = pk2(s[2 * k2][2], s[2 * k2][3]); pf.z = pk2(s[2 * k2 + 1][0], s[2 * k2 + 1][1]); pf.w = pk2(s[2 * k2 + 1][2], s[2 * k2 + 1][3]);
#pragma unroll
            for (int dt = 0; dt < 4; ++dt) { const v2u va = *(const LAS v2u*)(VT + (16 * dt + fr) * 136 + 32 * k2 + 4 * q), vb = *(const LAS v2u*)(VT + (16 * dt + fr) * 136 + 32 * k2 + 16 + 4 * q);
                v4u vf; vf.x = va.x; vf.y = va.y; vf.z = vb.x; vf.w = vb.y; oc[dt] = mfma16(vf, pf, oc[dt]); } }
        const float gg = g ? g0[1] : g0[0];
#pragma unroll
        for (int dt = 0; dt < 4; ++dt) { const f32x4 v = oc[dt] * gg; if (g) facc[1][dt] = v; else facc[0][dt] = v; }
        LDS_WAIT();
        const int tt2 = lane >> 4, jl = lane & 15, t2 = t0 + 8 * wave + 4 * g + tt2, cur = t2 >> 6;
        float key[2];
#pragma unroll
        for (int x = 0; x < 2; ++x) { const int j = jl + 16 * x; float im = 0.f;
#pragma unroll
            for (int i = 0; i < 5; ++i) { const int c = 4 * j - 1 + i;
                if (c >= 0 && c <= 126) { im += PS[(4 * tt2 + 0) * 132 + c]; im += PS[(4 * tt2 + 1) * 132 + c]; im += PS[(4 * tt2 + 2) * 132 + c]; im += PS[(4 * tt2 + 3) * 132 + c]; } }
            const bool valid = j <= cur, forced = (j == 0) | (j == cur) | (j == cur - 1);
            key[x] = valid ? (forced ? im + 1e4f : im) : -1e30f; IMP[tt2 * 32 + j] = key[x]; }
        LDS_WAIT();
        int rk0 = 0, rk1 = 0;
        f32x4 kq[8];
#pragma unroll
        for (int i = 0; i < 8; ++i) kq[i] = *(const LAS f32x4*)(IMP + tt2 * 32 + 4 * i);
#pragma unroll
        for (int j2 = 0; j2 < 32; ++j2) { const float k2 = kq[j2 >> 2][j2 & 3];
            rk0 += ((k2 > key[0]) || (k2 == key[0] && j2 < jl)) ? 1 : 0; rk1 += ((k2 > key[1]) || (k2 == key[1] && j2 < jl + 16)) ? 1 : 0; }
        const bool sel0 = (jl <= cur) && rk0 < 8, sel1 = (jl + 16 <= cur) && rk1 < 8;
        const unsigned long long bal0 = __ballot(sel0), bal1 = __ballot(sel1);
        const unsigned mk = (unsigned)((bal0 >> (16 * tt)) & 0xffffull) | ((unsigned)((bal1 >> (16 * tt)) & 0xffffull) << 16);
        unsigned wa = 0;
#pragma unroll
        for (int x = 0; x < 4; ++x) wa |= (unsigned)((bal0 >> (16 * x)) & 0xffffull) | ((unsigned)((bal1 >> (16 * x)) & 0xffffull) << 16);
        if (g) { msk[1] = mk; wny[1] = wa; } else { msk[0] = mk; wny[0] = wa; }
        LDS_WAIT();
    }
    if (lane == 0) WANY[wave] = wny[0] | wny[1];
    *(LAS v4u*)(TB + skey * 72 + 8 * spc) = kr; *(LAS v4u*)(TB + 4608 + skey * 72 + 8 * spc) = vr;
    __syncthreads();
    unsigned uni = 0;
#pragma unroll
    for (int w = 0; w < 8; ++w) uni |= WANY[w];
    int cph = 0, cj = 0, nph = 0, nj = 0, tb = 0;
#define ATT_ADV(ph, j) do { if (ph == 0) { const unsigned rem = uni & ~((2u << j) - 1u); if (rem) j = __builtin_ctz(rem); else { ph = 1; j = wlo; } } else if (++j > curb) ph = 2; } while (0)
    ATT_ADV(nph, nj);
    float m_run[2] = {-1e4f, -1e4f}; f32x4 o5[2], o[2][4];
#pragma unroll
    for (int g = 0; g < 2; ++g) { o5[g] = (f32x4){0.f, 0.f, 0.f, 0.f};
#pragma unroll
        for (int dt = 0; dt < 4; ++dt) o[g][dt] = (f32x4){0.f, 0.f, 0.f, 0.f}; }
    while (cph != 2) {
        if (nph != 2) { kr = *(const v4u*)(kbase + (size_t)(64 * nj) * ZC + (nph ? ZC_KW : ZC_KS)); vr = *(const v4u*)((nph ? VTW : VTS) + vbase + 64 * nj); }
        { const LAS bf16* Kb = TB + tb * 9216; const LAS bf16* Vb = Kb + 4608; const int kb = 64 * cj;
            const bool need[2] = { cph ? true : (bool)((wny[0] >> cj) & 1u), cph ? true : (bool)((wny[1] >> cj) & 1u) };
            if (need[0] || need[1]) { const float rb[2] = { (cph || ((msk[0] >> cj) & 1u)) ? 0.f : -1e30f, (cph || ((msk[1] >> cj) & 1u)) ? 0.f : -1e30f };
                const int tA = tq[0], tB = tq[1], wl = cph ? 512 : (1 << 30);
                attn_tile2(Kb, Vb, qf, fr, q, m_run, o5, o, need, rb, (cj == curb) || (cph && cj <= wlo),
                           [=](int g, int kk) { const int kp = kb + kk, tg = g ? tB : tA; return (kp <= tg) && (kp > tg - wl); }); } }
        if (nph != 2) { LAS bf16* Kn = TB + (tb ^ 1) * 9216; *(LAS v4u*)(Kn + skey * 72 + 8 * spc) = kr; *(LAS v4u*)(Kn + 4608 + skey * 72 + 8 * spc) = vr; }
        if (cph == 0 && nph == 1) {
#pragma unroll
            for (int g = 0; g < 2; ++g) { const float lt = __shfl(o5[g][0], fr); const float sc = g1[g] / lt;
#pragma unroll
                for (int dt = 0; dt < 4; ++dt) { facc[g][dt] = facc[g][dt] + o[g][dt] * sc; o[g][dt] = (f32x4){0.f, 0.f, 0.f, 0.f}; }
                m_run[g] = -1e4f; o5[g] = (f32x4){0.f, 0.f, 0.f, 0.f}; } }
        __syncthreads();
        cph = nph; cj = nj; tb ^= 1; ATT_ADV(nph, nj);
    }
#undef ATT_ADV
#pragma unroll
    for (int g = 0; g < 2; ++g) { const float lt = __shfl(o5[g][0], fr); const float sc = g2[g] / lt;
#pragma unroll
        for (int dt = 0; dt < 4; ++dt) { const f32x4 v = facc[g][dt] + o[g][dt] * sc; v2u w; w.x = pk2(v.x, v.y); w.y = pk2(v.z, v.w);
            *(v2u*)(MIX + grow[g] * DM + 512 + 64 * hh + 16 * dt + 4 * q) = w; } }
}
#undef Z
#undef MIX
#undef VTS
#undef VTW
#undef KC
#undef VCT

#define XB_TMO      128
#define XB_XCNT(j)  (256  + 64 * (j))
#define XB_XSUB(j)  (1280 + 64 * (j))
#define XB_XGEN(j)  (2304 + 64 * (j))
#define XB_TOP      3328
#define XB_TOPGEN   3392
#define XCD_BAR_WORDS 3456
#define XB_SPIN_CAP (1u << 18)

__device__ __forceinline__ unsigned xb_ld(unsigned* p)              { return __hip_atomic_load(p, __ATOMIC_RELAXED, __HIP_MEMORY_SCOPE_AGENT); }
__device__ __forceinline__ unsigned xb_add(unsigned* p, unsigned v) { return __hip_atomic_fetch_add(p, v, __ATOMIC_RELAXED, __HIP_MEMORY_SCOPE_AGENT); }
__device__ __forceinline__ unsigned xb_xcc_id() { return (unsigned)__builtin_amdgcn_s_getreg((3 << 11) | 20) & 0xFu; }
#define XB_SPIN(cond, bar) do { unsigned _sp = 0; while (cond) { __builtin_amdgcn_s_sleep(1); \
    if ((++_sp & 255u) == 0u) { if (xb_ld(&(bar)[XB_TMO])) break; if (_sp > XB_SPIN_CAP) { atomicAdd(&(bar)[XB_TMO], 1u); break; } } } } while (0)

struct XcdBarrier {
    unsigned* bar; unsigned x;
    volatile LAS unsigned* st;
};

__device__ __forceinline__ XcdBarrier xcd_barrier_post(unsigned* bar, volatile LAS unsigned* st) {
    XcdBarrier b; b.bar = bar; b.x = xb_xcc_id(); b.st = st;
    if (threadIdx.x == 0) (void)xb_add(&bar[XB_XCNT(b.x)], 1u);
    return b;
}
__device__ __forceinline__ void xcd_barrier_complete(unsigned* bar, unsigned x, unsigned& nloc, unsigned& nx) {
    const unsigned G = gridDim.x * gridDim.y * gridDim.z;
    unsigned sum, cnt, mine, sp = 0u;
    for (;;) {
        sum = 0u; cnt = 0u; mine = 0u;
#pragma unroll
        for (unsigned j = 0; j < 16; ++j) { const unsigned c = xb_ld(&bar[XB_XCNT(j)]); sum += c; cnt += (c > 0u) ? 1u : 0u; mine = (j == x) ? c : mine; }
        if (sum == G) break;
        __builtin_amdgcn_s_sleep(1);
        if ((++sp & 255u) == 0u) { if (xb_ld(&bar[XB_TMO])) break; if (sp > XB_SPIN_CAP) { atomicAdd(&bar[XB_TMO], 1u); break; } }
    }
    nloc = mine > 0u ? mine : 1u; nx = cnt > 0u ? cnt : 1u;
}

__device__ __forceinline__ void xcd_barrier(const XcdBarrier& b) {
    asm volatile("s_waitcnt vmcnt(0)" ::: "memory");
    __syncthreads();
    if (threadIdx.x == 0) {
        unsigned* bar = b.bar;
        __builtin_amdgcn_s_waitcnt(0);
        unsigned nloc = b.st[0], nx = b.st[1];
        if (nloc == 0u) { xcd_barrier_complete(bar, b.x, nloc, nx); b.st[0] = nloc; b.st[1] = nx; }
        const unsigned old = xb_add(&bar[XB_XSUB(b.x)], 1u);
        const unsigned gen = old / nloc;
        if (old + 1u == (gen + 1u) * nloc) {
            __builtin_amdgcn_fence(__ATOMIC_RELEASE, "agent");
            asm volatile("s_waitcnt vmcnt(0)" ::: "memory");
            const unsigned og = xb_add(&bar[XB_TOP], 1u);
            const unsigned tg = og / nx;
            if (og + 1u == (tg + 1u) * nx) xb_add(&bar[XB_TOPGEN], 1u);
            else XB_SPIN(xb_ld(&bar[XB_TOPGEN]) == tg, bar);
            __builtin_amdgcn_fence(__ATOMIC_ACQUIRE, "agent");
            xb_add(&bar[XB_XGEN(b.x)], 1u);
            asm volatile("s_waitcnt vmcnt(0)" ::: "memory");
        } else {
            XB_SPIN(xb_ld(&bar[XB_XGEN(b.x)]) == gen, bar);
            __builtin_amdgcn_fence(__ATOMIC_ACQUIRE, "agent");
            asm volatile("s_waitcnt vmcnt(0)" ::: "memory");
        }
    }
    __syncthreads();
}

#ifndef POSTBAR_SLEEP
#define POSTBAR_SLEEP do {} while (0)
#endif
#ifndef MIXD_NEW
#define MIXD_NEW 1
#endif
#ifndef MIXB_LNNEW
#define MIXB_LNNEW 1
#endif
#ifndef ATDRY
#define ATDRY 0
#endif
#ifndef ITREP
#define ITREP 0
#endif
#ifndef REPMASK
#define REPMASK 0
#endif
#ifndef PHSEL
#define PHSEL 0xfff
#endif
constexpr int N_PHASES = 1 + 8 * DEPTH;
__global__ void __launch_bounds__(NTHREADS) hybrid_fwd(Args KA) {
    extern __shared__ __attribute__((aligned(16))) unsigned char lds_raw[];
    LAS unsigned char* lds = (LAS unsigned char*)lds_raw;
    cg::grid_group grid = cg::this_grid();
    volatile LAS unsigned* MISC = (volatile LAS unsigned*)(lds + LDS_BYTES - 64);
    if (threadIdx.x < 16) MISC[threadIdx.x] = 0u;
    __syncthreads();
    const XcdBarrier bar = xcd_barrier_post((unsigned*)(KA.ws + WS_CTL), MISC);
#define SEAM(first) do { if (first) { __threadfence(); asm volatile("s_waitcnt vmcnt(0)" ::: "memory"); grid.sync(); __builtin_amdgcn_fence(__ATOMIC_ACQUIRE, "agent"); asm volatile("s_waitcnt vmcnt(0)" ::: "memory"); __syncthreads(); } else { xcd_barrier(bar); POSTBAR_SLEEP; } } while (0)
#if REPMASK
    for (int ph2 = 2 * KA.ph_lo; ph2 < 2 * KA.ph_hi; ++ph2) {
        const int ph = ph2 >> 1;
        if (ph2 & 1) { const int stx = (ph == 0) ? 8 : ((ph - 1) & 7); if (!(((REPMASK & ~0x90) >> stx) & 1) && !((REPMASK >> 9) & 1)) continue; }
        if (ph2 > 2 * KA.ph_lo) SEAM(ph2 == 2 * KA.ph_lo + 2);
        if (ph2 & 1) { const int stx = (ph == 0) ? 8 : ((ph - 1) & 7); if (!(((REPMASK & ~0x90) >> stx) & 1)) continue; }
#else
    for (int ph = KA.ph_lo; ph < KA.ph_hi; ++ph) {
        if (ph > KA.ph_lo) SEAM(ph == KA.ph_lo + 1);
#endif
        ArgP A = (ArgP)__builtin_amdgcn_kernarg_segment_ptr(); asm volatile("" : "+s"(A));
        int tid = threadIdx.x; asm volatile("" : "+v"(tid));
        int G = gridDim.x, bid = blockIdx.x; asm volatile("" : "+s"(G), "+s"(bid));
        const int ngw = G * NWAVES;
        const int lane = tid & 63, wave = __builtin_amdgcn_readfirstlane(tid >> 6), gw = bid * NWAVES + wave;
        unsigned char* ws = A->ws;
        bf16* H = (bf16*)(ws + WS_H); bf16* Zb = (bf16*)(ws + WS_Z); bf16* MIX = (bf16*)(ws + WS_MIX); bf16* HID = (bf16*)(ws + WS_HID); bf16* Y = (bf16*)(ws + WS_Y); float* R2 = (float*)(ws + WS_R2);
        if (ph == 0) {
#if PHSEL & 1
            LAS float* scr = (LAS float*)(lds + wave * 16384);
            for (int it = gw; it < DEPTH * TI_LAYER; it += ngw) prologue_item(A, it, scr, lane);
            for (int idx = bid * NTHREADS + tid; idx < DEPTH * 65536; idx += G * NTHREADS) { const int l = idx >> 16, rem = idx & 65535, tq = (rem >> 7) & 127, sq = rem & 127;
                ((bf16*)(ws + WS_W + (size_t)l * WS_WL + WO_SG))[rem] = (sq <= tq) ? (bf16)f2bf(A->in[I_SGW][idx]) : (bf16)0; }
            norm_first(A->in[I_X], H, R2, bid, G, wave, lane);
#endif
            continue;
        }
        const int l = (ph - 1) >> 3, st = (ph - 1) & 7;
        unsigned char* wl = ws + WS_W + (size_t)l * WS_WL;
        if (st == 0) {
#if PHSEL & 2
            pg8::Gemm g{H, (const bf16*)(wl + WO_IN), MROWS, ZC, DM}; pg8::StaticOrder S; S.init(MROWS, ZC, G, bid);
            pg8::EpiBf16RS E{Zb, ZC, R2 + (size_t)(2 * l) * MROWS};
            pg8::gemm_phase<pg8::EpiBf16RS, pg8::StaticOrder, PG8_ALIGN, PG8_SP2>(lds, g, S, E);
#endif
        } else if (st == 1) {
#if PHSEL & 4
            for (int it0 = bid; it0 < 1536 + (ITREP ? 512 : 0); it0 += G) {
                int it = it0; int tid_i = tid; ArgP A_i = A; asm volatile("" : "+v"(tid_i), "+s"(A_i));
                const int lane_i = tid_i & 63, wave_i = __builtin_amdgcn_readfirstlane(tid_i >> 6);
                if (it0 >= 1536) { const int e = it0 - 1536; if (ITREP == 1) { if (e >= 256) continue; it = e; } else if (ITREP == 2) it = 256 + e; else if (ITREP == 4) it = 768 + e; else { if (e >= 256) continue; it = 1280 + e; } }
                if (it < 256) {
#if PHSEL & 256
                    mixer_a(A_i, l, it, lds, tid_i, wave_i, lane_i);
#endif
                } else if (it < 768) {
#if PHSEL & 512
                    mixer_b(A_i, l, it - 256, lds, tid_i, wave_i, lane_i);
#endif
                } else if (it < 1280) {
#if PHSEL & 1024
                    mixer_d(A_i, l, it - 768, lds, tid_i, wave_i, lane_i);
#endif
                } else {
#if PHSEL & 2048
                    nsa_compress(A_i, l, it - 1280, lds, tid_i, wave_i, lane_i);
#endif
                }
            }
#endif
        } else if (st == 2) {
#if PHSEL & 8
            for (int it = bid; it < 512; it += G) { int tid_i = tid; ArgP A_i = A; asm volatile("" : "+v"(tid_i), "+s"(A_i));
                nsa_attn(A_i, l, it, lds, tid_i, __builtin_amdgcn_readfirstlane(tid_i >> 6), tid_i & 63); }
#endif
        } else if (st == 3 || st == 6) {
#if PHSEL & 16
            pg8::Gemm g{st == 3 ? MIX : HID, (const bf16*)(wl + (st == 3 ? WO_OUT : WO_DN)), MROWS, DM, st == 3 ? DM : FFH}; pg8::StaticOrder S; S.init(MROWS, DM, G, bid);
            pg8::EpiBf16<0> E{Y, DM, nullptr, 0, 0, 1.f};
            pg8::gemm_phase<pg8::EpiBf16<0>, pg8::StaticOrder, PG8_ALIGN, PG8_SP2>(lds, g, S, E);
#endif
        } else if (st == 4) {
#if PHSEL & 32
#if (REPMASK >> 4) & 1
            norm_bf<false>(H, HID, Y, A->in[I_GQM] + l * DM, (float*)(ws + WS_MIX), nullptr, bid, G, wave, lane);
#endif
            norm_bf<false>(H, H, Y, A->in[I_GQM] + l * DM, R2 + (size_t)(2 * l + 1) * MROWS, nullptr, bid, G, wave, lane);
#endif
        } else if (st == 5) {
#if PHSEL & 64
            pg8::Gemm g{H, (const bf16*)(wl + WO_GU), MROWS, 2 * FFH, DM}; pg8::StaticOrder S; S.init(MROWS, 2 * FFH, G, bid);
            pg8::EpiSwiGLU E{HID, FFH, R2 + (size_t)(2 * l + 1) * MROWS};
            pg8::gemm_phase<pg8::EpiSwiGLU, pg8::StaticOrder, PG8_ALIGN, PG8_SP2>(lds, g, S, E);
#endif
        } else {
#if PHSEL & 128
            const bool last = (l == DEPTH - 1);
#if (REPMASK >> 7) & 1
            norm_bf<false>(H, HID, Y, A->in[I_GQF] + l * DM, (float*)(ws + WS_MIX), nullptr, bid, G, wave, lane);
#endif
            if (last) norm_bf<true>(H, H, Y, A->in[I_GQF] + l * DM, nullptr, A->out, bid, G, wave, lane);
            else norm_bf<false>(H, H, Y, A->in[I_GQF] + l * DM, R2 + (size_t)(2 * l + 2) * MROWS, nullptr, bid, G, wave, lane);
#endif
        }
    }
}

#ifndef MK_MULTI
#define MK_MULTI 0
#endif
extern "C" void kernel_launch(void* const* d_in, const int* in_sizes, int n_in, void* d_out, int out_size, void* d_ws, size_t ws_size, hipStream_t stream) {
    static int grid = 0;
    if (grid == 0) {
        if (n_in != 26 || out_size != MROWS * DM || ws_size < WS_END) { fprintf(stderr, "kernel_launch: unexpected shapes (n_in %d out %d ws %zu)\n", n_in, out_size, ws_size); grid = -1; return; }
        int dev = 0, cus = 0, per_cu = 0;
        hipGetDevice(&dev); hipDeviceGetAttribute(&cus, hipDeviceAttributeMultiprocessorCount, dev);
        hipFuncSetAttribute((const void*)hybrid_fwd, hipFuncAttributeMaxDynamicSharedMemorySize, LDS_BYTES);
        hipOccupancyMaxActiveBlocksPerMultiprocessor(&per_cu, (const void*)hybrid_fwd, NTHREADS, LDS_BYTES);
        if (per_cu < 1) per_cu = 1;
        grid = cus * per_cu;
        (void)hipGetLastError();
    }
    if (grid < 0) return;
    Args a{};
    for (int i = 0; i < 26; ++i) a.in[i] = (const float*)d_in[i];
    a.out = (float*)d_out; a.ws = (unsigned char*)d_ws;
    if (hipMemsetAsync((char*)d_ws + WS_CTL, 0, CTL_BYTES, stream) != hipSuccess) { fprintf(stderr, "kernel_launch: memset of the barrier words failed\n"); return; }
#if MK_MULTI
    for (int ph = 0; ph < N_PHASES; ++ph) { a.ph_lo = ph; a.ph_hi = ph + 1; hipLaunchKernelGGL(hybrid_fwd, dim3(grid), dim3(NTHREADS), LDS_BYTES, stream, a); }
#else
    a.ph_lo = 0; a.ph_hi = N_PHASES;
    void* args[] = {&a};
    hipError_t e = hipLaunchCooperativeKernel((const void*)hybrid_fwd, dim3(grid), dim3(NTHREADS), args, LDS_BYTES, stream);
    if (e != hipSuccess) fprintf(stderr, "cooperative launch failed: %s (grid %d)\n", hipGetErrorString(e), grid);
#endif
}
```

```cpp
#include <hip/hip_runtime.h>
#include <hip/hip_cooperative_groups.h>
#include <cstdio>
#include <cstdint>
namespace cg = cooperative_groups;
namespace pg8 {
#define PG8_LAS __attribute__((address_space(3)))
typedef unsigned short bf16_t;
typedef short bf16x8 __attribute__((ext_vector_type(8)));
typedef float f32x4 __attribute__((ext_vector_type(4)));
typedef unsigned u32x4 __attribute__((ext_vector_type(4)));
constexpr int BM = 256, BK = 64, HALF = 128, HTB = HALF * BK * 2  , STAGE_BYTES = 8 * HTB, NXCD = 8, WGM = 8;

__host__ __device__ __forceinline__ int lds_byte(int r, int c) { const int st = (r >> 4) * 2 + (c >> 5), rr = r & 15, cc = c & 31, ob = rr * 64 + cc * 2; return st * 1024 + (ob ^ (((ob >> 9) & 1) << 5)); }
__host__ __device__ __forceinline__ void stage_rc(int b, int& R, int& C) { const int st = b / 1024, sb = b % 1024, swz = sb ^ (((sb >> 9) & 1) << 5); R = (st >> 1) * 16 + swz / 64; C = (st & 1) * 32 + (swz % 64) / 2; }
__host__ __device__ __forceinline__ int perm32(int rho) { const int n = rho >> 4, i = rho & 15; return 8 * (i >> 2) + 4 * n + (i & 3); }

struct Unit { int pm, pn; };
struct Gemm { const bf16_t* A; const bf16_t* Bt; int M, N, K; };

struct StaticOrder {
    int nM, nN, nwg, G, c;
    __host__ __device__ void init(int M, int N, int G_, int c_) { nM = M / BM; nN = N / BM; nwg = nM * nN; G = G_; c = c_; }
    __host__ __device__ bool next(int i, Unit& u) const {
        const long L = (long)i * G + c; if (L >= nwg) return false;
        int wgid = (int)L; { const int q = nwg / NXCD, r = nwg % NXCD, xcd = wgid % NXCD, off = wgid / NXCD; wgid = (xcd < r ? xcd * (q + 1) : r * (q + 1) + (xcd - r) * q) + off; }
        const int nig = WGM * nN, gid = wgid / nig, fm = gid * WGM, gsz = (nM - fm) < WGM ? (nM - fm) : WGM;
        u.pm = fm + ((wgid % nig) % gsz); u.pn = (wgid % nig) / gsz; return true;
    }
    __device__ __forceinline__ void a_ready(const Unit&) const {}
    __device__ __forceinline__ void done(const Unit&) const {}
};

__device__ __forceinline__ unsigned cvt_pk_bf16(float lo, float hi) { unsigned r; asm volatile("v_cvt_pk_bf16_f32 %0, %1, %2" : "=v"(r) : "v"(lo), "v"(hi)); return r; }
typedef float f32x2 __attribute__((ext_vector_type(2)));
__device__ __forceinline__ f32x2 gelu_pk(f32x2 v) {
    const f32x2 av = __builtin_elementwise_abs(v), d = av * 0.2316418882f + 1.0f;
    f32x2 t; t.x = __builtin_amdgcn_rcpf(d.x); t.y = __builtin_amdgcn_rcpf(d.y);
    f32x2 q = t * 0.5307027145f + (-0.7265760135f); q = q * t + 0.7107068705f; q = q * t + (-0.142248368f); q = q * t + 0.127414796f; q = q * t;
    const f32x2 s = (v * v) * (-0.72134752044f);
    f32x2 e; e.x = __builtin_amdgcn_exp2f(s.x); e.y = __builtin_amdgcn_exp2f(s.y);
    const f32x2 m = v * (q * e), r = v - m;
    f32x2 o; o.x = v.x < 0.f ? m.x : r.x; o.y = v.y < 0.f ? m.y : r.y; return o;
}

template <int ACT  > struct EpiBf16 {
    static constexpr bool PERM = true, AFTER_DRAIN = false; static_assert(ACT == 0 || ACT == 1, "EpiBf16: ACT is 0 (none) or 1 (gelu_pk)");
    bf16_t* O; int ldc; const float* bias; int split_cols; size_t split_stride; float scale0;
    __device__ __forceinline__ void operator()(const f32x4 (&acc)[2][2][4][2], const Unit& u, int wr, int wc, int fr, int fq) const {
        const int row0 = u.pm * BM + wr * 64 + fr; int colt = u.pn * BM; bf16_t* base = O;
        float sc = 1.f; if (split_cols) { const int t = colt / split_cols; base += (size_t)t * split_stride; colt -= t * split_cols; if (t == 0) sc = scale0; }
        const int col0 = colt + wc * 32 + 8 * fq, bcol0 = u.pn * BM + wc * 32 + 8 * fq;
        f32x4 bv[2][2];
#pragma unroll
        for (int bj = 0; bj < 2; ++bj)
#pragma unroll
            for (int n = 0; n < 2; ++n) bv[bj][n] = bias ? *(const f32x4*)(bias + bcol0 + bj * HALF + 4 * n) : (f32x4){0.f, 0.f, 0.f, 0.f};
#pragma unroll
        for (int ai = 0; ai < 2; ++ai)
#pragma unroll
            for (int m = 0; m < 4; ++m) { bf16_t* rowp = base + (size_t)(row0 + ai * HALF + m * 16) * ldc + col0;
#pragma unroll
                for (int bj = 0; bj < 2; ++bj) { f32x4 v0 = acc[ai][bj][m][0] + bv[bj][0], v1 = acc[ai][bj][m][1] + bv[bj][1];
                    if (ACT == 1) { f32x2 a = gelu_pk((f32x2){v0[0], v0[1]}), b = gelu_pk((f32x2){v0[2], v0[3]}), c = gelu_pk((f32x2){v1[0], v1[1]}), d = gelu_pk((f32x2){v1[2], v1[3]});
                        v0 = (f32x4){a.x, a.y, b.x, b.y}; v1 = (f32x4){c.x, c.y, d.x, d.y}; }
                    v0 = v0 * sc; v1 = v1 * sc; u32x4 w; w.x = cvt_pk_bf16(v0[0], v0[1]); w.y = cvt_pk_bf16(v0[2], v0[3]); w.z = cvt_pk_bf16(v1[0], v1[1]); w.w = cvt_pk_bf16(v1[2], v1[3]);
                    *(u32x4*)(rowp + bj * HALF) = w; } }
    }
};
struct EpiF32 {
    static constexpr bool PERM = false, AFTER_DRAIN = false;
    float* O; int ldc;
    __device__ __forceinline__ void operator()(const f32x4 (&acc)[2][2][4][2], const Unit& u, int wr, int wc, int fr, int fq) const {
        const int row0 = u.pm * BM + wr * 64 + fr, col0 = u.pn * BM + wc * 32 + 4 * fq;
#pragma unroll
        for (int ai = 0; ai < 2; ++ai)
#pragma unroll
            for (int m = 0; m < 4; ++m) { float* rowp = O + (size_t)(row0 + ai * HALF + m * 16) * ldc + col0;
#pragma unroll
                for (int bj = 0; bj < 2; ++bj)
#pragma unroll
                    for (int n = 0; n < 2; ++n) *(f32x4*)(rowp + bj * HALF + n * 16) = acc[ai][bj][m][n]; }
    }
};
struct EpiSwiGLU {
    static constexpr bool PERM = true, AFTER_DRAIN = false;
    bf16_t* O; int ldc; const float* rs;
    __device__ __forceinline__ void operator()(const f32x4 (&acc)[2][2][4][2], const Unit& u, int wr, int wc, int fr, int fq) const {
        const int row0 = u.pm * BM + wr * 64 + fr, col0 = u.pn * HALF + wc * 32 + 8 * fq;
#pragma unroll
        for (int ai = 0; ai < 2; ++ai)
#pragma unroll
            for (int m = 0; m < 4; ++m) { bf16_t* rowp = O + (size_t)(row0 + ai * HALF + m * 16) * ldc + col0;
                const float r = rs[row0 + ai * HALF + m * 16];
                float h[8];
#pragma unroll
                for (int n = 0; n < 2; ++n)
#pragma unroll
                    for (int e = 0; e < 4; ++e) { const float g = acc[ai][0][m][n][e] * r, up = acc[ai][1][m][n][e] * r;
                        h[n * 4 + e] = g * __builtin_amdgcn_rcpf(1.0f + __builtin_amdgcn_exp2f(-1.4426950408889634f * g)) * up; }
                u32x4 w; w.x = cvt_pk_bf16(h[0], h[1]); w.y = cvt_pk_bf16(h[2], h[3]); w.z = cvt_pk_bf16(h[4], h[5]); w.w = cvt_pk_bf16(h[6], h[7]);
                *(u32x4*)rowp = w; }
    }
};
struct EpiBf16RS {
    static constexpr bool PERM = true, AFTER_DRAIN = false;
    bf16_t* O; int ldc; const float* rs; size_t ts;
    __device__ __forceinline__ void operator()(const f32x4 (&acc)[2][2][4][2], const Unit& u, int wr, int wc, int fr, int fq) const {
        const int row0 = u.pm * BM + wr * 64 + fr, col0 = wc * 32 + 8 * fq;
#pragma unroll
        for (int ai = 0; ai < 2; ++ai)
#pragma unroll
            for (int m = 0; m < 4; ++m) { bf16_t* rowp = O + (size_t)u.pn * ts + (size_t)(row0 + ai * HALF + m * 16) * ldc + col0; const float r = rs[row0 + ai * HALF + m * 16];
#pragma unroll
                for (int bj = 0; bj < 2; ++bj) { const f32x4 v0 = acc[ai][bj][m][0] * r, v1 = acc[ai][bj][m][1] * r;
                    u32x4 w; w.x = cvt_pk_bf16(v0[0], v0[1]); w.y = cvt_pk_bf16(v0[2], v0[3]); w.z = cvt_pk_bf16(v1[0], v1[1]); w.w = cvt_pk_bf16(v1[2], v1[3]);
                    *(u32x4*)(rowp + bj * HALF) = w; } }
    }
};
template <class Epi, class Sched, bool ALIGN_EPI = false, bool SP2 = false>
__device__ __forceinline__ void gemm_phase(PG8_LAS unsigned char* lds, const Gemm g, const Sched& S, const Epi& E) {
    int tid_l = threadIdx.x; asm volatile("" : "+v"(tid_l));
    const int tid = tid_l, wid = __builtin_amdgcn_readfirstlane(tid >> 6), lane = tid & 63, wr = wid >> 2, wc = wid & 3, fr = lane & 15, fq = lane >> 4;
    const int K = g.K, nt = K / BK;
    unsigned voffA[2], voffB[2];
#pragma unroll
    for (int i = 0; i < 2; ++i) { int R, C; stage_rc(tid * 16 + i * 8192, R, C); const int Rb = Epi::PERM ? ((R & ~31) + perm32(R & 31)) : R;
        voffA[i] = (unsigned)(R * K + C) * 2u; voffB[i] = (unsigned)(Rb * K + C) * 2u; }
    const size_t kstep = (size_t)(BK * 2);
    const size_t hstep = (size_t)HALF * K * 2;
    const size_t tstep = 2 * hstep;
    const unsigned ldsw = (unsigned)wid * 1024u;
    const int aoff = lds_byte(wr * 64 + fr, fq * 8), boff = lds_byte(wc * 32 + fr, fq * 8);
#define PG8_SA(b, h) (((b) * 2 + (h)) * HTB)
#define PG8_SB(b, h) ((4 + (b) * 2 + (h)) * HTB)
#define PG8_STAGE(bufoff, gbase, voff) do { _Pragma("unroll") for (int _i = 0; _i < 2; ++_i) \
        __builtin_amdgcn_global_load_lds((const unsigned*)((const char*)(gbase) + (voff)[_i]), (PG8_LAS unsigned*)(lds + (bufoff) + ldsw + _i * 8192), 16, 0, 0); } while (0)
#define PG8_LDA(dst, b, h) do { _Pragma("unroll") for (int m = 0; m < 4; ++m) _Pragma("unroll") for (int k = 0; k < 2; ++k) dst[m][k] = *(const PG8_LAS bf16x8*)(lds + PG8_SA(b, h) + aoff + m * 2048 + k * 1024); } while (0)
#define PG8_LDB(dst, b, h) do { _Pragma("unroll") for (int n = 0; n < 2; ++n) _Pragma("unroll") for (int k = 0; k < 2; ++k) dst[n][k] = *(const PG8_LAS bf16x8*)(lds + PG8_SB(b, h) + boff + n * 2048 + k * 1024); } while (0)
#define PG8_MMA(ai, bj, At, Bt) do { __builtin_amdgcn_s_setprio(1); _Pragma("unroll") for (int m = 0; m < 4; ++m) _Pragma("unroll") for (int n = 0; n < 2; ++n) _Pragma("unroll") for (int k = 0; k < 2; ++k) \
        acc[ai][bj][m][n] = __builtin_amdgcn_mfma_f32_16x16x32_bf16(Bt[n][k], At[m][k], acc[ai][bj][m][n], 0, 0, 0); __builtin_amdgcn_s_setprio(0); } while (0)
#define PG8_WAIT_V(n) asm volatile("s_waitcnt vmcnt(" #n ")" ::: "memory")
#define PG8_WAIT_L(n) asm volatile("s_waitcnt lgkmcnt(" #n ")" ::: "memory")
#define PG8_BAR __builtin_amdgcn_s_barrier()
#define PG8_SCHED __builtin_amdgcn_sched_barrier(0)
    Unit cur, nxt; int ui = 0;
    if (!S.next(0, cur)) return;
    f32x4 acc[2][2][4][2];
#pragma unroll
    for (int a = 0; a < 2; ++a)
#pragma unroll
        for (int b = 0; b < 2; ++b)
#pragma unroll
            for (int m = 0; m < 4; ++m)
#pragma unroll
                for (int n = 0; n < 2; ++n) acc[a][b][m][n] = (f32x4){0.f, 0.f, 0.f, 0.f};
    bf16x8 At[4][2], B0[2][2], B1[2][2];
    const char* cA = (const char*)g.A + (size_t)cur.pm * tstep; const char* cB = (const char*)g.Bt + (size_t)cur.pn * tstep;
    S.a_ready(cur);
    if constexpr (SP2) {
        PG8_STAGE(PG8_SB(0, 0), cB, voffB); PG8_STAGE(PG8_SB(0, 1), cB + hstep, voffB); PG8_STAGE(PG8_SA(0, 0), cA, voffA); PG8_STAGE(PG8_SA(0, 1), cA + hstep, voffA);
        if (wr == 1) PG8_BAR;
        PG8_WAIT_V(2); PG8_BAR;
        PG8_STAGE(PG8_SB(1, 0), cB + kstep, voffB); PG8_STAGE(PG8_SA(1, 0), cA + kstep, voffA); PG8_STAGE(PG8_SB(1, 1), cB + hstep + kstep, voffB);
        PG8_WAIT_V(6); PG8_BAR;
    } else {
        PG8_STAGE(PG8_SB(0, 0), cB, voffB); PG8_STAGE(PG8_SA(0, 0), cA, voffA); PG8_STAGE(PG8_SB(0, 1), cB + hstep, voffB); PG8_STAGE(PG8_SA(0, 1), cA + hstep, voffA);
        if (wr == 1) PG8_BAR;
        PG8_WAIT_V(4); PG8_BAR;
        PG8_STAGE(PG8_SB(1, 0), cB + kstep, voffB); PG8_STAGE(PG8_SA(1, 0), cA + kstep, voffA); PG8_STAGE(PG8_SB(1, 1), cB + hstep + kstep, voffB);
        PG8_WAIT_V(6); PG8_BAR;
    }
    for (;;) {
        const bool has_next = S.next(ui + 1, nxt);
        const char* nA = has_next ? (const char*)g.A + (size_t)nxt.pm * tstep : cA; const char* nB = has_next ? (const char*)g.Bt + (size_t)nxt.pn * tstep : cB;
        for (int t = 0; t < nt; t += 2) {
            const bool last = (t == nt - 2);
            const char* a1 = cA + (size_t)(t + 1) * kstep;
            const char* a2 = last ? nA : cA + (size_t)(t + 2) * kstep; const char* b2 = last ? nB : cB + (size_t)(t + 2) * kstep;
            const char* a3 = a2 + kstep; const char* b3 = b2 + kstep;
            if (last && has_next) S.a_ready(nxt);
            if constexpr (SP2) {
            PG8_LDB(B0, 0, 0); PG8_LDB(B1, 0, 1); PG8_SCHED; PG8_LDA(At, 0, 0); PG8_STAGE(PG8_SA(1, 1), a1 + hstep, voffA);
            PG8_WAIT_V(8); PG8_WAIT_L(0); PG8_BAR; PG8_MMA(0, 0, At, B0); PG8_MMA(0, 1, At, B1); PG8_BAR; PG8_SCHED;
            PG8_LDA(At, 0, 1); PG8_STAGE(PG8_SB(0, 0), b2, voffB); PG8_STAGE(PG8_SB(0, 1), b2 + hstep, voffB); PG8_STAGE(PG8_SA(0, 0), a2, voffA);
            PG8_WAIT_V(8); PG8_WAIT_L(0); PG8_BAR; PG8_MMA(1, 0, At, B0); PG8_MMA(1, 1, At, B1); PG8_BAR; PG8_SCHED;
            PG8_LDB(B0, 1, 0); PG8_LDB(B1, 1, 1); PG8_SCHED; PG8_LDA(At, 1, 0); PG8_STAGE(PG8_SA(0, 1), a2 + hstep, voffA);
            PG8_WAIT_V(8); PG8_WAIT_L(0); PG8_BAR; PG8_MMA(0, 0, At, B0); PG8_MMA(0, 1, At, B1); PG8_BAR; PG8_SCHED;
            PG8_LDA(At, 1, 1); PG8_STAGE(PG8_SB(1, 0), b3, voffB); PG8_STAGE(PG8_SB(1, 1), b3 + hstep, voffB); PG8_STAGE(PG8_SA(1, 0), a3, voffA);
            PG8_WAIT_V(8); PG8_WAIT_L(0); PG8_BAR; PG8_MMA(1, 0, At, B0); PG8_MMA(1, 1, At, B1); PG8_BAR; PG8_SCHED;
            } else {
            PG8_LDB(B0, 0, 0); PG8_SCHED; PG8_LDA(At, 0, 0); PG8_STAGE(PG8_SA(1, 1), a1 + hstep, voffA);
            PG8_WAIT_L(8); PG8_BAR; PG8_WAIT_L(0); PG8_MMA(0, 0, At, B0); PG8_BAR; PG8_SCHED;
            PG8_LDB(B1, 0, 1); PG8_STAGE(PG8_SB(0, 0), b2, voffB);
            PG8_BAR; PG8_WAIT_L(0); PG8_MMA(0, 1, At, B1); PG8_BAR;
            PG8_LDA(At, 0, 1); PG8_STAGE(PG8_SA(0, 0), a2, voffA);
            PG8_BAR; PG8_WAIT_L(0); PG8_MMA(1, 0, At, B0); PG8_BAR; PG8_SCHED;
            PG8_STAGE(PG8_SB(0, 1), b2 + hstep, voffB);
            PG8_WAIT_V(6); PG8_BAR; PG8_MMA(1, 1, At, B1); PG8_BAR;
            PG8_LDB(B0, 1, 0); PG8_SCHED; PG8_LDA(At, 1, 0); PG8_STAGE(PG8_SA(0, 1), a2 + hstep, voffA);
            PG8_WAIT_L(8); PG8_BAR; PG8_WAIT_L(0); PG8_MMA(0, 0, At, B0); PG8_BAR; PG8_SCHED;
            PG8_LDB(B1, 1, 1); PG8_STAGE(PG8_SB(1, 0), b3, voffB);
            PG8_BAR; PG8_WAIT_L(0); PG8_MMA(0, 1, At, B1); PG8_BAR;
            PG8_LDA(At, 1, 1); PG8_STAGE(PG8_SA(1, 0), a3, voffA);
            PG8_BAR; PG8_WAIT_L(0); PG8_MMA(1, 0, At, B0); PG8_BAR; PG8_SCHED;
            PG8_STAGE(PG8_SB(1, 1), b3 + hstep, voffB);
            PG8_WAIT_V(6); PG8_BAR; PG8_MMA(1, 1, At, B1); PG8_BAR;
            }
        }
        if constexpr (ALIGN_EPI) { if (wr == 0) PG8_BAR; }
        if constexpr (!Epi::AFTER_DRAIN) { E(acc, cur, wr, wc, fr, fq); S.done(cur); }
        if (!has_next) break;
#pragma unroll
        for (int a = 0; a < 2; ++a)
#pragma unroll
            for (int b = 0; b < 2; ++b)
#pragma unroll
                for (int m = 0; m < 4; ++m)
#pragma unroll
                    for (int n = 0; n < 2; ++n) acc[a][b][m][n] = (f32x4){0.f, 0.f, 0.f, 0.f};
        cur = nxt; cA = nA; cB = nB; ++ui;
        if constexpr (ALIGN_EPI) { if (wr == 1) PG8_BAR; }
    }
    PG8_WAIT_V(0);
    if constexpr (!ALIGN_EPI) { if (wr == 0) PG8_BAR; }
    PG8_BAR;
    if constexpr (Epi::AFTER_DRAIN) { E.fused(acc, cur, wr, wc, fr, fq, lds, wid, lane); S.done(cur); }
#undef PG8_SA
#undef PG8_SB
#undef PG8_STAGE
#undef PG8_LDA
#undef PG8_LDB
#undef PG8_MMA
#undef PG8_WAIT_V
#undef PG8_WAIT_L
#undef PG8_BAR
#undef PG8_SCHED
}
}

#ifndef PG8_SP2
#define PG8_SP2 true
#endif
#ifndef PG8_ALIGN
#define PG8_ALIGN true
#endif

#define LAS __attribute__((address_space(3)))
typedef unsigned short bf16;
typedef unsigned v4u __attribute__((ext_vector_type(4)));
typedef unsigned v2u __attribute__((ext_vector_type(2)));
typedef float f32x4 __attribute__((ext_vector_type(4)));
typedef short bf16x8 __attribute__((ext_vector_type(8)));

constexpr int DM = 1024, NBATCH = 16, SEQ = 2048, DEPTH = 4, MROWS = NBATCH * SEQ, INC = 1932, ZC = 2048, FFH = 2816;
constexpr int NTHREADS = 512, NWAVES = 8;
constexpr int LDS_BYTES = 147456;
constexpr int ZC_AU = 0, ZC_AV = 256, ZC_BA = 512, ZC_BG = 768, ZC_Q = 1024, ZC_KC = 1280, ZC_VC = 1344, ZC_KS = 1408, ZC_VS = 1472, ZC_KW = 1536, ZC_VW = 1600, ZC_G = 1664, ZC_D = 1792;
constexpr size_t ZT = (size_t)NBATCH * SEQ * 256;
#define ZP(Zb, row, col) ((Zb) + (size_t)((col) >> 8) * ZT + (size_t)(row) * 256 + ((col) & 255))
constexpr size_t MiB = 1u << 20;
constexpr size_t WS_CTL = 0, CTL_BYTES = 16384;
constexpr size_t WS_W = 1 * MiB, WS_WL = 24 * MiB;
constexpr size_t WO_IN = 0, WO_OUT = 4 * MiB, WO_GU = 6 * MiB, WO_DN = 17 * MiB, WO_SG = 23 * MiB - 512 * 1024, WO_PW = WO_SG + 131072, WO_POOL = WO_PW + 131072, WO_W1K = WO_POOL + 32768, WO_W1V = WO_W1K + 262144;
static_assert(WO_DN + (size_t)1024 * 2816 * 2 <= WO_SG && WO_W1V + 262144 <= WS_WL, "weight map");
constexpr size_t WS_H = 98 * MiB, WS_Z = 162 * MiB, WS_MIX = 290 * MiB, WS_HID = 162 * MiB, WS_Y = 354 * MiB;
constexpr size_t WS_VTS = 482 * MiB, WS_VTW = 486 * MiB, WS_KC = 490 * MiB, WS_VCT = 490 * MiB + 262144, WS_R2 = 491 * MiB, WS_END = 493 * MiB;
static_assert(WS_HID + (size_t)MROWS * FFH * 2 <= WS_Y, "hid overlay");

#define LDS_WAIT() asm volatile("s_waitcnt lgkmcnt(0)" ::: "memory")
__device__ __forceinline__ float bflo(unsigned w) { return __uint_as_float(w << 16); }
__device__ __forceinline__ float bfhi(unsigned w) { return __uint_as_float(w & 0xffff0000u); }
__device__ __forceinline__ float bf2f(bf16 v) { return __uint_as_float((unsigned)v << 16); }
__device__ __forceinline__ unsigned f2bf(float f) { unsigned u = __float_as_uint(f); return (u + 0x7fffu + ((u >> 16) & 1u)) >> 16; }
__device__ __forceinline__ unsigned pk2(float lo, float hi) { unsigned r; asm("v_cvt_pk_bf16_f32 %0, %1, %2" : "=v"(r) : "v"(lo), "v"(hi)); return r; }
__device__ __forceinline__ float sigmoidf_(float x) { return __builtin_amdgcn_rcpf(1.0f + __builtin_amdgcn_exp2f(-1.4426950408889634f * x)); }
__device__ __forceinline__ float siluf_(float x) { return x * sigmoidf_(x); }
__device__ __forceinline__ float wave_sum(float v) {
#pragma unroll
    for (int o = 1; o < 64; o <<= 1) v += __shfl_xor(v, o);
    return v;
}
__device__ __forceinline__ f32x4 mfma16(v4u a, v4u b, f32x4 c) {
    return __builtin_amdgcn_mfma_f32_16x16x32_bf16(__builtin_bit_cast(bf16x8, a), __builtin_bit_cast(bf16x8, b), c, 0, 0, 0);
}

struct Args { const float* in[26]; float* out; unsigned char* ws; int ph_lo, ph_hi; };
typedef const __attribute__((address_space(4))) Args* ArgP;
enum { I_X = 0, I_GPM, I_GQM, I_GPF, I_GQF, I_WIN, I_SGLN, I_SGW, I_SGB, I_CVW, I_CVB, I_CVLG, I_CVLB, I_CVPW, I_CVPB, I_POSK, I_POSV, I_W1K, I_W2K, I_W1V, I_W2V, I_POOLW, I_POOLS, I_WOUT, I_GU, I_DN };

__device__ __forceinline__ void tr_item(const float* __restrict__ src, int Nsrc, int K, bf16* dst, int k0, int n0d, int nsrc0, int nvalid, LAS float* scr, int lane, const float* gk = nullptr) {
    const int kk8 = lane >> 3, n4 = (lane & 7) * 4; const bool ok = n4 < nvalid;
#pragma unroll
    for (int i = 0; i < 8; ++i) { const int kk = 8 * i + kk8; f32x4 v = (f32x4){0.f, 0.f, 0.f, 0.f};
        if (ok) { v = *(const f32x4*)(src + (size_t)(k0 + kk) * Nsrc + nsrc0 + n4); if (gk) v = v * gk[k0 + kk]; }
        LAS float* sp = scr + kk * 33 + n4; sp[0] = v.x; sp[1] = v.y; sp[2] = v.z; sp[3] = v.w; }
    LDS_WAIT();
    const int c = lane & 7;
#pragma unroll
    for (int j = 0; j < 4; ++j) { const int n = (lane >> 3) + 8 * j; const LAS float* s = scr + (8 * c) * 33 + n;
        v4u o; o.x = pk2(s[0 * 33], s[1 * 33]); o.y = pk2(s[2 * 33], s[3 * 33]); o.z = pk2(s[4 * 33], s[5 * 33]); o.w = pk2(s[6 * 33], s[7 * 33]);
        *(v4u*)(dst + (size_t)(n0d + n) * K + k0 + 8 * c) = o; }
    LDS_WAIT();
}
constexpr int TI_IN = 1024, TI_OUT = 512, TI_GU = 2816, TI_DN = 1408, TI_PW = 32, TI_POOL = 8, TI_W1 = 64;
constexpr int TI_LAYER = TI_IN + TI_OUT + TI_GU + TI_DN + TI_PW + TI_POOL + 2 * TI_W1;

__device__ __forceinline__ void prologue_item(ArgP A, int it, LAS float* scr, int lane) {
    const int l = it / TI_LAYER; int r = it % TI_LAYER;
    unsigned char* wl = A->ws + WS_W + (size_t)l * WS_WL;
    if (r < TI_IN) { const int kb = r >> 6, nb = r & 63, n0d = 32 * nb; int ns = n0d, nv = 32;
        if (n0d >= ZC_D) ns = 1676 + (n0d - ZC_D); else if (n0d == ZC_G) { ns = 1664; nv = 12; } else if (n0d > ZC_G) { ns = 0; nv = 0; }
        tr_item(A->in[I_WIN] + (size_t)l * DM * INC, INC, DM, (bf16*)(wl + WO_IN), 64 * kb, n0d, ns, nv, scr, lane, A->in[I_GPM] + l * DM); return; }
    r -= TI_IN;
    if (r < TI_OUT) { const int kb = r >> 5, nb = r & 31;
        tr_item(A->in[I_WOUT] + (size_t)l * DM * DM, DM, DM, (bf16*)(wl + WO_OUT), 64 * kb, 32 * nb, 32 * nb, 32, scr, lane); return; }
    r -= TI_OUT;
    if (r < TI_GU) { const int kb = r / 176, nb = r % 176, n0d = 32 * nb, pn = n0d >> 8, bj = (n0d >> 7) & 1, i0 = n0d & 127;
        tr_item(A->in[I_GU] + (size_t)l * DM * 2 * FFH, 2 * FFH, DM, (bf16*)(wl + WO_GU), 64 * kb, n0d, bj * FFH + 128 * pn + i0, 32, scr, lane, A->in[I_GPF] + l * DM); return; }
    r -= TI_GU;
    if (r < TI_DN) { const int kb = r >> 5, nb = r & 31;
        tr_item(A->in[I_DN] + (size_t)l * FFH * DM, DM, FFH, (bf16*)(wl + WO_DN), 64 * kb, 32 * nb, 32 * nb, 32, scr, lane); return; }
    r -= TI_DN;
    if (r < TI_PW) { const int kb = r >> 3, nb = r & 7;
        tr_item(A->in[I_CVPW] + (size_t)l * 65536, 256, 256, (bf16*)(wl + WO_PW), 64 * kb, 32 * nb, 32 * nb, 32, scr, lane); return; }
    r -= TI_PW;
    if (r < TI_POOL) { const int g = r >> 1, nb = r & 1;
        tr_item(A->in[I_POOLW] + (size_t)l * 16384 + g * 4096, 64, 64, (bf16*)(wl + WO_POOL) + g * 4096, 0, 32 * nb, 32 * nb, 32, scr, lane); return; }
    r -= TI_POOL;
    if (r < TI_W1) { const int kb = r >> 1, nb = r & 1;
        tr_item(A->in[I_W1K] + (size_t)l * 131072, 64, 2048, (bf16*)(wl + WO_W1K), 64 * kb, 32 * nb, 32 * nb, 32, scr, lane); return; }
    r -= TI_W1;
    { const int kb = r >> 1, nb = r & 1;
        tr_item(A->in[I_W1V] + (size_t)l * 131072, 64, 2048, (bf16*)(wl + WO_W1V), 64 * kb, 32 * nb, 32 * nb, 32, scr, lane); }
}

struct NRow { f32x4 x[4], y[4]; };
template <bool HASY>
__device__ __forceinline__ void nr_load(NRow& r, const float* xin, const float* y, int m, int lane) {
    const f32x4* xr = (const f32x4*)(xin + (size_t)m * DM) + lane;
#pragma unroll
    for (int j = 0; j < 4; ++j) r.x[j] = xr[64 * j];
    if (HASY) { const f32x4* yr = (const f32x4*)(y + (size_t)m * DM) + lane;
#pragma unroll
        for (int j = 0; j < 4; ++j) r.y[j] = yr[64 * j]; }
}
template <bool HASY, bool HASH>
__device__ __forceinline__ void nr_proc(NRow& r, const float* g1, float* xout, const float* g2, bf16* Hout, int m, int lane) {
    if (HASY) { float ss = 0.f;
#pragma unroll
        for (int j = 0; j < 4; ++j) ss += (r.y[j].x * r.y[j].x + r.y[j].y * r.y[j].y) + (r.y[j].z * r.y[j].z + r.y[j].w * r.y[j].w);
        const float rr = 1.0f / sqrtf(wave_sum(ss) * (1.0f / DM) + 1e-6f);
        f32x4* xo = (f32x4*)(xout + (size_t)m * DM) + lane;
#pragma unroll
        for (int j = 0; j < 4; ++j) { const f32x4 g = ((const f32x4*)g1)[lane + 64 * j]; r.x[j] = r.x[j] + (r.y[j] * rr) * g; xo[64 * j] = r.x[j]; } }
    if (HASH) { float ss = 0.f;
#pragma unroll
        for (int j = 0; j < 4; ++j) ss += (r.x[j].x * r.x[j].x + r.x[j].y * r.x[j].y) + (r.x[j].z * r.x[j].z + r.x[j].w * r.x[j].w);
        const float rr = 1.0f / sqrtf(wave_sum(ss) * (1.0f / DM) + 1e-6f);
        v2u* ho = (v2u*)(Hout + (size_t)m * DM) + lane;
#pragma unroll
        for (int j = 0; j < 4; ++j) { const f32x4 g = ((const f32x4*)g2)[lane + 64 * j]; const f32x4 o = (r.x[j] * rr) * g; v2u w; w.x = pk2(o.x, o.y); w.y = pk2(o.z, o.w); ho[64 * j] = w; } }
}
template <bool HASY, bool HASH>
__device__ __forceinline__ void norm_rows(const float* xin, const float* y, const float* g1, float* xout, const float* g2, bf16* Hout, int gw, int ngw, int lane) {
    if ((MROWS % (2 * ngw)) == 0) {
        for (int m = gw; m < MROWS; m += 2 * ngw) {
            NRow ra, rb;
            nr_load<HASY>(ra, xin, y, m, lane); nr_load<HASY>(rb, xin, y, m + ngw, lane);
            nr_proc<HASY, HASH>(ra, g1, xout, g2, Hout, m, lane); nr_proc<HASY, HASH>(rb, g1, xout, g2, Hout, m + ngw, lane);
        }
    } else {
        for (int m = gw; m < MROWS; m += ngw) { NRow ra; nr_load<HASY>(ra, xin, y, m, lane); nr_proc<HASY, HASH>(ra, g1, xout, g2, Hout, m, lane); }
    }
}

__device__ __forceinline__ void norm_first(const float* xin, bf16* XB, float* R2, int bid, int G, int wave, int lane) {
    for (int c = bid; c < MROWS / 32; c += G)
        for (int i = 0; i < 4; ++i) { const int m = 32 * c + wave + 8 * i;
            const f32x4* xr = (const f32x4*)(xin + (size_t)m * DM) + lane; f32x4 xv[4]; float ss = 0.f;
#pragma unroll
            for (int j = 0; j < 4; ++j) { xv[j] = xr[64 * j]; ss += (xv[j].x * xv[j].x + xv[j].y * xv[j].y) + (xv[j].z * xv[j].z + xv[j].w * xv[j].w); }
            const float r = 1.0f / sqrtf(wave_sum(ss) * (1.0f / DM) + 1e-6f);
            if (lane == 0) R2[m] = r;
            v2u* ho = (v2u*)(XB + (size_t)m * DM) + lane;
#pragma unroll
            for (int j = 0; j < 4; ++j) { v2u w; w.x = pk2(xv[j].x, xv[j].y); w.y = pk2(xv[j].z, xv[j].w); ho[64 * j] = w; }
        }
}
template <bool LAST, int NR>
__device__ __forceinline__ void norm_bf_rows(const bf16* XB, bf16* XO, const bf16* Yb, const f32x4 (&g)[2][2], float* R2, float* out, int m0, int ngw, int lane) {
    v4u xw[NR][2], yw[NR][2];
#pragma unroll
    for (int r = 0; r < NR; ++r)
#pragma unroll
        for (int j = 0; j < 2; ++j) { const size_t o = (size_t)(m0 + r * ngw) * DM + 8 * lane + 512 * j; xw[r][j] = *(const v4u*)(XB + o); yw[r][j] = *(const v4u*)(Yb + o); }
#pragma unroll
    for (int r = 0; r < NR; ++r) { const int m = m0 + r * ngw;
        float xv[2][8], yv[2][8]; float ss = 0.f;
#pragma unroll
        for (int j = 0; j < 2; ++j) {
            xv[j][0] = bflo(xw[r][j].x); xv[j][1] = bfhi(xw[r][j].x); xv[j][2] = bflo(xw[r][j].y); xv[j][3] = bfhi(xw[r][j].y); xv[j][4] = bflo(xw[r][j].z); xv[j][5] = bfhi(xw[r][j].z); xv[j][6] = bflo(xw[r][j].w); xv[j][7] = bfhi(xw[r][j].w);
            yv[j][0] = bflo(yw[r][j].x); yv[j][1] = bfhi(yw[r][j].x); yv[j][2] = bflo(yw[r][j].y); yv[j][3] = bfhi(yw[r][j].y); yv[j][4] = bflo(yw[r][j].z); yv[j][5] = bfhi(yw[r][j].z); yv[j][6] = bflo(yw[r][j].w); yv[j][7] = bfhi(yw[r][j].w);
#pragma unroll
            for (int e = 0; e < 8; ++e) ss += yv[j][e] * yv[j][e]; }
        const float rr = 1.0f / sqrtf(wave_sum(ss) * (1.0f / DM) + 1e-6f);
        float s2 = 0.f;
#pragma unroll
        for (int j = 0; j < 2; ++j)
#pragma unroll
            for (int e = 0; e < 8; ++e) { xv[j][e] = xv[j][e] + (yv[j][e] * rr) * g[j][e >> 2][e & 3]; s2 += xv[j][e] * xv[j][e]; }
        if (LAST) {
#pragma unroll
            for (int j = 0; j < 2; ++j) { f32x4* op = (f32x4*)(out + (size_t)m * DM + 8 * lane + 512 * j); op[0] = (f32x4){xv[j][0], xv[j][1], xv[j][2], xv[j][3]}; op[1] = (f32x4){xv[j][4], xv[j][5], xv[j][6], xv[j][7]}; }
        } else {
            const float r2 = 1.0f / sqrtf(wave_sum(s2) * (1.0f / DM) + 1e-6f);
            if (lane == 0) R2[m] = r2;
#pragma unroll
            for (int j = 0; j < 2; ++j) { v4u w; w.x = pk2(xv[j][0], xv[j][1]); w.y = pk2(xv[j][2], xv[j][3]); w.z = pk2(xv[j][4], xv[j][5]); w.w = pk2(xv[j][6], xv[j][7]);
                *(v4u*)(XO + (size_t)m * DM + 8 * lane + 512 * j) = w; }
        }
    }
}
template <bool LAST>
__device__ __forceinline__ void norm_bf(const bf16* XB, bf16* XO, const bf16* Yb, const float* g1, float* R2, float* out, int bid, int G, int wave, int lane) {
    f32x4 g[2][2];
#pragma unroll
    for (int j = 0; j < 2; ++j) { g[j][0] = *(const f32x4*)(g1 + 8 * lane + 512 * j); g[j][1] = *(const f32x4*)(g1 + 8 * lane + 512 * j + 4); }
    for (int c = bid; c < MROWS / 32; c += G) norm_bf_rows<LAST, 4>(XB, XO, Yb, g, R2, out, 32 * c + wave, 8, lane);
}

__device__ __forceinline__ void mixer_a(ArgP A, int l, int item, LAS unsigned char* lds, int tid, int wave, int lane) {
    const bf16* Z = (const bf16*)(A->ws + WS_Z); bf16* MIX = (bf16*)(A->ws + WS_MIX);
    const bf16* sgw = (const bf16*)(A->ws + WS_W + (size_t)l * WS_WL + WO_SG);
    const int b = item >> 4, ch = item & 15; const size_t r0 = (size_t)b * SEQ + 128 * ch;
    LAS bf16* VT = (LAS bf16*)lds;
    LAS float* ST = (LAS float*)(lds + 69632);
    { const int s = tid >> 2, qd = tid & 3; float sm = 0.f, sq = 0.f;
#pragma unroll
        for (int i = 0; i < 8; ++i) { const v4u w = *(const v4u*)ZP(Z, r0 + s, ZC_AV + 64 * qd + 8 * i);
            const float a0 = bflo(w.x), a1 = bfhi(w.x), a2 = bflo(w.y), a3 = bfhi(w.y), a4 = bflo(w.z), a5 = bfhi(w.z), a6 = bflo(w.w), a7 = bfhi(w.w);
            sm += ((a0 + a1) + (a2 + a3)) + ((a4 + a5) + (a6 + a7)); sq += ((a0 * a0 + a1 * a1) + (a2 * a2 + a3 * a3)) + ((a4 * a4 + a5 * a5) + (a6 * a6 + a7 * a7)); }
        sm += __shfl_xor(sm, 1); sq += __shfl_xor(sq, 1); sm += __shfl_xor(sm, 2); sq += __shfl_xor(sq, 2);
        const float mu = sm * (1.0f / 256.0f), var = fmaxf(sq * (1.0f / 256.0f) - mu * mu, 0.f);
        if (qd == 0) { ST[2 * s] = mu; ST[2 * s + 1] = 1.0f / sqrtf(var + 1e-5f); } }
    __syncthreads();
    { const int s = tid & 127, og = tid >> 7; const float mu = ST[2 * s], rs = ST[2 * s + 1];
        const float* gp = A->in[I_SGLN] + l * 256;
#pragma unroll 2
        for (int i = 0; i < 8; ++i) { const int oct = og + 4 * i;
            const v4u w = *(const v4u*)ZP(Z, r0 + s, ZC_AV + 8 * oct);
            const f32x4 g0 = *(const f32x4*)(gp + 8 * oct), g1 = *(const f32x4*)(gp + 8 * oct + 4);
            LAS bf16* vp = VT + (8 * oct) * 136 + s;
            vp[0 * 136] = (bf16)f2bf((bflo(w.x) - mu) * rs * g0.x); vp[1 * 136] = (bf16)f2bf((bfhi(w.x) - mu) * rs * g0.y);
            vp[2 * 136] = (bf16)f2bf((bflo(w.y) - mu) * rs * g0.z); vp[3 * 136] = (bf16)f2bf((bfhi(w.y) - mu) * rs * g0.w);
            vp[4 * 136] = (bf16)f2bf((bflo(w.z) - mu) * rs * g1.x); vp[5 * 136] = (bf16)f2bf((bfhi(w.z) - mu) * rs * g1.y);
            vp[6 * 136] = (bf16)f2bf((bflo(w.w) - mu) * rs * g1.z); vp[7 * 136] = (bf16)f2bf((bfhi(w.w) - mu) * rs * g1.w); } }
    __syncthreads();
    const int h = wave >> 1, th = wave & 1, fr = lane & 15, q = lane >> 4;
    f32x4 acc[4][4];
#pragma unroll
    for (int a = 0; a < 4; ++a)
#pragma unroll
        for (int c = 0; c < 4; ++c) acc[a][c] = (f32x4){0.f, 0.f, 0.f, 0.f};
    const bf16* Wb = sgw + (size_t)h * 128 * 128;
#pragma unroll 2
    for (int ks = 0; ks < 4; ++ks) {
        v4u vf[4];
#pragma unroll
        for (int nt = 0; nt < 4; ++nt) vf[nt] = *(const LAS v4u*)(VT + (64 * h + 16 * nt + fr) * 136 + 32 * ks + 8 * q);
#pragma unroll
        for (int mt = 0; mt < 4; ++mt) { const int t = 64 * th + 16 * mt + fr; const v4u wf = *(const v4u*)(Wb + t * 128 + 32 * ks + 8 * q);
#pragma unroll
            for (int nt = 0; nt < 4; ++nt) acc[mt][nt] = mfma16(vf[nt], wf, acc[mt][nt]); }
    }
#pragma unroll
    for (int mt = 0; mt < 4; ++mt) { const int t = 64 * th + 16 * mt + fr; const float bias = A->in[I_SGB][l * 512 + h * 128 + t];
#pragma unroll
        for (int nt = 0; nt < 4; ++nt) { const int d0 = 64 * h + 16 * nt + 4 * q;
            const v2u uw = *(const v2u*)ZP(Z, r0 + t, ZC_AU + d0); const f32x4 a = acc[mt][nt];
            v2u o; o.x = pk2(bflo(uw.x) * (a.x + bias), bfhi(uw.x) * (a.y + bias)); o.y = pk2(bflo(uw.y) * (a.z + bias), bfhi(uw.y) * (a.w + bias));
            *(v2u*)(MIX + (r0 + t) * DM + d0) = o; } }
    __syncthreads();
}

__device__ __forceinline__ void mixer_b(ArgP A, int l, int item, LAS unsigned char* lds, int tid, int wave, int lane) {
    const bf16* Z = (const bf16*)(A->ws + WS_Z); bf16* MIX = (bf16*)(A->ws + WS_MIX);
    const bf16* pwt = (const bf16*)(A->ws + WS_W + (size_t)l * WS_WL + WO_PW);
    const int b = item >> 5, tau = item & 31, t0 = 64 * tau; const size_t r0 = (size_t)b * SEQ + t0;
    LAS bf16* Ht = (LAS bf16*)lds;
    LAS float* CO = (LAS float*)(lds + 49152);
    LAS bf16* AT = (LAS bf16*)lds;
    {
        v4u av[6], gv[6];
#pragma unroll
        for (int it_ = 0; it_ < 6; ++it_) { int idx = tid + it_ * NTHREADS; idx = idx < 94 * 32 ? idx : 94 * 32 - 1; const int i = idx >> 5, oct = idx & 31, t = t0 - 30 + i;
            const size_t zr = (size_t)b * SEQ + (t > 0 ? t : 0); av[it_] = *(const v4u*)ZP(Z, zr, ZC_BA + 8 * oct); gv[it_] = *(const v4u*)ZP(Z, zr, ZC_BG + 8 * oct); }
#pragma unroll
        for (int it_ = 0; it_ < 6; ++it_) { const int idx = tid + it_ * NTHREADS; if (idx < 94 * 32) { const int i = idx >> 5, oct = idx & 31, t = t0 - 30 + i; v4u o = (v4u){0u, 0u, 0u, 0u};
                if (t >= 0) { const v4u a = av[it_], g = gv[it_];
                    o.x = pk2(bflo(a.x) * sigmoidf_(bflo(g.x)), bfhi(a.x) * sigmoidf_(bfhi(g.x))); o.y = pk2(bflo(a.y) * sigmoidf_(bflo(g.y)), bfhi(a.y) * sigmoidf_(bfhi(g.y)));
                    o.z = pk2(bflo(a.z) * sigmoidf_(bflo(g.z)), bfhi(a.z) * sigmoidf_(bfhi(g.z))); o.w = pk2(bflo(a.w) * sigmoidf_(bflo(g.w)), bfhi(a.w) * sigmoidf_(bfhi(g.w))); }
                *(LAS v4u*)(Ht + i * 256 + 8 * oct) = o; } }
    }
    __syncthreads();
    { const int c = tid & 255, half = tid >> 8; float wt[31];
#pragma unroll
        for (int w = 0; w < 31; ++w) wt[w] = A->in[I_CVW][(size_t)l * 31 * 256 + w * 256 + c];
        const float bias = A->in[I_CVB][l * 256 + c];
#pragma unroll 1
        for (int tg = 0; tg < 4; ++tg) { const int tb = 32 * half + 8 * tg; float ac[8];
#pragma unroll
            for (int j = 0; j < 8; ++j) ac[j] = bias;
#pragma unroll
            for (int i = 0; i < 38; ++i) { const float hv = bf2f(Ht[(tb + i) * 256 + c]);
#pragma unroll
                for (int j = 0; j < 8; ++j) if (i - j >= 0 && i - j < 31) ac[j] += hv * wt[i - j]; }
#pragma unroll
            for (int j = 0; j < 8; ++j) CO[(tb + j) * 256 + c] = ac[j]; } }
    __syncthreads();
    v4u bpf[8][2];
#pragma unroll
    for (int ks = 0; ks < 8; ++ks)
#pragma unroll
        for (int nt = 0; nt < 2; ++nt) bpf[ks][nt] = *(const v4u*)(pwt + (32 * wave + 16 * nt + (lane & 15)) * 256 + 32 * ks + 8 * (lane >> 4));
    { const f32x4 g = *(const f32x4*)(A->in[I_CVLG] + l * 256 + 4 * lane), bb = *(const f32x4*)(A->in[I_CVLB] + l * 256 + 4 * lane);
#if MIXB_LNNEW
        f32x4 v[8]; float sm[8];
#pragma unroll
        for (int i = 0; i < 8; ++i) { v[i] = *(const LAS f32x4*)(CO + (8 * wave + i) * 256 + 4 * lane); sm[i] = (v[i].x + v[i].y) + (v[i].z + v[i].w); }
#pragma unroll
        for (int o = 1; o < 64; o <<= 1)
#pragma unroll
            for (int i = 0; i < 8; ++i) sm[i] += __shfl_xor(sm[i], o);
#pragma unroll
        for (int i = 0; i < 8; ++i) { v[i] = v[i] - sm[i] * (1.0f / 256.0f); sm[i] = (v[i].x * v[i].x + v[i].y * v[i].y) + (v[i].z * v[i].z + v[i].w * v[i].w); }
#pragma unroll
        for (int o = 1; o < 64; o <<= 1)
#pragma unroll
            for (int i = 0; i < 8; ++i) sm[i] += __shfl_xor(sm[i], o);
#pragma unroll
        for (int i = 0; i < 8; ++i) { const float rs = 1.0f / sqrtf(sm[i] * (1.0f / 256.0f) + 1e-5f);
            const f32x4 y = (v[i] * rs) * g + bb; v2u o; o.x = pk2(siluf_(y.x), siluf_(y.y)); o.y = pk2(siluf_(y.z), siluf_(y.w));
            *(LAS v2u*)(AT + (8 * wave + i) * 264 + 4 * lane) = o; } }
#else
        for (int i = 0; i < 8; ++i) { const int t = 8 * wave + i; const f32x4 v = *(const LAS f32x4*)(CO + t * 256 + 4 * lane);
            const float mu = wave_sum((v.x + v.y) + (v.z + v.w)) * (1.0f / 256.0f); const f32x4 d = v - mu;
            const float var = wave_sum((d.x * d.x + d.y * d.y) + (d.z * d.z + d.w * d.w)) * (1.0f / 256.0f); const float rs = 1.0f / sqrtf(var + 1e-5f);
            const f32x4 y = (d * rs) * g + bb; v2u o; o.x = pk2(siluf_(y.x), siluf_(y.y)); o.y = pk2(siluf_(y.z), siluf_(y.w));
            *(LAS v2u*)(AT + t * 264 + 4 * lane) = o; } }
#endif
    __syncthreads();
    const int fr = lane & 15, q = lane >> 4;
    f32x4 acc[4][2];
#pragma unroll
    for (int a = 0; a < 4; ++a)
#pragma unroll
        for (int c = 0; c < 2; ++c) acc[a][c] = (f32x4){0.f, 0.f, 0.f, 0.f};
#pragma unroll
    for (int ks = 0; ks < 8; ++ks) {
#pragma unroll
        for (int mt = 0; mt < 4; ++mt) { const v4u af = *(const LAS v4u*)(AT + (16 * mt + fr) * 264 + 32 * ks + 8 * q);
#pragma unroll
            for (int nt = 0; nt < 2; ++nt) acc[mt][nt] = mfma16(bpf[ks][nt], af, acc[mt][nt]); } }
#pragma unroll
    for (int mt = 0; mt < 4; ++mt)
#pragma unroll
        for (int nt = 0; nt < 2; ++nt) { const int n0 = 32 * wave + 16 * nt + 4 * q; const f32x4 pb = *(const f32x4*)(A->in[I_CVPB] + l * 256 + n0); const f32x4 o = acc[mt][nt] + pb;
            v2u w; w.x = pk2(o.x, o.y); w.y = pk2(o.z, o.w); *(v2u*)(MIX + (r0 + 16 * mt + fr) * DM + 256 + n0) = w; }
    __syncthreads();
}

template <int W>
__device__ __forceinline__ void pool_means(const LAS bf16* Xt, LAS bf16* AT, int c, int half, int t0) {
    float xv[47];
#pragma unroll
    for (int i = 0; i < 47; ++i) xv[i] = (i >= 16 - W) ? bf2f(Xt[(32 * half + i) * 256 + c]) : 0.f;
    float s = 0.f;
#pragma unroll
    for (int i = 0; i < W; ++i) s += xv[15 - i];
#pragma unroll
    for (int j = 0; j < 32; ++j) { const int jj = 32 * half + j, t = t0 + jj;
        if (j > 0) s += xv[15 + j] - xv[15 + j - W];
        const int cnt = (t + 1 < W) ? (t + 1) : W;
        AT[jj * 264 + c] = (bf16)f2bf(s / (float)cnt - xv[15 + j]); }
}

__device__ __forceinline__ void mixer_d(ArgP A, int l, int item, LAS unsigned char* lds, int tid, int wave, int lane) {
    const bf16* Z = (const bf16*)(A->ws + WS_Z); bf16* MIX = (bf16*)(A->ws + WS_MIX);
    const bf16* poolt = (const bf16*)(A->ws + WS_W + (size_t)l * WS_WL + WO_POOL);
    bf16* VTS = (bf16*)(A->ws + WS_VTS); bf16* VTW = (bf16*)(A->ws + WS_VTW);
    const int b = item >> 5, tau = item & 31, t0 = 64 * tau; const size_t r0 = (size_t)b * SEQ + t0;
    LAS bf16* Xt = (LAS bf16*)lds;
    LAS bf16* AT = (LAS bf16*)(lds + 40960);
    LAS bf16* TS = (LAS bf16*)(lds + 75776);
    {
        v4u xv[5];
#pragma unroll
        for (int it_ = 0; it_ < 5; ++it_) { int idx = tid + it_ * NTHREADS; idx = idx < 79 * 32 ? idx : 79 * 32 - 1; const int i = idx >> 5, oct = idx & 31, t = t0 - 15 + i;
            xv[it_] = *(const v4u*)ZP(Z, (size_t)b * SEQ + (t > 0 ? t : 0), ZC_D + 8 * oct); }
#pragma unroll
        for (int it_ = 0; it_ < 5; ++it_) { const int idx = tid + it_ * NTHREADS; if (idx < 79 * 32) { const int i = idx >> 5, oct = idx & 31, t = t0 - 15 + i;
                *(LAS v4u*)(Xt + i * 256 + 8 * oct) = (t >= 0) ? xv[it_] : (v4u){0u, 0u, 0u, 0u}; } }
    }
    { const int tok = tid & 63, oct = tid >> 6;
        const v4u a = *(const v4u*)ZP(Z, r0 + tok, ZC_VS + 8 * oct), c = *(const v4u*)ZP(Z, r0 + tok, ZC_VW + 8 * oct);
        LAS bf16* p0 = TS + (8 * oct) * 72 + tok; LAS bf16* p1 = p0 + 4608;
        p0[0] = (bf16)(a.x & 0xffffu); p0[72] = (bf16)(a.x >> 16); p0[144] = (bf16)(a.y & 0xffffu); p0[216] = (bf16)(a.y >> 16);
        p0[288] = (bf16)(a.z & 0xffffu); p0[360] = (bf16)(a.z >> 16); p0[432] = (bf16)(a.w & 0xffffu); p0[504] = (bf16)(a.w >> 16);
        p1[0] = (bf16)(c.x & 0xffffu); p1[72] = (bf16)(c.x >> 16); p1[144] = (bf16)(c.y & 0xffffu); p1[216] = (bf16)(c.y >> 16);
        p1[288] = (bf16)(c.z & 0xffffu); p1[360] = (bf16)(c.z >> 16); p1[432] = (bf16)(c.w & 0xffffu); p1[504] = (bf16)(c.w >> 16); }
    __syncthreads();
#if MIXD_NEW
    { const int c = tid & 255, half = tid >> 8, g = c >> 6;
        if (g == 0) pool_means<2>(Xt, AT, c, half, t0); else if (g == 1) pool_means<4>(Xt, AT, c, half, t0); else if (g == 2) pool_means<8>(Xt, AT, c, half, t0); else pool_means<16>(Xt, AT, c, half, t0); }
#else
    { const int c = tid & 255, half = tid >> 8, g = c >> 6, w = 2 << g;
        for (int j = 0; j < 32; ++j) { const int jj = 32 * half + j, t = t0 + jj; float s = 0.f;
            for (int i = 0; i < w; ++i) s += bf2f(Xt[(15 + jj - i) * 256 + c]);
            const int cnt = (t + 1 < w) ? (t + 1) : w;
            const float mval = s / (float)cnt - bf2f(Xt[(15 + jj) * 256 + c]);
            AT[jj * 264 + c] = (bf16)f2bf(mval); } }
#endif
    { const int d = tid >> 3, pc = tid & 7;
        *(v4u*)(VTS + ((size_t)b * 64 + d) * SEQ + t0 + 8 * pc) = *(const LAS v4u*)(TS + d * 72 + 8 * pc);
        *(v4u*)(VTW + ((size_t)b * 64 + d) * SEQ + t0 + 8 * pc) = *(const LAS v4u*)(TS + 4608 + d * 72 + 8 * pc); }
    __syncthreads();
    const int fr = lane & 15, q = lane >> 4, g = wave >> 1, nh = wave & 1;
    f32x4 acc[4][2];
#pragma unroll
    for (int a = 0; a < 4; ++a)
#pragma unroll
        for (int c = 0; c < 2; ++c) acc[a][c] = (f32x4){0.f, 0.f, 0.f, 0.f};
#pragma unroll
    for (int ks = 0; ks < 2; ++ks) { v4u bfr[2];
#pragma unroll
        for (int nt = 0; nt < 2; ++nt) bfr[nt] = *(const v4u*)(poolt + g * 4096 + (32 * nh + 16 * nt + fr) * 64 + 32 * ks + 8 * q);
#pragma unroll
        for (int mt = 0; mt < 4; ++mt) { const v4u af = *(const LAS v4u*)(AT + (16 * mt + fr) * 264 + 64 * g + 32 * ks + 8 * q);
#pragma unroll
            for (int nt = 0; nt < 2; ++nt) acc[mt][nt] = mfma16(bfr[nt], af, acc[mt][nt]); } }
#pragma unroll
    for (int mt = 0; mt < 4; ++mt)
#pragma unroll
        for (int nt = 0; nt < 2; ++nt) { const int n0 = 64 * g + 32 * nh + 16 * nt + 4 * q; const f32x4 sc = *(const f32x4*)(A->in[I_POOLS] + l * 256 + n0); const f32x4 o = acc[mt][nt] * sc;
            v2u w; w.x = pk2(o.x, o.y); w.y = pk2(o.z, o.w); *(v2u*)(MIX + (r0 + 16 * mt + fr) * DM + 768 + n0) = w; }
    __syncthreads();
}

__device__ __forceinline__ void nsa_compress(ArgP A, int l, int item, LAS unsigned char* lds, int tid, int wave, int lane) {
    const bf16* Z = (const bf16*)(A->ws + WS_Z);
    bf16* KC = (bf16*)(A->ws + WS_KC); bf16* VCT = (bf16*)(A->ws + WS_VCT);
    const int b = item >> 4, kv = (item >> 3) & 1, mt = item & 7;
    const int colb = kv ? ZC_VC : ZC_KC;
    const float* pos = A->in[kv ? I_POSV : I_POSK] + l * 2048;
    const bf16* w1t = (const bf16*)(A->ws + WS_W + (size_t)l * WS_WL + (kv ? WO_W1V : WO_W1K));
    const float* w2 = A->in[kv ? I_W2V : I_W2K] + l * 4096;
    LAS float* RED = (LAS float*)lds;
    LAS float* H1 = (LAS float*)(lds + 32768);
    const int fr = lane & 15, q = lane >> 4, c = 16 * mt + fr; const bool cok = c < 127;
    f32x4 acc[4];
#pragma unroll
    for (int n = 0; n < 4; ++n) acc[n] = (f32x4){0.f, 0.f, 0.f, 0.f};
#pragma unroll 4
    for (int kk = 0; kk < 8; ++kk) { const int ks = 8 * wave + kk, ltok = ks >> 1, dd = 32 * (ks & 1) + 8 * q;
        v4u af = (v4u){0u, 0u, 0u, 0u};
        if (cok) { const v4u zw = *(const v4u*)ZP(Z, (size_t)b * SEQ + 16 * c + ltok, colb + dd);
            const f32x4 p0 = *(const f32x4*)(pos + ltok * 64 + dd), p1 = *(const f32x4*)(pos + ltok * 64 + dd + 4);
            af.x = pk2(bflo(zw.x) + p0.x, bfhi(zw.x) + p0.y); af.y = pk2(bflo(zw.y) + p0.z, bfhi(zw.y) + p0.w);
            af.z = pk2(bflo(zw.z) + p1.x, bfhi(zw.z) + p1.y); af.w = pk2(bflo(zw.w) + p1.z, bfhi(zw.w) + p1.w); }
#pragma unroll
        for (int nt = 0; nt < 4; ++nt) { const v4u bfr = *(const v4u*)(w1t + (16 * nt + fr) * 2048 + 32 * ks + 8 * q); acc[nt] = mfma16(af, bfr, acc[nt]); } }
#pragma unroll
    for (int nt = 0; nt < 4; ++nt)
#pragma unroll
        for (int rg = 0; rg < 4; ++rg) RED[(wave * 16 + 4 * q + rg) * 64 + 16 * nt + fr] = acc[nt][rg];
    __syncthreads();
#pragma unroll
    for (int x = 0; x < 2; ++x) { const int o = tid + 512 * x, cc = o >> 6, n = o & 63; float s = 0.f;
#pragma unroll
        for (int w = 0; w < 8; ++w) s += RED[(w * 16 + cc) * 64 + n];
        H1[o] = siluf_(s); }
    __syncthreads();
#pragma unroll
    for (int x = 0; x < 2; ++x) { const int o = tid + 512 * x, cc = o >> 6, n2 = o & 63; float s = 0.f;
        for (int n = 0; n < 64; ++n) s += H1[cc * 64 + n] * w2[n * 64 + n2];
        const int cg_ = 16 * mt + cc;
        (kv == 0 ? KC : VCT)[((size_t)b * 128 + cg_) * 64 + n2] = (bf16)f2bf(s); }
    __syncthreads();
}

template <int HA, int HB, class MaskA, class MaskB>
__device__ __forceinline__ void attn_pair(const LAS bf16* KT, const LAS bf16* VT, const v4u (&qf)[2], int fr, int q, float& m_run, f32x4& o5, f32x4 (&o)[4],
                                          float rba, float rbb, bool ma, bool mb, MaskA okA, MaskB okB) {
    constexpr int N0 = HA ? 0 : 4, N1 = HB ? 8 : 4, K0 = HA ? 0 : 2, K1 = HB ? 4 : 2;
    v4u kf0[8], kf1[8];
#pragma unroll
    for (int nt = N0; nt < N1; ++nt) { kf0[nt] = *(const LAS v4u*)(KT + (16 * nt + fr) * 72 + 8 * q); kf1[nt] = *(const LAS v4u*)(KT + (16 * nt + fr) * 72 + 32 + 8 * q); }
    __builtin_amdgcn_sched_barrier(0);
    f32x4 s[8];
#pragma unroll
    for (int nt = N0; nt < N1; ++nt) { const float rb = nt < 4 ? rba : rbb;
        s[nt] = mfma16(kf0[nt], qf[0], (f32x4){rb, rb, rb, rb}); s[nt] = mfma16(kf1[nt], qf[1], s[nt]); }
    __builtin_amdgcn_sched_barrier(0);
    v2u vfa[4][4], vfb[4][4];
#pragma unroll
    for (int k2 = K0; k2 < K1; ++k2)
#pragma unroll
        for (int dt = 0; dt < 4; ++dt) { vfa[k2][dt] = *(const LAS v2u*)(VT + (16 * dt + fr) * 136 + 32 * k2 + 4 * q); vfb[k2][dt] = *(const LAS v2u*)(VT + (16 * dt + fr) * 136 + 32 * k2 + 16 + 4 * q); }
    __builtin_amdgcn_sched_barrier(0);
    if (HA && ma) {
#pragma unroll
        for (int nt = 0; nt < 4; ++nt)
#pragma unroll
            for (int rg = 0; rg < 4; ++rg) s[nt][rg] = okA(16 * nt + 4 * q + rg) ? s[nt][rg] : -1e30f; }
    if (HB && mb) {
#pragma unroll
        for (int nt = 0; nt < 4; ++nt)
#pragma unroll
            for (int rg = 0; rg < 4; ++rg) s[4 + nt][rg] = okB(16 * nt + 4 * q + rg) ? s[4 + nt][rg] : -1e30f; }
    float mx = m_run;
#pragma unroll
    for (int nt = N0; nt < N1; ++nt)
#pragma unroll
        for (int rg = 0; rg < 4; ++rg) mx = fmaxf(mx, s[nt][rg]);
    mx = fmaxf(mx, __shfl_xor(mx, 16)); mx = fmaxf(mx, __shfl_xor(mx, 32));
    if (__ballot(mx != m_run) != 0ull) {
        const float sc = __builtin_amdgcn_exp2f(m_run - mx); m_run = mx; o5 = o5 * sc;
#pragma unroll
        for (int dt = 0; dt < 4; ++dt) o[dt] = o[dt] * sc; }
#pragma unroll
    for (int nt = N0; nt < N1; ++nt)
#pragma unroll
        for (int rg = 0; rg < 4; ++rg) s[nt][rg] = __builtin_amdgcn_exp2f(s[nt][rg] - mx);
    const unsigned onesw = (fr == 0) ? 0x3f803f80u : 0u; const v4u vones = (v4u){onesw, onesw, onesw, onesw};
#pragma unroll
    for (int k2 = K0; k2 < K1; ++k2) { v4u pf; pf.x = pk2(s[2 * k2][0], s[2 * k2][1]); pf.y = pk2(s[2 * k2][2], s[2 * k2][3]); pf.z = pk2(s[2 * k2 + 1][0], s[2 * k2 + 1][1]); pf.w = pk2(s[2 * k2 + 1][2], s[2 * k2 + 1][3]);
        o5 = mfma16(vones, pf, o5);
#pragma unroll
        for (int dt = 0; dt < 4; ++dt) { v4u vf; vf.x = vfa[k2][dt].x; vf.y = vfa[k2][dt].y; vf.z = vfb[k2][dt].x; vf.w = vfb[k2][dt].y; o[dt] = mfma16(vf, pf, o[dt]); } }
}

template <class MaskF>
__device__ __forceinline__ void attn_tile2(const LAS bf16* KT, const LAS bf16* VT, const v4u (&qf)[2][2], int fr, int q, float (&m_run)[2], f32x4 (&o5)[2], f32x4 (&o)[2][4],
                                           const bool (&need)[2], const float (&rb)[2], bool masked, MaskF okf) {
    v4u kf0[4], kf1[4];
#pragma unroll
    for (int nt = 0; nt < 4; ++nt) { kf0[nt] = *(const LAS v4u*)(KT + (16 * nt + fr) * 72 + 8 * q); kf1[nt] = *(const LAS v4u*)(KT + (16 * nt + fr) * 72 + 32 + 8 * q); }
    __builtin_amdgcn_sched_barrier(0);
    f32x4 s[2][4];
#pragma unroll
    for (int g = 0; g < 2; ++g) if (need[g]) {
#pragma unroll
        for (int nt = 0; nt < 4; ++nt) { s[g][nt] = mfma16(kf0[nt], qf[g][0], (f32x4){rb[g], rb[g], rb[g], rb[g]}); s[g][nt] = mfma16(kf1[nt], qf[g][1], s[g][nt]); } }
    __builtin_amdgcn_sched_barrier(0);
    v2u vfa[2][4], vfb[2][4];
#pragma unroll
    for (int k2 = 0; k2 < 2; ++k2)
#pragma unroll
        for (int dt = 0; dt < 4; ++dt) { vfa[k2][dt] = *(const LAS v2u*)(VT + (16 * dt + fr) * 72 + 32 * k2 + 4 * q); vfb[k2][dt] = *(const LAS v2u*)(VT + (16 * dt + fr) * 72 + 32 * k2 + 16 + 4 * q); }
    __builtin_amdgcn_sched_barrier(0);
    const unsigned onesw = (fr == 0) ? 0x3f803f80u : 0u; const v4u vones = (v4u){onesw, onesw, onesw, onesw};
#pragma unroll
    for (int g = 0; g < 2; ++g) if (need[g]) {
        if (masked) {
#pragma unroll
            for (int nt = 0; nt < 4; ++nt)
#pragma unroll
                for (int rg = 0; rg < 4; ++rg) s[g][nt][rg] = okf(g, 16 * nt + 4 * q + rg) ? s[g][nt][rg] : -1e30f; }
        float mx = m_run[g];
#pragma unroll
        for (int nt = 0; nt < 4; ++nt)
#pragma unroll
            for (int rg = 0; rg < 4; ++rg) mx = fmaxf(mx, s[g][nt][rg]);
        mx = fmaxf(mx, __shfl_xor(mx, 16)); mx = fmaxf(mx, __shfl_xor(mx, 32));
        if (__ballot(mx != m_run[g]) != 0ull) { const float sc = __builtin_amdgcn_exp2f(m_run[g] - mx); m_run[g] = mx; o5[g] = o5[g] * sc;
#pragma unroll
            for (int dt = 0; dt < 4; ++dt) o[g][dt] = o[g][dt] * sc; }
#pragma unroll
        for (int nt = 0; nt < 4; ++nt)
#pragma unroll
            for (int rg = 0; rg < 4; ++rg) s[g][nt][rg] = __builtin_amdgcn_exp2f(s[g][nt][rg] - mx);
#pragma unroll
        for (int k2 = 0; k2 < 2; ++k2) { v4u pf; pf.x = pk2(s[g][2 * k2][0], s[g][2 * k2][1]); pf.y = pk2(s[g][2 * k2][2], s[g][2 * k2][3]); pf.z = pk2(s[g][2 * k2 + 1][0], s[g][2 * k2 + 1][1]); pf.w = pk2(s[g][2 * k2 + 1][2], s[g][2 * k2 + 1][3]);
            o5[g] = mfma16(vones, pf, o5[g]);
#pragma unroll
            for (int dt = 0; dt < 4; ++dt) { v4u vf; vf.x = vfa[k2][dt].x; vf.y = vfa[k2][dt].y; vf.z = vfb[k2][dt].x; vf.w = vfb[k2][dt].y; o[g][dt] = mfma16(vf, pf, o[g][dt]); } } }
}

__device__ __forceinline__ void nsa_attn(ArgP A, int l, int item, LAS unsigned char* lds, int tid, int wave, int lane) {
#define Z ((const bf16*)(A->ws + WS_Z))
#define MIX ((bf16*)(A->ws + WS_MIX))
#define VTS ((const bf16*)(A->ws + WS_VTS))
#define VTW ((const bf16*)(A->ws + WS_VTW))
#define KC ((const bf16*)(A->ws + WS_KC))
#define VCT ((const bf16*)(A->ws + WS_VCT))
    const int jq = item >> 8, ib = item & 255, b = 2 * (ib & 7) + ((ib >> 3) & 1), a = ib >> 4;
    const int tau = jq ? 31 - a : a;
    const int t0 = 64 * tau, curb = tau, wlo = (tau >= 8) ? tau - 8 : 0;
    LAS bf16* KT = (LAS bf16*)lds; LAS bf16* VT = KT + 9216;
    LAS bf16* TB = (LAS bf16*)(lds + 35840);
    LAS float* PS = (LAS float*)(lds + 72704) + wave * (16 * 132);
    LAS float* IMP = (LAS float*)(lds + 140288) + wave * 128;
    LAS unsigned* WANY = (LAS unsigned*)(lds + 144384);
    const int fr = lane & 15, q = lane >> 4, tt = fr >> 2, hh = fr & 3;
    const int skey = tid >> 3, spc = tid & 7;
    const size_t krow = (size_t)b * SEQ + skey;
#define KADDR(j, col) ZP(Z, krow + 64 * (j), (col) + 8 * spc)
    const size_t vbase = ((size_t)b * 64 + skey) * SEQ + 8 * spc;
    v4u kr = *(const v4u*)KADDR(0, ZC_KS), vr = *(const v4u*)(VTS + vbase);
    int tq[2]; size_t grow[2]; v4u qf[2][2]; float g0[2], g1[2], g2[2];
#pragma unroll
    for (int g = 0; g < 2; ++g) { tq[g] = t0 + 8 * wave + 4 * g + tt; grow[g] = (size_t)b * SEQ + tq[g];
#pragma unroll
        for (int ks = 0; ks < 2; ++ks) { const v4u w = *(const v4u*)ZP(Z, grow[g], ZC_Q + 64 * hh + 32 * ks + 8 * q);
            const float qs = 0.125f * 1.4426950408889634f;
            qf[g][ks].x = pk2(bflo(w.x) * qs, bfhi(w.x) * qs); qf[g][ks].y = pk2(bflo(w.y) * qs, bfhi(w.y) * qs);
            qf[g][ks].z = pk2(bflo(w.z) * qs, bfhi(w.z) * qs); qf[g][ks].w = pk2(bflo(w.w) * qs, bfhi(w.w) * qs); }
        g0[g] = sigmoidf_(bf2f(*ZP(Z, grow[g], ZC_G + 3 * hh + 0))); g1[g] = sigmoidf_(bf2f(*ZP(Z, grow[g], ZC_G + 3 * hh + 1))); g2[g] = sigmoidf_(bf2f(*ZP(Z, grow[g], ZC_G + 3 * hh + 2))); }
#pragma unroll
    for (int x = 0; x < 2; ++x) { const int pi = tid + 512 * x;
        { const int c = pi >> 3, pc = pi & 7; *(LAS v4u*)(KT + c * 72 + 8 * pc) = *(const v4u*)(KC + ((size_t)b * 128 + c) * 64 + 8 * pc); }
        { const int c = pi >> 3, pc = pi & 7; const v4u w = *(const v4u*)(VCT + ((size_t)b * 128 + c) * 64 + 8 * pc); LAS bf16* vp = VT + (8 * pc) * 136 + c;
            vp[0] = (bf16)(w.x & 0xffffu); vp[136] = (bf16)(w.x >> 16); vp[272] = (bf16)(w.y & 0xffffu); vp[408] = (bf16)(w.y >> 16);
            vp[544] = (bf16)(w.z & 0xffffu); vp[680] = (bf16)(w.z >> 16); vp[816] = (bf16)(w.w & 0xffffu); vp[952] = (bf16)(w.w >> 16); } }
    __syncthreads();
    f32x4 facc[2][4];
    unsigned msk[2], wny[2];
#pragma unroll 1
    for (int g = 0; g < 2; ++g) {
        const int t = t0 + 8 * wave + 4 * g + tt;
        const v4u q0 = g ? qf[1][0] : qf[0][0], q1 = g ? qf[1][1] : qf[0][1];
        f32x4 s[8];
#pragma unroll
        for (int nt = 0; nt < 8; ++nt) { const v4u k0 = *(const LAS v4u*)(KT + (16 * nt + fr) * 72 + 8 * q), k1 = *(const LAS v4u*)(KT + (16 * nt + fr) * 72 + 32 + 8 * q);
            s[nt] = mfma16(k0, q0, (f32x4){0.f, 0.f, 0.f, 0.f}); s[nt] = mfma16(k1, q1, s[nt]); }
        float mx = -1e30f;
#pragma unroll
        for (int nt = 0; nt < 8; ++nt)
#pragma unroll
            for (int rg = 0; rg < 4; ++rg) { const int c = 16 * nt + 4 * q + rg; const float v = (16 * c + 31 <= t) ? s[nt][rg] : -1e30f; s[nt][rg] = v; mx = fmaxf(mx, v); }
        mx = fmaxf(mx, __shfl_xor(mx, 16)); mx = fmaxf(mx, __shfl_xor(mx, 32));
        float sum = 0.f;
#pragma unroll
        for (int nt = 0; nt < 8; ++nt)
#pragma unroll
            for (int rg = 0; rg < 4; ++rg) { const float p = (s[nt][rg] > -5e29f) ? __builtin_amdgcn_exp2f(s[nt][rg] - mx) : 0.f; s[nt][rg] = p; sum += p; }
        sum += __shfl_xor(sum, 16); sum += __shfl_xor(sum, 32);
        const float inv = (t >= 31) ? 1.0f / sum : 0.f;
#pragma unroll
        for (int nt = 0; nt < 8; ++nt) { s[nt] = s[nt] * inv; *(LAS f32x4*)(PS + fr * 132 + 16 * nt + 4 * q) = s[nt]; }
        f32x4 oc[4];
#pragma unroll
        for (int dt = 0; dt < 4; ++dt) oc[dt] = (f32x4){0.f, 0.f, 0.f, 0.f};
#pragma unroll
        for (int k2 = 0; k2 < 4; ++k2) { v4u pf; pf.x = pk2(s[2 * k2][0], s[2 * k2][1]); pf.y = pk2(s[2 * k2][2], s[2 * k2][3]); pf.z = pk2(s[2 * k2 + 1][0], s[2 * k2 + 1][1]); pf.w = pk2(s[2 * k2 + 1][2], s[2 * k2 + 1][3]);
#pragma unroll
            for (int dt = 0; dt < 4; ++dt) { const v2u va = *(const LAS v2u*)(VT + (16 * dt + fr) * 136 + 32 * k2 + 4 * q), vb = *(const LAS v2u*)(VT + (16 * dt + fr) * 136 + 32 * k2 + 16 + 4 * q);
                v4u vf; vf.x = va.x; vf.y = va.y; vf.z = vb.x; vf.w = vb.y; oc[dt] = mfma16(vf, pf, oc[dt]); } }
        const float gg = g ? g0[1] : g0[0];
#pragma unroll
        for (int dt = 0; dt < 4; ++dt) { const f32x4 v = oc[dt] * gg; if (g) facc[1][dt] = v; else facc[0][dt] = v; }
        LDS_WAIT();
        const int tt2 = lane >> 4, jl = lane & 15, t2 = t0 + 8 * wave + 4 * g + tt2, cur = t2 >> 6;
        float key[2];
#pragma unroll
        for (int x = 0; x < 2; ++x) { const int j = jl + 16 * x; float im = 0.f;
#pragma unroll
            for (int i = 0; i < 5; ++i) { const int c = 4 * j - 1 + i;
                if (c >= 0 && c <= 126) { im += PS[(4 * tt2 + 0) * 132 + c]; im += PS[(4 * tt2 + 1) * 132 + c]; im += PS[(4 * tt2 + 2) * 132 + c]; im += PS[(4 * tt2 + 3) * 132 + c]; } }
            const bool valid = j <= cur, forced = (j == 0) | (j == cur) | (j == cur - 1);
            key[x] = valid ? (forced ? im + 1e4f : im) : -1e30f; IMP[tt2 * 32 + j] = key[x]; }
        LDS_WAIT();
        int rk0 = 0, rk1 = 0;
        f32x4 kq[8];
#pragma unroll
        for (int i = 0; i < 8; ++i) kq[i] = *(const LAS f32x4*)(IMP + tt2 * 32 + 4 * i);
#pragma unroll
        for (int j2 = 0; j2 < 32; ++j2) { const float k2 = kq[j2 >> 2][j2 & 3];
            rk0 += ((k2 > key[0]) || (k2 == key[0] && j2 < jl)) ? 1 : 0; rk1 += ((k2 > key[1]) || (k2 == key[1] && j2 < jl + 16)) ? 1 : 0; }
        const bool sel0 = (jl <= cur) && rk0 < 8, sel1 = (jl + 16 <= cur) && rk1 < 8;
        const unsigned long long bal0 = __ballot(sel0), bal1 = __ballot(sel1);
        const unsigned mk = (unsigned)((bal0 >> (16 * tt)) & 0xffffull) | ((unsigned)((bal1 >> (16 * tt)) & 0xffffull) << 16);
        unsigned wa = 0;
#pragma unroll
        for (int x = 0; x < 4; ++x) wa |= (unsigned)((bal0 >> (16 * x)) & 0xffffull) | ((unsigned)((bal1 >> (16 * x)) & 0xffffull) << 16);
        if (g) { msk[1] = mk; wny[1] = wa; } else { msk[0] = mk; wny[0] = wa; }
        LDS_WAIT();
    }
    if (lane == 0) WANY[wave] = wny[0] | wny[1];
    *(LAS v4u*)(TB + skey * 72 + 8 * spc) = kr; *(LAS v4u*)(TB + 4608 + skey * 72 + 8 * spc) = vr;
    __syncthreads();
    unsigned uni = 0;
#pragma unroll
    for (int w = 0; w < 8; ++w) uni |= WANY[w];
    int cph = 0, cj = 0, nph = 0, nj = 0, tb = 0;
#define ATT_ADV(ph, j) do { if (ph == 0) { const unsigned rem = uni & ~((2u << j) - 1u); if (rem) j = __builtin_ctz(rem); else { ph = 1; j = wlo; } } else if (++j > curb) ph = 2; } while (0)
    ATT_ADV(nph, nj);
    float m_run[2] = {-1e4f, -1e4f}; f32x4 o5[2], o[2][4];
#pragma unroll
    for (int g = 0; g < 2; ++g) { o5[g] = (f32x4){0.f, 0.f, 0.f, 0.f};
#pragma unroll
        for (int dt = 0; dt < 4; ++dt) o[g][dt] = (f32x4){0.f, 0.f, 0.f, 0.f}; }
    while (cph != 2) {
        if (nph != 2) { kr = *(const v4u*)KADDR(nj, nph ? ZC_KW : ZC_KS); vr = *(const v4u*)((nph ? VTW : VTS) + vbase + 64 * nj); }
        { const LAS bf16* Kb = TB + tb * 9216; const LAS bf16* Vb = Kb + 4608; const int kb = 64 * cj;
            const bool need[2] = { cph ? true : (bool)((wny[0] >> cj) & 1u), cph ? true : (bool)((wny[1] >> cj) & 1u) };
            if (need[0] || need[1]) { const float rb[2] = { (cph || ((msk[0] >> cj) & 1u)) ? 0.f : -1e30f, (cph || ((msk[1] >> cj) & 1u)) ? 0.f : -1e30f };
                const int tA = tq[0], tB = tq[1], wl = cph ? 512 : (1 << 30);
                attn_tile2(Kb, Vb, qf, fr, q, m_run, o5, o, need, rb, (cj == curb) || (cph && cj <= wlo),
                           [=](int g, int kk) { const int kp = kb + kk, tg = g ? tB : tA; return (kp <= tg) && (kp > tg - wl); }); } }
        if (nph != 2) { LAS bf16* Kn = TB + (tb ^ 1) * 9216; *(LAS v4u*)(Kn + skey * 72 + 8 * spc) = kr; *(LAS v4u*)(Kn + 4608 + skey * 72 + 8 * spc) = vr; }
        if (cph == 0 && nph == 1) {
#pragma unroll
            for (int g = 0; g < 2; ++g) { const float lt = __shfl(o5[g][0], fr); const float sc = g1[g] / lt;
#pragma unroll
                for (int dt = 0; dt < 4; ++dt) { facc[g][dt] = facc[g][dt] + o[g][dt] * sc; o[g][dt] = (f32x4){0.f, 0.f, 0.f, 0.f}; }
                m_run[g] = -1e4f; o5[g] = (f32x4){0.f, 0.f, 0.f, 0.f}; } }
        __syncthreads();
        cph = nph; cj = nj; tb ^= 1; ATT_ADV(nph, nj);
    }
#undef ATT_ADV
#pragma unroll
    for (int g = 0; g < 2; ++g) { const float lt = __shfl(o5[g][0], fr); const float sc = g2[g] / lt;
#pragma unroll
        for (int dt = 0; dt < 4; ++dt) { const f32x4 v = facc[g][dt] + o[g][dt] * sc; v2u w; w.x = pk2(v.x, v.y); w.y = pk2(v.z, v.w);
            *(v2u*)(MIX + grow[g] * DM + 512 + 64 * hh + 16 * dt + 4 * q) = w; } }
}
#undef KADDR
#undef Z
#undef MIX
#undef VTS
#undef VTW
#undef KC
#undef VCT

#define XB_TMO      128
#define XB_XCNT(j)  (256  + 64 * (j))
#define XB_XSUB(j)  (1280 + 64 * (j))
#define XB_XGEN(j)  (2304 + 64 * (j))
#define XB_TOP      3328
#define XB_TOPGEN   3392
#define XCD_BAR_WORDS 3456
#define XB_SPIN_CAP (1u << 18)

__device__ __forceinline__ unsigned xb_ld(unsigned* p)              { return __hip_atomic_load(p, __ATOMIC_RELAXED, __HIP_MEMORY_SCOPE_AGENT); }
__device__ __forceinline__ unsigned xb_add(unsigned* p, unsigned v) { return __hip_atomic_fetch_add(p, v, __ATOMIC_RELAXED, __HIP_MEMORY_SCOPE_AGENT); }
__device__ __forceinline__ unsigned xb_xcc_id() { return (unsigned)__builtin_amdgcn_s_getreg((3 << 11) | 20) & 0xFu; }
#define XB_SPIN(cond, bar) do { unsigned _sp = 0; while (cond) { __builtin_amdgcn_s_sleep(1); \
    if ((++_sp & 255u) == 0u) { if (xb_ld(&(bar)[XB_TMO])) break; if (_sp > XB_SPIN_CAP) { atomicAdd(&(bar)[XB_TMO], 1u); break; } } } } while (0)

struct XcdBarrier {
    unsigned* bar; unsigned x;
    volatile LAS unsigned* st;
};

__device__ __forceinline__ XcdBarrier xcd_barrier_post(unsigned* bar, volatile LAS unsigned* st) {
    XcdBarrier b; b.bar = bar; b.x = xb_xcc_id(); b.st = st;
    if (threadIdx.x == 0) (void)xb_add(&bar[XB_XCNT(b.x)], 1u);
    return b;
}
__device__ __forceinline__ void xcd_barrier_complete(unsigned* bar, unsigned x, unsigned& nloc, unsigned& nx) {
    const unsigned G = gridDim.x * gridDim.y * gridDim.z;
    unsigned sum, cnt, mine, sp = 0u;
    for (;;) {
        sum = 0u; cnt = 0u; mine = 0u;
#pragma unroll
        for (unsigned j = 0; j < 16; ++j) { const unsigned c = xb_ld(&bar[XB_XCNT(j)]); sum += c; cnt += (c > 0u) ? 1u : 0u; mine = (j == x) ? c : mine; }
        if (sum == G) break;
        __builtin_amdgcn_s_sleep(1);
        if ((++sp & 255u) == 0u) { if (xb_ld(&bar[XB_TMO])) break; if (sp > XB_SPIN_CAP) { atomicAdd(&bar[XB_TMO], 1u); break; } }
    }
    nloc = mine > 0u ? mine : 1u; nx = cnt > 0u ? cnt : 1u;
}

__device__ __forceinline__ void xcd_barrier(const XcdBarrier& b) {
    asm volatile("s_waitcnt vmcnt(0)" ::: "memory");
    __syncthreads();
    if (threadIdx.x == 0) {
        unsigned* bar = b.bar;
        __builtin_amdgcn_s_waitcnt(0);
        unsigned nloc = b.st[0], nx = b.st[1];
        if (nloc == 0u) { xcd_barrier_complete(bar, b.x, nloc, nx); b.st[0] = nloc; b.st[1] = nx; }
        const unsigned old = xb_add(&bar[XB_XSUB(b.x)], 1u);
        const unsigned gen = old / nloc;
        if (old + 1u == (gen + 1u) * nloc) {
            __builtin_amdgcn_fence(__ATOMIC_RELEASE, "agent");
            asm volatile("s_waitcnt vmcnt(0)" ::: "memory");
            const unsigned og = xb_add(&bar[XB_TOP], 1u);
            const unsigned tg = og / nx;
            if (og + 1u == (tg + 1u) * nx) xb_add(&bar[XB_TOPGEN], 1u);
            else XB_SPIN(xb_ld(&bar[XB_TOPGEN]) == tg, bar);
            __builtin_amdgcn_fence(__ATOMIC_ACQUIRE, "agent");
            xb_add(&bar[XB_XGEN(b.x)], 1u);
            asm volatile("s_waitcnt vmcnt(0)" ::: "memory");
        } else {
            XB_SPIN(xb_ld(&bar[XB_XGEN(b.x)]) == gen, bar);
            __builtin_amdgcn_fence(__ATOMIC_ACQUIRE, "agent");
            asm volatile("s_waitcnt vmcnt(0)" ::: "memory");
        }
    }
    __syncthreads();
}

#ifndef POSTBAR_SLEEP
#define POSTBAR_SLEEP do {} while (0)
#endif
#ifndef MIXD_NEW
#define MIXD_NEW 1
#endif
#ifndef MIXB_LNNEW
#define MIXB_LNNEW 1
#endif
#ifndef ATDRY
#define ATDRY 0
#endif
#ifndef ITREP
#define ITREP 0
#endif
#ifndef REPMASK
#define REPMASK 0
#endif
#ifndef PHSEL
#define PHSEL 0xfff
#endif
constexpr int N_PHASES = 1 + 8 * DEPTH;
__global__ void __launch_bounds__(NTHREADS) hybrid_fwd(Args KA) {
    extern __shared__ __attribute__((aligned(16))) unsigned char lds_raw[];
    LAS unsigned char* lds = (LAS unsigned char*)lds_raw;
    cg::grid_group grid = cg::this_grid();
    volatile LAS unsigned* MISC = (volatile LAS unsigned*)(lds + LDS_BYTES - 64);
    if (threadIdx.x < 16) MISC[threadIdx.x] = 0u;
    __syncthreads();
    const XcdBarrier bar = xcd_barrier_post((unsigned*)(KA.ws + WS_CTL), MISC);
#define SEAM(first) do { if (first) { __threadfence(); asm volatile("s_waitcnt vmcnt(0)" ::: "memory"); grid.sync(); __builtin_amdgcn_fence(__ATOMIC_ACQUIRE, "agent"); asm volatile("s_waitcnt vmcnt(0)" ::: "memory"); __syncthreads(); } else { xcd_barrier(bar); POSTBAR_SLEEP; } } while (0)
#if REPMASK
    for (int ph2 = 2 * KA.ph_lo; ph2 < 2 * KA.ph_hi; ++ph2) {
        const int ph = ph2 >> 1;
        if (ph2 & 1) { const int stx = (ph == 0) ? 8 : ((ph - 1) & 7); if (!(((REPMASK & ~0x90) >> stx) & 1) && !((REPMASK >> 9) & 1)) continue; }
        if (ph2 > 2 * KA.ph_lo) SEAM(ph2 == 2 * KA.ph_lo + 2);
        if (ph2 & 1) { const int stx = (ph == 0) ? 8 : ((ph - 1) & 7); if (!(((REPMASK & ~0x90) >> stx) & 1)) continue; }
#else
    for (int ph = KA.ph_lo; ph < KA.ph_hi; ++ph) {
        if (ph > KA.ph_lo) SEAM(ph == KA.ph_lo + 1);
#endif
        ArgP A = (ArgP)__builtin_amdgcn_kernarg_segment_ptr(); asm volatile("" : "+s"(A));
        int tid = threadIdx.x; asm volatile("" : "+v"(tid));
        int G = gridDim.x, bid = blockIdx.x; asm volatile("" : "+s"(G), "+s"(bid));
        const int ngw = G * NWAVES;
        const int lane = tid & 63, wave = __builtin_amdgcn_readfirstlane(tid >> 6), gw = bid * NWAVES + wave;
        unsigned char* ws = A->ws;
        bf16* H = (bf16*)(ws + WS_H); bf16* Zb = (bf16*)(ws + WS_Z); bf16* MIX = (bf16*)(ws + WS_MIX); bf16* HID = (bf16*)(ws + WS_HID); bf16* Y = (bf16*)(ws + WS_Y); float* R2 = (float*)(ws + WS_R2);
        if (ph == 0) {
#if PHSEL & 1
            LAS float* scr = (LAS float*)(lds + wave * 16384);
            for (int it = gw; it < DEPTH * TI_LAYER; it += ngw) prologue_item(A, it, scr, lane);
            for (int idx = bid * NTHREADS + tid; idx < DEPTH * 65536; idx += G * NTHREADS) { const int l = idx >> 16, rem = idx & 65535, tq = (rem >> 7) & 127, sq = rem & 127;
                ((bf16*)(ws + WS_W + (size_t)l * WS_WL + WO_SG))[rem] = (sq <= tq) ? (bf16)f2bf(A->in[I_SGW][idx]) : (bf16)0; }
            norm_first(A->in[I_X], H, R2, bid, G, wave, lane);
#endif
            continue;
        }
        const int l = (ph - 1) >> 3, st = (ph - 1) & 7;
        unsigned char* wl = ws + WS_W + (size_t)l * WS_WL;
        if (st == 0) {
#if PHSEL & 2
            pg8::Gemm g{H, (const bf16*)(wl + WO_IN), MROWS, ZC, DM}; pg8::StaticOrder S; S.init(MROWS, ZC, G, bid);
            pg8::EpiBf16RS E{Zb, 256, R2 + (size_t)(2 * l) * MROWS, ZT};
            pg8::gemm_phase<pg8::EpiBf16RS, pg8::StaticOrder, PG8_ALIGN, PG8_SP2>(lds, g, S, E);
#endif
        } else if (st == 1) {
#if PHSEL & 4
            for (int it0 = bid; it0 < 1536 + (ITREP ? 512 : 0); it0 += G) {
                int it = it0; int tid_i = tid; ArgP A_i = A; asm volatile("" : "+v"(tid_i), "+s"(A_i));
                const int lane_i = tid_i & 63, wave_i = __builtin_amdgcn_readfirstlane(tid_i >> 6);
                if (it0 >= 1536) { const int e = it0 - 1536; if (ITREP == 1) { if (e >= 256) continue; it = e; } else if (ITREP == 2) it = 256 + e; else if (ITREP == 4) it = 768 + e; else { if (e >= 256) continue; it = 1280 + e; } }
                if (it < 256) {
#if PHSEL & 256
                    mixer_a(A_i, l, it, lds, tid_i, wave_i, lane_i);
#endif
                } else if (it < 768) {
#if PHSEL & 512
                    mixer_b(A_i, l, it - 256, lds, tid_i, wave_i, lane_i);
#endif
                } else if (it < 1280) {
#if PHSEL & 1024
                    mixer_d(A_i, l, it - 768, lds, tid_i, wave_i, lane_i);
#endif
                } else {
#if PHSEL & 2048
                    nsa_compress(A_i, l, it - 1280, lds, tid_i, wave_i, lane_i);
#endif
                }
            }
#endif
        } else if (st == 2) {
#if PHSEL & 8
            for (int it = bid; it < 512; it += G) { int tid_i = tid; ArgP A_i = A; asm volatile("" : "+v"(tid_i), "+s"(A_i));
                nsa_attn(A_i, l, it, lds, tid_i, __builtin_amdgcn_readfirstlane(tid_i >> 6), tid_i & 63); }
#endif
        } else if (st == 3 || st == 6) {
#if PHSEL & 16
            pg8::Gemm g{st == 3 ? MIX : HID, (const bf16*)(wl + (st == 3 ? WO_OUT : WO_DN)), MROWS, DM, st == 3 ? DM : FFH}; pg8::StaticOrder S; S.init(MROWS, DM, G, bid);
            pg8::EpiBf16<0> E{Y, DM, nullptr, 0, 0, 1.f};
            pg8::gemm_phase<pg8::EpiBf16<0>, pg8::StaticOrder, PG8_ALIGN, PG8_SP2>(lds, g, S, E);
#endif
        } else if (st == 4) {
#if PHSEL & 32
#if (REPMASK >> 4) & 1
            norm_bf<false>(H, HID, Y, A->in[I_GQM] + l * DM, (float*)(ws + WS_MIX), nullptr, bid, G, wave, lane);
#endif
            norm_bf<false>(H, H, Y, A->in[I_GQM] + l * DM, R2 + (size_t)(2 * l + 1) * MROWS, nullptr, bid, G, wave, lane);
#endif
        } else if (st == 5) {
#if PHSEL & 64
            pg8::Gemm g{H, (const bf16*)(wl + WO_GU), MROWS, 2 * FFH, DM}; pg8::StaticOrder S; S.init(MROWS, 2 * FFH, G, bid);
            pg8::EpiSwiGLU E{HID, FFH, R2 + (size_t)(2 * l + 1) * MROWS};
            pg8::gemm_phase<pg8::EpiSwiGLU, pg8::StaticOrder, PG8_ALIGN, PG8_SP2>(lds, g, S, E);
#endif
        } else {
#if PHSEL & 128
            const bool last = (l == DEPTH - 1);
#if (REPMASK >> 7) & 1
            norm_bf<false>(H, HID, Y, A->in[I_GQF] + l * DM, (float*)(ws + WS_MIX), nullptr, bid, G, wave, lane);
#endif
            if (last) norm_bf<true>(H, H, Y, A->in[I_GQF] + l * DM, nullptr, A->out, bid, G, wave, lane);
            else norm_bf<false>(H, H, Y, A->in[I_GQF] + l * DM, R2 + (size_t)(2 * l + 2) * MROWS, nullptr, bid, G, wave, lane);
#endif
        }
    }
}

#ifndef MK_MULTI
#define MK_MULTI 0
#endif
extern "C" void kernel_launch(void* const* d_in, const int* in_sizes, int n_in, void* d_out, int out_size, void* d_ws, size_t ws_size, hipStream_t stream) {
    static int grid = 0;
    if (grid == 0) {
        if (n_in != 26 || out_size != MROWS * DM || ws_size < WS_END) { fprintf(stderr, "kernel_launch: unexpected shapes (n_in %d out %d ws %zu)\n", n_in, out_size, ws_size); grid = -1; return; }
        int dev = 0, cus = 0, per_cu = 0;
        hipGetDevice(&dev); hipDeviceGetAttribute(&cus, hipDeviceAttributeMultiprocessorCount, dev);
        hipFuncSetAttribute((const void*)hybrid_fwd, hipFuncAttributeMaxDynamicSharedMemorySize, LDS_BYTES);
        hipOccupancyMaxActiveBlocksPerMultiprocessor(&per_cu, (const void*)hybrid_fwd, NTHREADS, LDS_BYTES);
        if (per_cu < 1) per_cu = 1;
        grid = cus * per_cu;
        (void)hipGetLastError();
    }
    if (grid < 0) return;
    Args a{};
    for (int i = 0; i < 26; ++i) a.in[i] = (const float*)d_in[i];
    a.out = (float*)d_out; a.ws = (unsigned char*)d_ws;
    if (hipMemsetAsync((char*)d_ws + WS_CTL, 0, CTL_BYTES, stream) != hipSuccess) { fprintf(stderr, "kernel_launch: memset of the barrier words failed\n"); return; }
#if MK_MULTI
    for (int ph = 0; ph < N_PHASES; ++ph) { a.ph_lo = ph; a.ph_hi = ph + 1; hipLaunchKernelGGL(hybrid_fwd, dim3(grid), dim3(NTHREADS), LDS_BYTES, stream, a); }
#else
    a.ph_lo = 0; a.ph_hi = N_PHASES;
    void* args[] = {&a};
    hipError_t e = hipLaunchCooperativeKernel((const void*)hybrid_fwd, dim3(grid), dim3(NTHREADS), args, LDS_BYTES, stream);
    if (e != hipSuccess) fprintf(stderr, "cooperative launch failed: %s (grid %d)\n", hipGetErrorString(e), grid);
#endif
}
```

```cpp
#include <hip/hip_runtime.h>
#include <hip/hip_cooperative_groups.h>
#include <cstdio>
#include <cstdint>
namespace cg = cooperative_groups;
namespace pg8 {
#define PG8_LAS __attribute__((address_space(3)))
typedef unsigned short bf16_t;
typedef short bf16x8 __attribute__((ext_vector_type(8)));
typedef float f32x4 __attribute__((ext_vector_type(4)));
typedef unsigned u32x4 __attribute__((ext_vector_type(4)));
constexpr int BM = 256, BK = 64, HALF = 128, HTB = HALF * BK * 2  , STAGE_BYTES = 8 * HTB, NXCD = 8, WGM = 8;

__host__ __device__ __forceinline__ int lds_byte(int r, int c) { const int st = (r >> 4) * 2 + (c >> 5), rr = r & 15, cc = c & 31, ob = rr * 64 + cc * 2; return st * 1024 + (ob ^ (((ob >> 9) & 1) << 5)); }
__host__ __device__ __forceinline__ void stage_rc(int b, int& R, int& C) { const int st = b / 1024, sb = b % 1024, swz = sb ^ (((sb >> 9) & 1) << 5); R = (st >> 1) * 16 + swz / 64; C = (st & 1) * 32 + (swz % 64) / 2; }
__host__ __device__ __forceinline__ int perm32(int rho) { const int n = rho >> 4, i = rho & 15; return 8 * (i >> 2) + 4 * n + (i & 3); }

struct Unit { int pm, pn; };
struct Gemm { const bf16_t* A; const bf16_t* Bt; int M, N, K; };

struct StaticOrder {
    int nM, nN, nwg, G, c;
    __host__ __device__ void init(int M, int N, int G_, int c_) { nM = M / BM; nN = N / BM; nwg = nM * nN; G = G_; c = c_; }
    __host__ __device__ bool next(int i, Unit& u) const {
        const long L = (long)i * G + c; if (L >= nwg) return false;
        int wgid = (int)L; { const int q = nwg / NXCD, r = nwg % NXCD, xcd = wgid % NXCD, off = wgid / NXCD; wgid = (xcd < r ? xcd * (q + 1) : r * (q + 1) + (xcd - r) * q) + off; }
        const int nig = WGM * nN, gid = wgid / nig, fm = gid * WGM, gsz = (nM - fm) < WGM ? (nM - fm) : WGM;
        u.pm = fm + ((wgid % nig) % gsz); u.pn = (wgid % nig) / gsz; return true;
    }
    __device__ __forceinline__ void a_ready(const Unit&) const {}
    __device__ __forceinline__ void done(const Unit&) const {}
};

__device__ __forceinline__ unsigned cvt_pk_bf16(float lo, float hi) { unsigned r; asm volatile("v_cvt_pk_bf16_f32 %0, %1, %2" : "=v"(r) : "v"(lo), "v"(hi)); return r; }
typedef float f32x2 __attribute__((ext_vector_type(2)));
__device__ __forceinline__ f32x2 gelu_pk(f32x2 v) {
    const f32x2 av = __builtin_elementwise_abs(v), d = av * 0.2316418882f + 1.0f;
    f32x2 t; t.x = __builtin_amdgcn_rcpf(d.x); t.y = __builtin_amdgcn_rcpf(d.y);
    f32x2 q = t * 0.5307027145f + (-0.7265760135f); q = q * t + 0.7107068705f; q = q * t + (-0.142248368f); q = q * t + 0.127414796f; q = q * t;
    const f32x2 s = (v * v) * (-0.72134752044f);
    f32x2 e; e.x = __builtin_amdgcn_exp2f(s.x); e.y = __builtin_amdgcn_exp2f(s.y);
    const f32x2 m = v * (q * e), r = v - m;
    f32x2 o; o.x = v.x < 0.f ? m.x : r.x; o.y = v.y < 0.f ? m.y : r.y; return o;
}

template <int ACT  > struct EpiBf16 {
    static constexpr bool PERM = true, AFTER_DRAIN = false; static_assert(ACT == 0 || ACT == 1, "EpiBf16: ACT is 0 (none) or 1 (gelu_pk)");
    bf16_t* O; int ldc; const float* bias; int split_cols; size_t split_stride; float scale0;
    __device__ __forceinline__ void operator()(const f32x4 (&acc)[2][2][4][2], const Unit& u, int wr, int wc, int fr, int fq) const {
        const int row0 = u.pm * BM + wr * 64 + fr; int colt = u.pn * BM; bf16_t* base = O;
        float sc = 1.f; if (split_cols) { const int t = colt / split_cols; base += (size_t)t * split_stride; colt -= t * split_cols; if (t == 0) sc = scale0; }
        const int col0 = colt + wc * 32 + 8 * fq, bcol0 = u.pn * BM + wc * 32 + 8 * fq;
        f32x4 bv[2][2];
#pragma unroll
        for (int bj = 0; bj < 2; ++bj)
#pragma unroll
            for (int n = 0; n < 2; ++n) bv[bj][n] = bias ? *(const f32x4*)(bias + bcol0 + bj * HALF + 4 * n) : (f32x4){0.f, 0.f, 0.f, 0.f};
#pragma unroll
        for (int ai = 0; ai < 2; ++ai)
#pragma unroll
            for (int m = 0; m < 4; ++m) { bf16_t* rowp = base + (size_t)(row0 + ai * HALF + m * 16) * ldc + col0;
#pragma unroll
                for (int bj = 0; bj < 2; ++bj) { f32x4 v0 = acc[ai][bj][m][0] + bv[bj][0], v1 = acc[ai][bj][m][1] + bv[bj][1];
                    if (ACT == 1) { f32x2 a = gelu_pk((f32x2){v0[0], v0[1]}), b = gelu_pk((f32x2){v0[2], v0[3]}), c = gelu_pk((f32x2){v1[0], v1[1]}), d = gelu_pk((f32x2){v1[2], v1[3]});
                        v0 = (f32x4){a.x, a.y, b.x, b.y}; v1 = (f32x4){c.x, c.y, d.x, d.y}; }
                    v0 = v0 * sc; v1 = v1 * sc; u32x4 w; w.x = cvt_pk_bf16(v0[0], v0[1]); w.y = cvt_pk_bf16(v0[2], v0[3]); w.z = cvt_pk_bf16(v1[0], v1[1]); w.w = cvt_pk_bf16(v1[2], v1[3]);
                    *(u32x4*)(rowp + bj * HALF) = w; } }
    }
};
struct EpiF32 {
    static constexpr bool PERM = false, AFTER_DRAIN = false;
    float* O; int ldc;
    __device__ __forceinline__ void operator()(const f32x4 (&acc)[2][2][4][2], const Unit& u, int wr, int wc, int fr, int fq) const {
        const int row0 = u.pm * BM + wr * 64 + fr, col0 = u.pn * BM + wc * 32 + 4 * fq;
#pragma unroll
        for (int ai = 0; ai < 2; ++ai)
#pragma unroll
            for (int m = 0; m < 4; ++m) { float* rowp = O + (size_t)(row0 + ai * HALF + m * 16) * ldc + col0;
#pragma unroll
                for (int bj = 0; bj < 2; ++bj)
#pragma unroll
                    for (int n = 0; n < 2; ++n) *(f32x4*)(rowp + bj * HALF + n * 16) = acc[ai][bj][m][n]; }
    }
};
struct EpiSwiGLU {
    static constexpr bool PERM = true, AFTER_DRAIN = false;
    bf16_t* O; int ldc; const float* rs;
    __device__ __forceinline__ void operator()(const f32x4 (&acc)[2][2][4][2], const Unit& u, int wr, int wc, int fr, int fq) const {
        const int row0 = u.pm * BM + wr * 64 + fr, col0 = u.pn * HALF + wc * 32 + 8 * fq;
#pragma unroll
        for (int ai = 0; ai < 2; ++ai)
#pragma unroll
            for (int m = 0; m < 4; ++m) { bf16_t* rowp = O + (size_t)(row0 + ai * HALF + m * 16) * ldc + col0;
                const float r = rs[row0 + ai * HALF + m * 16];
                float h[8];
#pragma unroll
                for (int n = 0; n < 2; ++n)
#pragma unroll
                    for (int e = 0; e < 4; ++e) { const float g = acc[ai][0][m][n][e] * r, up = acc[ai][1][m][n][e] * r;
                        h[n * 4 + e] = g * __builtin_amdgcn_rcpf(1.0f + __builtin_amdgcn_exp2f(-1.4426950408889634f * g)) * up; }
                u32x4 w; w.x = cvt_pk_bf16(h[0], h[1]); w.y = cvt_pk_bf16(h[2], h[3]); w.z = cvt_pk_bf16(h[4], h[5]); w.w = cvt_pk_bf16(h[6], h[7]);
                *(u32x4*)rowp = w; }
    }
};
struct EpiBf16RS {
    static constexpr bool PERM = true, AFTER_DRAIN = false;
    bf16_t* O; int ldc; const float* rs; size_t ts;
    __device__ __forceinline__ void operator()(const f32x4 (&acc)[2][2][4][2], const Unit& u, int wr, int wc, int fr, int fq) const {
        const int row0 = u.pm * BM + wr * 64 + fr, col0 = wc * 32 + 8 * fq;
#pragma unroll
        for (int ai = 0; ai < 2; ++ai)
#pragma unroll
            for (int m = 0; m < 4; ++m) { bf16_t* rowp = O + (size_t)u.pn * ts + (size_t)(row0 + ai * HALF + m * 16) * ldc + col0; const float r = rs[row0 + ai * HALF + m * 16];
#pragma unroll
                for (int bj = 0; bj < 2; ++bj) { const f32x4 v0 = acc[ai][bj][m][0] * r, v1 = acc[ai][bj][m][1] * r;
                    u32x4 w; w.x = cvt_pk_bf16(v0[0], v0[1]); w.y = cvt_pk_bf16(v0[2], v0[3]); w.z = cvt_pk_bf16(v1[0], v1[1]); w.w = cvt_pk_bf16(v1[2], v1[3]);
                    *(u32x4*)(rowp + bj * HALF) = w; } }
    }
};
template <class Epi, class Sched, bool ALIGN_EPI = false, bool SP2 = false>
__device__ __forceinline__ void gemm_phase(PG8_LAS unsigned char* lds, const Gemm g, const Sched& S, const Epi& E) {
    int tid_l = threadIdx.x; asm volatile("" : "+v"(tid_l));
    const int tid = tid_l, wid = __builtin_amdgcn_readfirstlane(tid >> 6), lane = tid & 63, wr = wid >> 2, wc = wid & 3, fr = lane & 15, fq = lane >> 4;
    const int K = g.K, nt = K / BK;
    unsigned voffA[2], voffB[2];
#pragma unroll
    for (int i = 0; i < 2; ++i) { int R, C; stage_rc(tid * 16 + i * 8192, R, C); const int Rb = Epi::PERM ? ((R & ~31) + perm32(R & 31)) : R;
        voffA[i] = (unsigned)(R * K + C) * 2u; voffB[i] = (unsigned)(Rb * K + C) * 2u; }
    const size_t kstep = (size_t)(BK * 2);
    const size_t hstep = (size_t)HALF * K * 2;
    const size_t tstep = 2 * hstep;
    const unsigned ldsw = (unsigned)wid * 1024u;
    const int aoff = lds_byte(wr * 64 + fr, fq * 8), boff = lds_byte(wc * 32 + fr, fq * 8);
#define PG8_SA(b, h) (((b) * 2 + (h)) * HTB)
#define PG8_SB(b, h) ((4 + (b) * 2 + (h)) * HTB)
#define PG8_STAGE(bufoff, gbase, voff) do { _Pragma("unroll") for (int _i = 0; _i < 2; ++_i) \
        __builtin_amdgcn_global_load_lds((const unsigned*)((const char*)(gbase) + (voff)[_i]), (PG8_LAS unsigned*)(lds + (bufoff) + ldsw + _i * 8192), 16, 0, 0); } while (0)
#define PG8_LDA(dst, b, h) do { _Pragma("unroll") for (int m = 0; m < 4; ++m) _Pragma("unroll") for (int k = 0; k < 2; ++k) dst[m][k] = *(const PG8_LAS bf16x8*)(lds + PG8_SA(b, h) + aoff + m * 2048 + k * 1024); } while (0)
#define PG8_LDB(dst, b, h) do { _Pragma("unroll") for (int n = 0; n < 2; ++n) _Pragma("unroll") for (int k = 0; k < 2; ++k) dst[n][k] = *(const PG8_LAS bf16x8*)(lds + PG8_SB(b, h) + boff + n * 2048 + k * 1024); } while (0)
#define PG8_MMA(ai, bj, At, Bt) do { __builtin_amdgcn_s_setprio(1); _Pragma("unroll") for (int m = 0; m < 4; ++m) _Pragma("unroll") for (int n = 0; n < 2; ++n) _Pragma("unroll") for (int k = 0; k < 2; ++k) \
        acc[ai][bj][m][n] = __builtin_amdgcn_mfma_f32_16x16x32_bf16(Bt[n][k], At[m][k], acc[ai][bj][m][n], 0, 0, 0); __builtin_amdgcn_s_setprio(0); } while (0)
#define PG8_WAIT_V(n) asm volatile("s_waitcnt vmcnt(" #n ")" ::: "memory")
#define PG8_WAIT_L(n) asm volatile("s_waitcnt lgkmcnt(" #n ")" ::: "memory")
#define PG8_BAR __builtin_amdgcn_s_barrier()
#define PG8_SCHED __builtin_amdgcn_sched_barrier(0)
    Unit cur, nxt; int ui = 0;
    if (!S.next(0, cur)) return;
    f32x4 acc[2][2][4][2];
#pragma unroll
    for (int a = 0; a < 2; ++a)
#pragma unroll
        for (int b = 0; b < 2; ++b)
#pragma unroll
            for (int m = 0; m < 4; ++m)
#pragma unroll
                for (int n = 0; n < 2; ++n) acc[a][b][m][n] = (f32x4){0.f, 0.f, 0.f, 0.f};
    bf16x8 At[4][2], B0[2][2], B1[2][2];
    const char* cA = (const char*)g.A + (size_t)cur.pm * tstep; const char* cB = (const char*)g.Bt + (size_t)cur.pn * tstep;
    S.a_ready(cur);
    if constexpr (SP2) {
        PG8_STAGE(PG8_SB(0, 0), cB, voffB); PG8_STAGE(PG8_SB(0, 1), cB + hstep, voffB); PG8_STAGE(PG8_SA(0, 0), cA, voffA); PG8_STAGE(PG8_SA(0, 1), cA + hstep, voffA);
        if (wr == 1) PG8_BAR;
        PG8_WAIT_V(2); PG8_BAR;
        PG8_STAGE(PG8_SB(1, 0), cB + kstep, voffB); PG8_STAGE(PG8_SA(1, 0), cA + kstep, voffA); PG8_STAGE(PG8_SB(1, 1), cB + hstep + kstep, voffB);
        PG8_WAIT_V(6); PG8_BAR;
    } else {
        PG8_STAGE(PG8_SB(0, 0), cB, voffB); PG8_STAGE(PG8_SA(0, 0), cA, voffA); PG8_STAGE(PG8_SB(0, 1), cB + hstep, voffB); PG8_STAGE(PG8_SA(0, 1), cA + hstep, voffA);
        if (wr == 1) PG8_BAR;
        PG8_WAIT_V(4); PG8_BAR;
        PG8_STAGE(PG8_SB(1, 0), cB + kstep, voffB); PG8_STAGE(PG8_SA(1, 0), cA + kstep, voffA); PG8_STAGE(PG8_SB(1, 1), cB + hstep + kstep, voffB);
        PG8_WAIT_V(6); PG8_BAR;
    }
    for (;;) {
        const bool has_next = S.next(ui + 1, nxt);
        const char* nA = has_next ? (const char*)g.A + (size_t)nxt.pm * tstep : cA; const char* nB = has_next ? (const char*)g.Bt + (size_t)nxt.pn * tstep : cB;
        for (int t = 0; t < nt; t += 2) {
            const bool last = (t == nt - 2);
            const char* a1 = cA + (size_t)(t + 1) * kstep;
            const char* a2 = last ? nA : cA + (size_t)(t + 2) * kstep; const char* b2 = last ? nB : cB + (size_t)(t + 2) * kstep;
            const char* a3 = a2 + kstep; const char* b3 = b2 + kstep;
            if (last && has_next) S.a_ready(nxt);
            if constexpr (SP2) {
            PG8_LDB(B0, 0, 0); PG8_LDB(B1, 0, 1); PG8_SCHED; PG8_LDA(At, 0, 0); PG8_STAGE(PG8_SA(1, 1), a1 + hstep, voffA);
            PG8_WAIT_V(8); PG8_WAIT_L(0); PG8_BAR; PG8_MMA(0, 0, At, B0); PG8_MMA(0, 1, At, B1); PG8_BAR; PG8_SCHED;
            PG8_LDA(At, 0, 1); PG8_STAGE(PG8_SB(0, 0), b2, voffB); PG8_STAGE(PG8_SB(0, 1), b2 + hstep, voffB); PG8_STAGE(PG8_SA(0, 0), a2, voffA);
            PG8_WAIT_V(8); PG8_WAIT_L(0); PG8_BAR; PG8_MMA(1, 0, At, B0); PG8_MMA(1, 1, At, B1); PG8_BAR; PG8_SCHED;
            PG8_LDB(B0, 1, 0); PG8_LDB(B1, 1, 1); PG8_SCHED; PG8_LDA(At, 1, 0); PG8_STAGE(PG8_SA(0, 1), a2 + hstep, voffA);
            PG8_WAIT_V(8); PG8_WAIT_L(0); PG8_BAR; PG8_MMA(0, 0, At, B0); PG8_MMA(0, 1, At, B1); PG8_BAR; PG8_SCHED;
            PG8_LDA(At, 1, 1); PG8_STAGE(PG8_SB(1, 0), b3, voffB); PG8_STAGE(PG8_SB(1, 1), b3 + hstep, voffB); PG8_STAGE(PG8_SA(1, 0), a3, voffA);
            PG8_WAIT_V(8); PG8_WAIT_L(0); PG8_BAR; PG8_MMA(1, 0, At, B0); PG8_MMA(1, 1, At, B1); PG8_BAR; PG8_SCHED;
            } else {
            PG8_LDB(B0, 0, 0); PG8_SCHED; PG8_LDA(At, 0, 0); PG8_STAGE(PG8_SA(1, 1), a1 + hstep, voffA);
            PG8_WAIT_L(8); PG8_BAR; PG8_WAIT_L(0); PG8_MMA(0, 0, At, B0); PG8_BAR; PG8_SCHED;
            PG8_LDB(B1, 0, 1); PG8_STAGE(PG8_SB(0, 0), b2, voffB);
            PG8_BAR; PG8_WAIT_L(0); PG8_MMA(0, 1, At, B1); PG8_BAR;
            PG8_LDA(At, 0, 1); PG8_STAGE(PG8_SA(0, 0), a2, voffA);
            PG8_BAR; PG8_WAIT_L(0); PG8_MMA(1, 0, At, B0); PG8_BAR; PG8_SCHED;
            PG8_STAGE(PG8_SB(0, 1), b2 + hstep, voffB);
            PG8_WAIT_V(6); PG8_BAR; PG8_MMA(1, 1, At, B1); PG8_BAR;
            PG8_LDB(B0, 1, 0); PG8_SCHED; PG8_LDA(At, 1, 0); PG8_STAGE(PG8_SA(0, 1), a2 + hstep, voffA);
            PG8_WAIT_L(8); PG8_BAR; PG8_WAIT_L(0); PG8_MMA(0, 0, At, B0); PG8_BAR; PG8_SCHED;
            PG8_LDB(B1, 1, 1); PG8_STAGE(PG8_SB(1, 0), b3, voffB);
            PG8_BAR; PG8_WAIT_L(0); PG8_MMA(0, 1, At, B1); PG8_BAR;
            PG8_LDA(At, 1, 1); PG8_STAGE(PG8_SA(1, 0), a3, voffA);
            PG8_BAR; PG8_WAIT_L(0); PG8_MMA(1, 0, At, B0); PG8_BAR; PG8_SCHED;
            PG8_STAGE(PG8_SB(1, 1), b3 + hstep, voffB);
            PG8_WAIT_V(6); PG8_BAR; PG8_MMA(1, 1, At, B1); PG8_BAR;
            }
        }
        if constexpr (ALIGN_EPI) { if (wr == 0) PG8_BAR; }
        if constexpr (!Epi::AFTER_DRAIN) { E(acc, cur, wr, wc, fr, fq); S.done(cur); }
        if (!has_next) break;
#pragma unroll
        for (int a = 0; a < 2; ++a)
#pragma unroll
            for (int b = 0; b < 2; ++b)
#pragma unroll
                for (int m = 0; m < 4; ++m)
#pragma unroll
                    for (int n = 0; n < 2; ++n) acc[a][b][m][n] = (f32x4){0.f, 0.f, 0.f, 0.f};
        cur = nxt; cA = nA; cB = nB; ++ui;
        if constexpr (ALIGN_EPI) { if (wr == 1) PG8_BAR; }
    }
    PG8_WAIT_V(0);
    if constexpr (!ALIGN_EPI) { if (wr == 0) PG8_BAR; }
    PG8_BAR;
    if constexpr (Epi::AFTER_DRAIN) { E.fused(acc, cur, wr, wc, fr, fq, lds, wid, lane); S.done(cur); }
#undef PG8_SA
#undef PG8_SB
#undef PG8_STAGE
#undef PG8_LDA
#undef PG8_LDB
#undef PG8_MMA
#undef PG8_WAIT_V
#undef PG8_WAIT_L
#undef PG8_BAR
#undef PG8_SCHED
}
}

#ifndef PG8_SP2
#define PG8_SP2 true
#endif
#ifndef PG8_ALIGN
#define PG8_ALIGN true
#endif

#define LAS __attribute__((address_space(3)))
typedef unsigned short bf16;
typedef unsigned v4u __attribute__((ext_vector_type(4)));
typedef unsigned v2u __attribute__((ext_vector_type(2)));
typedef float f32x4 __attribute__((ext_vector_type(4)));
typedef short bf16x8 __attribute__((ext_vector_type(8)));

constexpr int DM = 1024, NBATCH = 16, SEQ = 2048, DEPTH = 4, MROWS = NBATCH * SEQ, INC = 1932, ZC = 2048, FFH = 2816;
constexpr int NTHREADS = 512, NWAVES = 8;
constexpr int LDS_BYTES = 147456;
constexpr int ZC_AU = 0, ZC_AV = 256, ZC_BA = 512, ZC_BG = 768, ZC_Q = 1024, ZC_KC = 1280, ZC_VC = 1344, ZC_KS = 1408, ZC_VS = 1472, ZC_KW = 1536, ZC_VW = 1600, ZC_G = 1664, ZC_D = 1792;
constexpr size_t ZT = (size_t)NBATCH * SEQ * 256;
#define ZP(Zb, row, col) ((Zb) + (size_t)((col) >> 8) * ZT + (size_t)(row) * 256 + ((col) & 255))
constexpr size_t MiB = 1u << 20;
constexpr size_t WS_CTL = 0, CTL_BYTES = 16384;
constexpr size_t WS_W = 1 * MiB, WS_WL = 24 * MiB;
constexpr size_t WO_IN = 0, WO_OUT = 4 * MiB, WO_GU = 6 * MiB, WO_DN = 17 * MiB, WO_SG = 23 * MiB - 512 * 1024, WO_PW = WO_SG + 131072, WO_POOL = WO_PW + 131072, WO_W1K = WO_POOL + 32768, WO_W1V = WO_W1K + 262144;
static_assert(WO_DN + (size_t)1024 * 2816 * 2 <= WO_SG && WO_W1V + 262144 <= WS_WL, "weight map");
constexpr size_t WS_H = 98 * MiB, WS_Z = 162 * MiB, WS_MIX = 290 * MiB, WS_HID = 162 * MiB, WS_Y = 354 * MiB;
constexpr size_t WS_VTS = 482 * MiB, WS_VTW = 486 * MiB, WS_KC = 490 * MiB, WS_VCT = 490 * MiB + 262144, WS_R2 = 491 * MiB, WS_END = 493 * MiB;
static_assert(WS_HID + (size_t)MROWS * FFH * 2 <= WS_Y, "hid overlay");

#define LDS_WAIT() asm volatile("s_waitcnt lgkmcnt(0)" ::: "memory")
__device__ __forceinline__ float bflo(unsigned w) { return __uint_as_float(w << 16); }
__device__ __forceinline__ float bfhi(unsigned w) { return __uint_as_float(w & 0xffff0000u); }
__device__ __forceinline__ float bf2f(bf16 v) { return __uint_as_float((unsigned)v << 16); }
__device__ __forceinline__ unsigned f2bf(float f) { unsigned u = __float_as_uint(f); return (u + 0x7fffu + ((u >> 16) & 1u)) >> 16; }
__device__ __forceinline__ unsigned pk2(float lo, float hi) { unsigned r; asm("v_cvt_pk_bf16_f32 %0, %1, %2" : "=v"(r) : "v"(lo), "v"(hi)); return r; }
__device__ __forceinline__ float sigmoidf_(float x) { return __builtin_amdgcn_rcpf(1.0f + __builtin_amdgcn_exp2f(-1.4426950408889634f * x)); }
__device__ __forceinline__ float siluf_(float x) { return x * sigmoidf_(x); }
__device__ __forceinline__ float wave_sum(float v) {
#pragma unroll
    for (int o = 1; o < 64; o <<= 1) v += __shfl_xor(v, o);
    return v;
}
__device__ __forceinline__ f32x4 mfma16(v4u a, v4u b, f32x4 c) {
    return __builtin_amdgcn_mfma_f32_16x16x32_bf16(__builtin_bit_cast(bf16x8, a), __builtin_bit_cast(bf16x8, b), c, 0, 0, 0);
}

struct Args { const float* in[26]; float* out; unsigned char* ws; int ph_lo, ph_hi; };
typedef const __attribute__((address_space(4))) Args* ArgP;
enum { I_X = 0, I_GPM, I_GQM, I_GPF, I_GQF, I_WIN, I_SGLN, I_SGW, I_SGB, I_CVW, I_CVB, I_CVLG, I_CVLB, I_CVPW, I_CVPB, I_POSK, I_POSV, I_W1K, I_W2K, I_W1V, I_W2V, I_POOLW, I_POOLS, I_WOUT, I_GU, I_DN };

__device__ __forceinline__ void tr_item(const float* __restrict__ src, int Nsrc, int K, bf16* dst, int k0, int n0d, int nsrc0, int nvalid, LAS float* scr, int lane, const float* gk = nullptr) {
    const int kk8 = lane >> 3, n4 = (lane & 7) * 4; const bool ok = n4 < nvalid;
#pragma unroll
    for (int i = 0; i < 8; ++i) { const int kk = 8 * i + kk8; f32x4 v = (f32x4){0.f, 0.f, 0.f, 0.f};
        if (ok) { v = *(const f32x4*)(src + (size_t)(k0 + kk) * Nsrc + nsrc0 + n4); if (gk) v = v * gk[k0 + kk]; }
        LAS float* sp = scr + kk * 33 + n4; sp[0] = v.x; sp[1] = v.y; sp[2] = v.z; sp[3] = v.w; }
    LDS_WAIT();
    const int c = lane & 7;
#pragma unroll
    for (int j = 0; j < 4; ++j) { const int n = (lane >> 3) + 8 * j; const LAS float* s = scr + (8 * c) * 33 + n;
        v4u o; o.x = pk2(s[0 * 33], s[1 * 33]); o.y = pk2(s[2 * 33], s[3 * 33]); o.z = pk2(s[4 * 33], s[5 * 33]); o.w = pk2(s[6 * 33], s[7 * 33]);
        *(v4u*)(dst + (size_t)(n0d + n) * K + k0 + 8 * c) = o; }
    LDS_WAIT();
}
constexpr int TI_IN = 1024, TI_OUT = 512, TI_GU = 2816, TI_DN = 1408, TI_PW = 32, TI_POOL = 8, TI_W1 = 64;
constexpr int TI_LAYER = TI_IN + TI_OUT + TI_GU + TI_DN + TI_PW + TI_POOL + 2 * TI_W1;

__device__ __forceinline__ void prologue_item(ArgP A, int it, LAS float* scr, int lane) {
    const int l = it / TI_LAYER; int r = it % TI_LAYER;
    unsigned char* wl = A->ws + WS_W + (size_t)l * WS_WL;
    if (r < TI_IN) { const int kb = r >> 6, nb = r & 63, n0d = 32 * nb; int ns = n0d, nv = 32;
        if (n0d >= ZC_D) ns = 1676 + (n0d - ZC_D); else if (n0d == ZC_G) { ns = 1664; nv = 12; } else if (n0d > ZC_G) { ns = 0; nv = 0; }
        tr_item(A->in[I_WIN] + (size_t)l * DM * INC, INC, DM, (bf16*)(wl + WO_IN), 64 * kb, n0d, ns, nv, scr, lane, A->in[I_GPM] + l * DM); return; }
    r -= TI_IN;
    if (r < TI_OUT) { const int kb = r >> 5, nb = r & 31;
        tr_item(A->in[I_WOUT] + (size_t)l * DM * DM, DM, DM, (bf16*)(wl + WO_OUT), 64 * kb, 32 * nb, 32 * nb, 32, scr, lane); return; }
    r -= TI_OUT;
    if (r < TI_GU) { const int kb = r / 176, nb = r % 176, n0d = 32 * nb, pn = n0d >> 8, bj = (n0d >> 7) & 1, i0 = n0d & 127;
        tr_item(A->in[I_GU] + (size_t)l * DM * 2 * FFH, 2 * FFH, DM, (bf16*)(wl + WO_GU), 64 * kb, n0d, bj * FFH + 128 * pn + i0, 32, scr, lane, A->in[I_GPF] + l * DM); return; }
    r -= TI_GU;
    if (r < TI_DN) { const int kb = r >> 5, nb = r & 31;
        tr_item(A->in[I_DN] + (size_t)l * FFH * DM, DM, FFH, (bf16*)(wl + WO_DN), 64 * kb, 32 * nb, 32 * nb, 32, scr, lane); return; }
    r -= TI_DN;
    if (r < TI_PW) { const int kb = r >> 3, nb = r & 7;
        tr_item(A->in[I_CVPW] + (size_t)l * 65536, 256, 256, (bf16*)(wl + WO_PW), 64 * kb, 32 * nb, 32 * nb, 32, scr, lane); return; }
    r -= TI_PW;
    if (r < TI_POOL) { const int g = r >> 1, nb = r & 1;
        tr_item(A->in[I_POOLW] + (size_t)l * 16384 + g * 4096, 64, 64, (bf16*)(wl + WO_POOL) + g * 4096, 0, 32 * nb, 32 * nb, 32, scr, lane); return; }
    r -= TI_POOL;
    if (r < TI_W1) { const int kb = r >> 1, nb = r & 1;
        tr_item(A->in[I_W1K] + (size_t)l * 131072, 64, 2048, (bf16*)(wl + WO_W1K), 64 * kb, 32 * nb, 32 * nb, 32, scr, lane); return; }
    r -= TI_W1;
    { const int kb = r >> 1, nb = r & 1;
        tr_item(A->in[I_W1V] + (size_t)l * 131072, 64, 2048, (bf16*)(wl + WO_W1V), 64 * kb, 32 * nb, 32 * nb, 32, scr, lane); }
}

struct NRow { f32x4 x[4], y[4]; };
template <bool HASY>
__device__ __forceinline__ void nr_load(NRow& r, const float* xin, const float* y, int m, int lane) {
    const f32x4* xr = (const f32x4*)(xin + (size_t)m * DM) + lane;
#pragma unroll
    for (int j = 0; j < 4; ++j) r.x[j] = xr[64 * j];
    if (HASY) { const f32x4* yr = (const f32x4*)(y + (size_t)m * DM) + lane;
#pragma unroll
        for (int j = 0; j < 4; ++j) r.y[j] = yr[64 * j]; }
}
template <bool HASY, bool HASH>
__device__ __forceinline__ void nr_proc(NRow& r, const float* g1, float* xout, const float* g2, bf16* Hout, int m, int lane) {
    if (HASY) { float ss = 0.f;
#pragma unroll
        for (int j = 0; j < 4; ++j) ss += (r.y[j].x * r.y[j].x + r.y[j].y * r.y[j].y) + (r.y[j].z * r.y[j].z + r.y[j].w * r.y[j].w);
        const float rr = 1.0f / sqrtf(wave_sum(ss) * (1.0f / DM) + 1e-6f);
        f32x4* xo = (f32x4*)(xout + (size_t)m * DM) + lane;
#pragma unroll
        for (int j = 0; j < 4; ++j) { const f32x4 g = ((const f32x4*)g1)[lane + 64 * j]; r.x[j] = r.x[j] + (r.y[j] * rr) * g; xo[64 * j] = r.x[j]; } }
    if (HASH) { float ss = 0.f;
#pragma unroll
        for (int j = 0; j < 4; ++j) ss += (r.x[j].x * r.x[j].x + r.x[j].y * r.x[j].y) + (r.x[j].z * r.x[j].z + r.x[j].w * r.x[j].w);
        const float rr = 1.0f / sqrtf(wave_sum(ss) * (1.0f / DM) + 1e-6f);
        v2u* ho = (v2u*)(Hout + (size_t)m * DM) + lane;
#pragma unroll
        for (int j = 0; j < 4; ++j) { const f32x4 g = ((const f32x4*)g2)[lane + 64 * j]; const f32x4 o = (r.x[j] * rr) * g; v2u w; w.x = pk2(o.x, o.y); w.y = pk2(o.z, o.w); ho[64 * j] = w; } }
}
template <bool HASY, bool HASH>
__device__ __forceinline__ void norm_rows(const float* xin, const float* y, const float* g1, float* xout, const float* g2, bf16* Hout, int gw, int ngw, int lane) {
    if ((MROWS % (2 * ngw)) == 0) {
        for (int m = gw; m < MROWS; m += 2 * ngw) {
            NRow ra, rb;
            nr_load<HASY>(ra, xin, y, m, lane); nr_load<HASY>(rb, xin, y, m + ngw, lane);
            nr_proc<HASY, HASH>(ra, g1, xout, g2, Hout, m, lane); nr_proc<HASY, HASH>(rb, g1, xout, g2, Hout, m + ngw, lane);
        }
    } else {
        for (int m = gw; m < MROWS; m += ngw) { NRow ra; nr_load<HASY>(ra, xin, y, m, lane); nr_proc<HASY, HASH>(ra, g1, xout, g2, Hout, m, lane); }
    }
}

__device__ __forceinline__ void norm_first(const float* xin, bf16* XB, float* R2, int bid, int G, int wave, int lane) {
    for (int c = bid; c < MROWS / 32; c += G)
        for (int i = 0; i < 4; ++i) { const int m = 32 * c + wave + 8 * i;
            const f32x4* xr = (const f32x4*)(xin + (size_t)m * DM) + lane; f32x4 xv[4]; float ss = 0.f;
#pragma unroll
            for (int j = 0; j < 4; ++j) { xv[j] = xr[64 * j]; ss += (xv[j].x * xv[j].x + xv[j].y * xv[j].y) + (xv[j].z * xv[j].z + xv[j].w * xv[j].w); }
            const float r = 1.0f / sqrtf(wave_sum(ss) * (1.0f / DM) + 1e-6f);
            if (lane == 0) R2[m] = r;
            v2u* ho = (v2u*)(XB + (size_t)m * DM) + lane;
#pragma unroll
            for (int j = 0; j < 4; ++j) { v2u w; w.x = pk2(xv[j].x, xv[j].y); w.y = pk2(xv[j].z, xv[j].w); ho[64 * j] = w; }
        }
}
template <bool LAST, int NR>
__device__ __forceinline__ void norm_bf_rows(const bf16* XB, bf16* XO, const bf16* Yb, const f32x4 (&g)[2][2], float* R2, float* out, int m0, int ngw, int lane) {
    v4u xw[NR][2], yw[NR][2];
#pragma unroll
    for (int r = 0; r < NR; ++r)
#pragma unroll
        for (int j = 0; j < 2; ++j) { const size_t o = (size_t)(m0 + r * ngw) * DM + 8 * lane + 512 * j; xw[r][j] = *(const v4u*)(XB + o); yw[r][j] = *(const v4u*)(Yb + o); }
#pragma unroll
    for (int r = 0; r < NR; ++r) { const int m = m0 + r * ngw;
        float xv[2][8], yv[2][8]; float ss = 0.f;
#pragma unroll
        for (int j = 0; j < 2; ++j) {
            xv[j][0] = bflo(xw[r][j].x); xv[j][1] = bfhi(xw[r][j].x); xv[j][2] = bflo(xw[r][j].y); xv[j][3] = bfhi(xw[r][j].y); xv[j][4] = bflo(xw[r][j].z); xv[j][5] = bfhi(xw[r][j].z); xv[j][6] = bflo(xw[r][j].w); xv[j][7] = bfhi(xw[r][j].w);
            yv[j][0] = bflo(yw[r][j].x); yv[j][1] = bfhi(yw[r][j].x); yv[j][2] = bflo(yw[r][j].y); yv[j][3] = bfhi(yw[r][j].y); yv[j][4] = bflo(yw[r][j].z); yv[j][5] = bfhi(yw[r][j].z); yv[j][6] = bflo(yw[r][j].w); yv[j][7] = bfhi(yw[r][j].w);
#pragma unroll
            for (int e = 0; e < 8; ++e) ss += yv[j][e] * yv[j][e]; }
        const float rr = 1.0f / sqrtf(wave_sum(ss) * (1.0f / DM) + 1e-6f);
        float s2 = 0.f;
#pragma unroll
        for (int j = 0; j < 2; ++j)
#pragma unroll
            for (int e = 0; e < 8; ++e) { xv[j][e] = xv[j][e] + (yv[j][e] * rr) * g[j][e >> 2][e & 3]; s2 += xv[j][e] * xv[j][e]; }
        if (LAST) {
#pragma unroll
            for (int j = 0; j < 2; ++j) { f32x4* op = (f32x4*)(out + (size_t)m * DM + 8 * lane + 512 * j); op[0] = (f32x4){xv[j][0], xv[j][1], xv[j][2], xv[j][3]}; op[1] = (f32x4){xv[j][4], xv[j][5], xv[j][6], xv[j][7]}; }
        } else {
            const float r2 = 1.0f / sqrtf(wave_sum(s2) * (1.0f / DM) + 1e-6f);
            if (lane == 0) R2[m] = r2;
#pragma unroll
            for (int j = 0; j < 2; ++j) { v4u w; w.x = pk2(xv[j][0], xv[j][1]); w.y = pk2(xv[j][2], xv[j][3]); w.z = pk2(xv[j][4], xv[j][5]); w.w = pk2(xv[j][6], xv[j][7]);
                *(v4u*)(XO + (size_t)m * DM + 8 * lane + 512 * j) = w; }
        }
    }
}
template <bool LAST>
__device__ __forceinline__ void norm_bf(const bf16* XB, bf16* XO, const bf16* Yb, const float* g1, float* R2, float* out, int bid, int G, int wave, int lane) {
    f32x4 g[2][2];
#pragma unroll
    for (int j = 0; j < 2; ++j) { g[j][0] = *(const f32x4*)(g1 + 8 * lane + 512 * j); g[j][1] = *(const f32x4*)(g1 + 8 * lane + 512 * j + 4); }
    for (int c = bid; c < MROWS / 32; c += G) norm_bf_rows<LAST, 4>(XB, XO, Yb, g, R2, out, 32 * c + wave, 8, lane);
}

__device__ __forceinline__ void mixer_a(ArgP A, int l, int item, LAS unsigned char* lds, int tid, int wave, int lane) {
    const bf16* Z = (const bf16*)(A->ws + WS_Z); bf16* MIX = (bf16*)(A->ws + WS_MIX);
    const bf16* sgw = (const bf16*)(A->ws + WS_W + (size_t)l * WS_WL + WO_SG);
    const int b = item >> 4, ch = item & 15; const size_t r0 = (size_t)b * SEQ + 128 * ch;
    LAS bf16* VT = (LAS bf16*)lds;
    LAS float* ST = (LAS float*)(lds + 69632);
    { const int s = tid >> 2, qd = tid & 3; float sm = 0.f, sq = 0.f;
#pragma unroll
        for (int i = 0; i < 8; ++i) { const v4u w = *(const v4u*)ZP(Z, r0 + s, ZC_AV + 64 * qd + 8 * i);
            const float a0 = bflo(w.x), a1 = bfhi(w.x), a2 = bflo(w.y), a3 = bfhi(w.y), a4 = bflo(w.z), a5 = bfhi(w.z), a6 = bflo(w.w), a7 = bfhi(w.w);
            sm += ((a0 + a1) + (a2 + a3)) + ((a4 + a5) + (a6 + a7)); sq += ((a0 * a0 + a1 * a1) + (a2 * a2 + a3 * a3)) + ((a4 * a4 + a5 * a5) + (a6 * a6 + a7 * a7)); }
        sm += __shfl_xor(sm, 1); sq += __shfl_xor(sq, 1); sm += __shfl_xor(sm, 2); sq += __shfl_xor(sq, 2);
        const float mu = sm * (1.0f / 256.0f), var = fmaxf(sq * (1.0f / 256.0f) - mu * mu, 0.f);
        if (qd == 0) { ST[2 * s] = mu; ST[2 * s + 1] = 1.0f / sqrtf(var + 1e-5f); } }
    __syncthreads();
    { const int s = tid & 127, og = tid >> 7; const float mu = ST[2 * s], rs = ST[2 * s + 1];
        const float* gp = A->in[I_SGLN] + l * 256;
#pragma unroll
        for (int i = 0; i < 8; ++i) { const int oct = og + 4 * i;
            const v4u w = *(const v4u*)ZP(Z, r0 + s, ZC_AV + 8 * oct);
            const f32x4 g0 = *(const f32x4*)(gp + 8 * oct), g1 = *(const f32x4*)(gp + 8 * oct + 4);
            LAS bf16* vp = VT + (8 * oct) * 136 + s;
            vp[0 * 136] = (bf16)f2bf((bflo(w.x) - mu) * rs * g0.x); vp[1 * 136] = (bf16)f2bf((bfhi(w.x) - mu) * rs * g0.y);
            vp[2 * 136] = (bf16)f2bf((bflo(w.y) - mu) * rs * g0.z); vp[3 * 136] = (bf16)f2bf((bfhi(w.y) - mu) * rs * g0.w);
            vp[4 * 136] = (bf16)f2bf((bflo(w.z) - mu) * rs * g1.x); vp[5 * 136] = (bf16)f2bf((bfhi(w.z) - mu) * rs * g1.y);
            vp[6 * 136] = (bf16)f2bf((bflo(w.w) - mu) * rs * g1.z); vp[7 * 136] = (bf16)f2bf((bfhi(w.w) - mu) * rs * g1.w); } }
    __syncthreads();
    const int h = wave >> 1, th = wave & 1, fr = lane & 15, q = lane >> 4;
    f32x4 acc[4][4];
#pragma unroll
    for (int a = 0; a < 4; ++a)
#pragma unroll
        for (int c = 0; c < 4; ++c) acc[a][c] = (f32x4){0.f, 0.f, 0.f, 0.f};
    const bf16* Wb = sgw + (size_t)h * 128 * 128;
#pragma unroll
    for (int ks = 0; ks < 4; ++ks) {
        v4u vf[4];
#pragma unroll
        for (int nt = 0; nt < 4; ++nt) vf[nt] = *(const LAS v4u*)(VT + (64 * h + 16 * nt + fr) * 136 + 32 * ks + 8 * q);
#pragma unroll
        for (int mt = 0; mt < 4; ++mt) { const int t = 64 * th + 16 * mt + fr; const v4u wf = *(const v4u*)(Wb + t * 128 + 32 * ks + 8 * q);
#pragma unroll
            for (int nt = 0; nt < 4; ++nt) acc[mt][nt] = mfma16(vf[nt], wf, acc[mt][nt]); }
    }
#pragma unroll
    for (int mt = 0; mt < 4; ++mt) { const int t = 64 * th + 16 * mt + fr; const float bias = A->in[I_SGB][l * 512 + h * 128 + t];
#pragma unroll
        for (int nt = 0; nt < 4; ++nt) { const int d0 = 64 * h + 16 * nt + 4 * q;
            const v2u uw = *(const v2u*)ZP(Z, r0 + t, ZC_AU + d0); const f32x4 a = acc[mt][nt];
            v2u o; o.x = pk2(bflo(uw.x) * (a.x + bias), bfhi(uw.x) * (a.y + bias)); o.y = pk2(bflo(uw.y) * (a.z + bias), bfhi(uw.y) * (a.w + bias));
            *(v2u*)(MIX + (r0 + t) * DM + d0) = o; } }
    __syncthreads();
}

__device__ __forceinline__ void mixer_b(ArgP A, int l, int item, LAS unsigned char* lds, int tid, int wave, int lane) {
    const bf16* Z = (const bf16*)(A->ws + WS_Z); bf16* MIX = (bf16*)(A->ws + WS_MIX);
    const bf16* pwt = (const bf16*)(A->ws + WS_W + (size_t)l * WS_WL + WO_PW);
    const int b = item >> 5, tau = item & 31, t0 = 64 * tau; const size_t r0 = (size_t)b * SEQ + t0;
    LAS bf16* Ht = (LAS bf16*)lds;
    LAS float* CO = (LAS float*)(lds + 49152);
    LAS bf16* AT = (LAS bf16*)lds;
    {
        v4u av[6], gv[6];
#pragma unroll
        for (int it_ = 0; it_ < 6; ++it_) { int idx = tid + it_ * NTHREADS; idx = idx < 94 * 32 ? idx : 94 * 32 - 1; const int i = idx >> 5, oct = idx & 31, t = t0 - 30 + i;
            const size_t zr = (size_t)b * SEQ + (t > 0 ? t : 0); av[it_] = *(const v4u*)ZP(Z, zr, ZC_BA + 8 * oct); gv[it_] = *(const v4u*)ZP(Z, zr, ZC_BG + 8 * oct); }
#pragma unroll
        for (int it_ = 0; it_ < 6; ++it_) { const int idx = tid + it_ * NTHREADS; if (idx < 94 * 32) { const int i = idx >> 5, oct = idx & 31, t = t0 - 30 + i; v4u o = (v4u){0u, 0u, 0u, 0u};
                if (t >= 0) { const v4u a = av[it_], g = gv[it_];
                    o.x = pk2(bflo(a.x) * sigmoidf_(bflo(g.x)), bfhi(a.x) * sigmoidf_(bfhi(g.x))); o.y = pk2(bflo(a.y) * sigmoidf_(bflo(g.y)), bfhi(a.y) * sigmoidf_(bfhi(g.y)));
                    o.z = pk2(bflo(a.z) * sigmoidf_(bflo(g.z)), bfhi(a.z) * sigmoidf_(bfhi(g.z))); o.w = pk2(bflo(a.w) * sigmoidf_(bflo(g.w)), bfhi(a.w) * sigmoidf_(bfhi(g.w))); }
                *(LAS v4u*)(Ht + i * 256 + 8 * oct) = o; } }
    }
    __syncthreads();
    { const int c = tid & 255, half = tid >> 8; float wt[31];
#pragma unroll
        for (int w = 0; w < 31; ++w) wt[w] = A->in[I_CVW][(size_t)l * 31 * 256 + w * 256 + c];
        const float bias = A->in[I_CVB][l * 256 + c];
#pragma unroll 1
        for (int tg = 0; tg < 4; ++tg) { const int tb = 32 * half + 8 * tg; float ac[8];
#pragma unroll
            for (int j = 0; j < 8; ++j) ac[j] = bias;
#pragma unroll
            for (int i = 0; i < 38; ++i) { const float hv = bf2f(Ht[(tb + i) * 256 + c]);
#pragma unroll
                for (int j = 0; j < 8; ++j) if (i - j >= 0 && i - j < 31) ac[j] += hv * wt[i - j]; }
#pragma unroll
            for (int j = 0; j < 8; ++j) CO[(tb + j) * 256 + c] = ac[j]; } }
    __syncthreads();
    v4u bpf[8][2];
#pragma unroll
    for (int ks = 0; ks < 8; ++ks)
#pragma unroll
        for (int nt = 0; nt < 2; ++nt) bpf[ks][nt] = *(const v4u*)(pwt + (32 * wave + 16 * nt + (lane & 15)) * 256 + 32 * ks + 8 * (lane >> 4));
    { const f32x4 g = *(const f32x4*)(A->in[I_CVLG] + l * 256 + 4 * lane), bb = *(const f32x4*)(A->in[I_CVLB] + l * 256 + 4 * lane);
#if MIXB_LNNEW
        f32x4 v[8]; float sm[8];
#pragma unroll
        for (int i = 0; i < 8; ++i) { v[i] = *(const LAS f32x4*)(CO + (8 * wave + i) * 256 + 4 * lane); sm[i] = (v[i].x + v[i].y) + (v[i].z + v[i].w); }
#pragma unroll
        for (int o = 1; o < 64; o <<= 1)
#pragma unroll
            for (int i = 0; i < 8; ++i) sm[i] += __shfl_xor(sm[i], o);
#pragma unroll
        for (int i = 0; i < 8; ++i) { v[i] = v[i] - sm[i] * (1.0f / 256.0f); sm[i] = (v[i].x * v[i].x + v[i].y * v[i].y) + (v[i].z * v[i].z + v[i].w * v[i].w); }
#pragma unroll
        for (int o = 1; o < 64; o <<= 1)
#pragma unroll
            for (int i = 0; i < 8; ++i) sm[i] += __shfl_xor(sm[i], o);
#pragma unroll
        for (int i = 0; i < 8; ++i) { const float rs = 1.0f / sqrtf(sm[i] * (1.0f / 256.0f) + 1e-5f);
            const f32x4 y = (v[i] * rs) * g + bb; v2u o; o.x = pk2(siluf_(y.x), siluf_(y.y)); o.y = pk2(siluf_(y.z), siluf_(y.w));
            *(LAS v2u*)(AT + (8 * wave + i) * 264 + 4 * lane) = o; } }
#else
        for (int i = 0; i < 8; ++i) { const int t = 8 * wave + i; const f32x4 v = *(const LAS f32x4*)(CO + t * 256 + 4 * lane);
            const float mu = wave_sum((v.x + v.y) + (v.z + v.w)) * (1.0f / 256.0f); const f32x4 d = v - mu;
            const float var = wave_sum((d.x * d.x + d.y * d.y) + (d.z * d.z + d.w * d.w)) * (1.0f / 256.0f); const float rs = 1.0f / sqrtf(var + 1e-5f);
            const f32x4 y = (d * rs) * g + bb; v2u o; o.x = pk2(siluf_(y.x), siluf_(y.y)); o.y = pk2(siluf_(y.z), siluf_(y.w));
            *(LAS v2u*)(AT + t * 264 + 4 * lane) = o; } }
#endif
    __syncthreads();
    const int fr = lane & 15, q = lane >> 4;
    f32x4 acc[4][2];
#pragma unroll
    for (int a = 0; a < 4; ++a)
#pragma unroll
        for (int c = 0; c < 2; ++c) acc[a][c] = (f32x4){0.f, 0.f, 0.f, 0.f};
#pragma unroll
    for (int ks = 0; ks < 8; ++ks) {
#pragma unroll
        for (int mt = 0; mt < 4; ++mt) { const v4u af = *(const LAS v4u*)(AT + (16 * mt + fr) * 264 + 32 * ks + 8 * q);
#pragma unroll
            for (int nt = 0; nt < 2; ++nt) acc[mt][nt] = mfma16(bpf[ks][nt], af, acc[mt][nt]); } }
#pragma unroll
    for (int mt = 0; mt < 4; ++mt)
#pragma unroll
        for (int nt = 0; nt < 2; ++nt) { const int n0 = 32 * wave + 16 * nt + 4 * q; const f32x4 pb = *(const f32x4*)(A->in[I_CVPB] + l * 256 + n0); const f32x4 o = acc[mt][nt] + pb;
            v2u w; w.x = pk2(o.x, o.y); w.y = pk2(o.z, o.w); *(v2u*)(MIX + (r0 + 16 * mt + fr) * DM + 256 + n0) = w; }
    __syncthreads();
}

template <int W>
__device__ __forceinline__ void pool_means(const LAS bf16* Xt, LAS bf16* AT, int c, int half, int t0) {
    float xv[47];
#pragma unroll
    for (int i = 0; i < 47; ++i) xv[i] = (i >= 16 - W) ? bf2f(Xt[(32 * half + i) * 256 + c]) : 0.f;
    float s = 0.f;
#pragma unroll
    for (int i = 0; i < W; ++i) s += xv[15 - i];
#pragma unroll
    for (int j = 0; j < 32; ++j) { const int jj = 32 * half + j, t = t0 + jj;
        if (j > 0) s += xv[15 + j] - xv[15 + j - W];
        const int cnt = (t + 1 < W) ? (t + 1) : W;
        AT[jj * 264 + c] = (bf16)f2bf(s / (float)cnt - xv[15 + j]); }
}

__device__ __forceinline__ void mixer_d(ArgP A, int l, int item, LAS unsigned char* lds, int tid, int wave, int lane) {
    const bf16* Z = (const bf16*)(A->ws + WS_Z); bf16* MIX = (bf16*)(A->ws + WS_MIX);
    const bf16* poolt = (const bf16*)(A->ws + WS_W + (size_t)l * WS_WL + WO_POOL);
    bf16* VTS = (bf16*)(A->ws + WS_VTS); bf16* VTW = (bf16*)(A->ws + WS_VTW);
    const int b = item >> 5, tau = item & 31, t0 = 64 * tau; const size_t r0 = (size_t)b * SEQ + t0;
    LAS bf16* Xt = (LAS bf16*)lds;
    LAS bf16* AT = (LAS bf16*)(lds + 40960);
    LAS bf16* TS = (LAS bf16*)(lds + 75776);
    {
        v4u xv[5];
#pragma unroll
        for (int it_ = 0; it_ < 5; ++it_) { int idx = tid + it_ * NTHREADS; idx = idx < 79 * 32 ? idx : 79 * 32 - 1; const int i = idx >> 5, oct = idx & 31, t = t0 - 15 + i;
            xv[it_] = *(const v4u*)ZP(Z, (size_t)b * SEQ + (t > 0 ? t : 0), ZC_D + 8 * oct); }
#pragma unroll
        for (int it_ = 0; it_ < 5; ++it_) { const int idx = tid + it_ * NTHREADS; if (idx < 79 * 32) { const int i = idx >> 5, oct = idx & 31, t = t0 - 15 + i;
                *(LAS v4u*)(Xt + i * 256 + 8 * oct) = (t >= 0) ? xv[it_] : (v4u){0u, 0u, 0u, 0u}; } }
    }
    { const int tok = tid & 63, oct = tid >> 6;
        const v4u a = *(const v4u*)ZP(Z, r0 + tok, ZC_VS + 8 * oct), c = *(const v4u*)ZP(Z, r0 + tok, ZC_VW + 8 * oct);
        LAS bf16* p0 = TS + (8 * oct) * 72 + tok; LAS bf16* p1 = p0 + 4608;
        p0[0] = (bf16)(a.x & 0xffffu); p0[72] = (bf16)(a.x >> 16); p0[144] = (bf16)(a.y & 0xffffu); p0[216] = (bf16)(a.y >> 16);
        p0[288] = (bf16)(a.z & 0xffffu); p0[360] = (bf16)(a.z >> 16); p0[432] = (bf16)(a.w & 0xffffu); p0[504] = (bf16)(a.w >> 16);
        p1[0] = (bf16)(c.x & 0xffffu); p1[72] = (bf16)(c.x >> 16); p1[144] = (bf16)(c.y & 0xffffu); p1[216] = (bf16)(c.y >> 16);
        p1[288] = (bf16)(c.z & 0xffffu); p1[360] = (bf16)(c.z >> 16); p1[432] = (bf16)(c.w & 0xffffu); p1[504] = (bf16)(c.w >> 16); }
    __syncthreads();
#if MIXD_NEW
    { const int c = tid & 255, half = tid >> 8, g = c >> 6;
        if (g == 0) pool_means<2>(Xt, AT, c, half, t0); else if (g == 1) pool_means<4>(Xt, AT, c, half, t0); else if (g == 2) pool_means<8>(Xt, AT, c, half, t0); else pool_means<16>(Xt, AT, c, half, t0); }
#else
    { const int c = tid & 255, half = tid >> 8, g = c >> 6, w = 2 << g;
        for (int j = 0; j < 32; ++j) { const int jj = 32 * half + j, t = t0 + jj; float s = 0.f;
            for (int i = 0; i < w; ++i) s += bf2f(Xt[(15 + jj - i) * 256 + c]);
            const int cnt = (t + 1 < w) ? (t + 1) : w;
            const float mval = s / (float)cnt - bf2f(Xt[(15 + jj) * 256 + c]);
            AT[jj * 264 + c] = (bf16)f2bf(mval); } }
#endif
    { const int d = tid >> 3, pc = tid & 7;
        *(v4u*)(VTS + ((size_t)b * 64 + d) * SEQ + t0 + 8 * pc) = *(const LAS v4u*)(TS + d * 72 + 8 * pc);
        *(v4u*)(VTW + ((size_t)b * 64 + d) * SEQ + t0 + 8 * pc) = *(const LAS v4u*)(TS + 4608 + d * 72 + 8 * pc); }
    __syncthreads();
    const int fr = lane & 15, q = lane >> 4, g = wave >> 1, nh = wave & 1;
    f32x4 acc[4][2];
#pragma unroll
    for (int a = 0; a < 4; ++a)
#pragma unroll
        for (int c = 0; c < 2; ++c) acc[a][c] = (f32x4){0.f, 0.f, 0.f, 0.f};
#pragma unroll
    for (int ks = 0; ks < 2; ++ks) { v4u bfr[2];
#pragma unroll
        for (int nt = 0; nt < 2; ++nt) bfr[nt] = *(const v4u*)(poolt + g * 4096 + (32 * nh + 16 * nt + fr) * 64 + 32 * ks + 8 * q);
#pragma unroll
        for (int mt = 0; mt < 4; ++mt) { const v4u af = *(const LAS v4u*)(AT + (16 * mt + fr) * 264 + 64 * g + 32 * ks + 8 * q);
#pragma unroll
            for (int nt = 0; nt < 2; ++nt) acc[mt][nt] = mfma16(bfr[nt], af, acc[mt][nt]); } }
#pragma unroll
    for (int mt = 0; mt < 4; ++mt)
#pragma unroll
        for (int nt = 0; nt < 2; ++nt) { const int n0 = 64 * g + 32 * nh + 16 * nt + 4 * q; const f32x4 sc = *(const f32x4*)(A->in[I_POOLS] + l * 256 + n0); const f32x4 o = acc[mt][nt] * sc;
            v2u w; w.x = pk2(o.x, o.y); w.y = pk2(o.z, o.w); *(v2u*)(MIX + (r0 + 16 * mt + fr) * DM + 768 + n0) = w; }
    __syncthreads();
}

__device__ __forceinline__ void nsa_compress(ArgP A, int l, int item, LAS unsigned char* lds, int tid, int wave, int lane) {
    const bf16* Z = (const bf16*)(A->ws + WS_Z);
    bf16* KC = (bf16*)(A->ws + WS_KC); bf16* VCT = (bf16*)(A->ws + WS_VCT);
    const int b = item >> 4, kv = (item >> 3) & 1, mt = item & 7;
    const int colb = kv ? ZC_VC : ZC_KC;
    const float* pos = A->in[kv ? I_POSV : I_POSK] + l * 2048;
    const bf16* w1t = (const bf16*)(A->ws + WS_W + (size_t)l * WS_WL + (kv ? WO_W1V : WO_W1K));
    const float* w2 = A->in[kv ? I_W2V : I_W2K] + l * 4096;
    LAS float* RED = (LAS float*)lds;
    LAS float* H1 = (LAS float*)(lds + 32768);
    const int fr = lane & 15, q = lane >> 4, c = 16 * mt + fr; const bool cok = c < 127;
    f32x4 acc[4];
#pragma unroll
    for (int n = 0; n < 4; ++n) acc[n] = (f32x4){0.f, 0.f, 0.f, 0.f};
#pragma unroll 4
    for (int kk = 0; kk < 8; ++kk) { const int ks = 8 * wave + kk, ltok = ks >> 1, dd = 32 * (ks & 1) + 8 * q;
        v4u af = (v4u){0u, 0u, 0u, 0u};
        if (cok) { const v4u zw = *(const v4u*)ZP(Z, (size_t)b * SEQ + 16 * c + ltok, colb + dd);
            const f32x4 p0 = *(const f32x4*)(pos + ltok * 64 + dd), p1 = *(const f32x4*)(pos + ltok * 64 + dd + 4);
            af.x = pk2(bflo(zw.x) + p0.x, bfhi(zw.x) + p0.y); af.y = pk2(bflo(zw.y) + p0.z, bfhi(zw.y) + p0.w);
            af.z = pk2(bflo(zw.z) + p1.x, bfhi(zw.z) + p1.y); af.w = pk2(bflo(zw.w) + p1.z, bfhi(zw.w) + p1.w); }
#pragma unroll
        for (int nt = 0; nt < 4; ++nt) { const v4u bfr = *(const v4u*)(w1t + (16 * nt + fr) * 2048 + 32 * ks + 8 * q); acc[nt] = mfma16(af, bfr, acc[nt]); } }
#pragma unroll
    for (int nt = 0; nt < 4; ++nt)
#pragma unroll
        for (int rg = 0; rg < 4; ++rg) RED[(wave * 16 + 4 * q + rg) * 64 + 16 * nt + fr] = acc[nt][rg];
    __syncthreads();
#pragma unroll
    for (int x = 0; x < 2; ++x) { const int o = tid + 512 * x, cc = o >> 6, n = o & 63; float s = 0.f;
#pragma unroll
        for (int w = 0; w < 8; ++w) s += RED[(w * 16 + cc) * 64 + n];
        H1[o] = siluf_(s); }
    __syncthreads();
#pragma unroll
    for (int x = 0; x < 2; ++x) { const int o = tid + 512 * x, cc = o >> 6, n2 = o & 63; float s = 0.f;
        for (int n = 0; n < 64; ++n) s += H1[cc * 64 + n] * w2[n * 64 + n2];
        const int cg_ = 16 * mt + cc;
        (kv == 0 ? KC : VCT)[((size_t)b * 128 + cg_) * 64 + n2] = (bf16)f2bf(s); }
    __syncthreads();
}

template <int HA, int HB, class MaskA, class MaskB>
__device__ __forceinline__ void attn_pair(const LAS bf16* KT, const LAS bf16* VT, const v4u (&qf)[2], int fr, int q, float& m_run, f32x4& o5, f32x4 (&o)[4],
                                          float rba, float rbb, bool ma, bool mb, MaskA okA, MaskB okB) {
    constexpr int N0 = HA ? 0 : 4, N1 = HB ? 8 : 4, K0 = HA ? 0 : 2, K1 = HB ? 4 : 2;
    v4u kf0[8], kf1[8];
#pragma unroll
    for (int nt = N0; nt < N1; ++nt) { kf0[nt] = *(const LAS v4u*)(KT + (16 * nt + fr) * 72 + 8 * q); kf1[nt] = *(const LAS v4u*)(KT + (16 * nt + fr) * 72 + 32 + 8 * q); }
    __builtin_amdgcn_sched_barrier(0);
    f32x4 s[8];
#pragma unroll
    for (int nt = N0; nt < N1; ++nt) { const float rb = nt < 4 ? rba : rbb;
        s[nt] = mfma16(kf0[nt], qf[0], (f32x4){rb, rb, rb, rb}); s[nt] = mfma16(kf1[nt], qf[1], s[nt]); }
    __builtin_amdgcn_sched_barrier(0);
    v2u vfa[4][4], vfb[4][4];
#pragma unroll
    for (int k2 = K0; k2 < K1; ++k2)
#pragma unroll
        for (int dt = 0; dt < 4; ++dt) { vfa[k2][dt] = *(const LAS v2u*)(VT + (16 * dt + fr) * 136 + 32 * k2 + 4 * q); vfb[k2][dt] = *(const LAS v2u*)(VT + (16 * dt + fr) * 136 + 32 * k2 + 16 + 4 * q); }
    __builtin_amdgcn_sched_barrier(0);
    if (HA && ma) {
#pragma unroll
        for (int nt = 0; nt < 4; ++nt)
#pragma unroll
            for (int rg = 0; rg < 4; ++rg) s[nt][rg] = okA(16 * nt + 4 * q + rg) ? s[nt][rg] : -1e30f; }
    if (HB && mb) {
#pragma unroll
        for (int nt = 0; nt < 4; ++nt)
#pragma unroll
            for (int rg = 0; rg < 4; ++rg) s[4 + nt][rg] = okB(16 * nt + 4 * q + rg) ? s[4 + nt][rg] : -1e30f; }
    float mx = m_run;
#pragma unroll
    for (int nt = N0; nt < N1; ++nt)
#pragma unroll
        for (int rg = 0; rg < 4; ++rg) mx = fmaxf(mx, s[nt][rg]);
    mx = fmaxf(mx, __shfl_xor(mx, 16)); mx = fmaxf(mx, __shfl_xor(mx, 32));
    if (__ballot(mx != m_run) != 0ull) {
        const float sc = __builtin_amdgcn_exp2f(m_run - mx); m_run = mx; o5 = o5 * sc;
#pragma unroll
        for (int dt = 0; dt < 4; ++dt) o[dt] = o[dt] * sc; }
#pragma unroll
    for (int nt = N0; nt < N1; ++nt)
#pragma unroll
        for (int rg = 0; rg < 4; ++rg) s[nt][rg] = __builtin_amdgcn_exp2f(s[nt][rg] - mx);
    const unsigned onesw = (fr == 0) ? 0x3f803f80u : 0u; const v4u vones = (v4u){onesw, onesw, onesw, onesw};
#pragma unroll
    for (int k2 = K0; k2 < K1; ++k2) { v4u pf; pf.x = pk2(s[2 * k2][0], s[2 * k2][1]); pf.y = pk2(s[2 * k2][2], s[2 * k2][3]); pf.z = pk2(s[2 * k2 + 1][0], s[2 * k2 + 1][1]); pf.w = pk2(s[2 * k2 + 1][2], s[2 * k2 + 1][3]);
        o5 = mfma16(vones, pf, o5);
#pragma unroll
        for (int dt = 0; dt < 4; ++dt) { v4u vf; vf.x = vfa[k2][dt].x; vf.y = vfa[k2][dt].y; vf.z = vfb[k2][dt].x; vf.w = vfb[k2][dt].y; o[dt] = mfma16(vf, pf, o[dt]); } }
}

template <class MaskF>
__device__ __forceinline__ void attn_tile2(const LAS bf16* KT, const LAS bf16* VT, const v4u (&qf)[2][2], int fr, int q, float (&m_run)[2], f32x4 (&o5)[2], f32x4 (&o)[2][4],
                                           const bool (&need)[2], const float (&rb)[2], bool masked, MaskF okf) {
    v4u kf0[4], kf1[4];
#pragma unroll
    for (int nt = 0; nt < 4; ++nt) { kf0[nt] = *(const LAS v4u*)(KT + (16 * nt + fr) * 72 + 8 * q); kf1[nt] = *(const LAS v4u*)(KT + (16 * nt + fr) * 72 + 32 + 8 * q); }
    __builtin_amdgcn_sched_barrier(0);
    f32x4 s[2][4];
#pragma unroll
    for (int g = 0; g < 2; ++g) if (need[g]) {
#pragma unroll
        for (int nt = 0; nt < 4; ++nt) { s[g][nt] = mfma16(kf0[nt], qf[g][0], (f32x4){rb[g], rb[g], rb[g], rb[g]}); s[g][nt] = mfma16(kf1[nt], qf[g][1], s[g][nt]); } }
    __builtin_amdgcn_sched_barrier(0);
    v2u vfa[2][4], vfb[2][4];
#pragma unroll
    for (int k2 = 0; k2 < 2; ++k2)
#pragma unroll
        for (int dt = 0; dt < 4; ++dt) { vfa[k2][dt] = *(const LAS v2u*)(VT + (16 * dt + fr) * 72 + 32 * k2 + 4 * q); vfb[k2][dt] = *(const LAS v2u*)(VT + (16 * dt + fr) * 72 + 32 * k2 + 16 + 4 * q); }
    __builtin_amdgcn_sched_barrier(0);
    const unsigned onesw = (fr == 0) ? 0x3f803f80u : 0u; const v4u vones = (v4u){onesw, onesw, onesw, onesw};
#pragma unroll
    for (int g = 0; g < 2; ++g) if (need[g]) {
        if (masked) {
#pragma unroll
            for (int nt = 0; nt < 4; ++nt)
#pragma unroll
                for (int rg = 0; rg < 4; ++rg) s[g][nt][rg] = okf(g, 16 * nt + 4 * q + rg) ? s[g][nt][rg] : -1e30f; }
        float mx = m_run[g];
#pragma unroll
        for (int nt = 0; nt < 4; ++nt)
#pragma unroll
            for (int rg = 0; rg < 4; ++rg) mx = fmaxf(mx, s[g][nt][rg]);
        mx = fmaxf(mx, __shfl_xor(mx, 16)); mx = fmaxf(mx, __shfl_xor(mx, 32));
        if (__ballot(mx != m_run[g]) != 0ull) { const float sc = __builtin_amdgcn_exp2f(m_run[g] - mx); m_run[g] = mx; o5[g] = o5[g] * sc;
#pragma unroll
            for (int dt = 0; dt < 4; ++dt) o[g][dt] = o[g][dt] * sc; }
#pragma unroll
        for (int nt = 0; nt < 4; ++nt)
#pragma unroll
            for (int rg = 0; rg < 4; ++rg) s[g][nt][rg] = __builtin_amdgcn_exp2f(s[g][nt][rg] - mx);
#pragma unroll
        for (int k2 = 0; k2 < 2; ++k2) { v4u pf; pf.x = pk2(s[g][2 * k2][0], s[g][2 * k2][1]); pf.y = pk2(s[g][2 * k2][2], s[g][2 * k2][3]); pf.z = pk2(s[g][2 * k2 + 1][0], s[g][2 * k2 + 1][1]); pf.w = pk2(s[g][2 * k2 + 1][2], s[g][2 * k2 + 1][3]);
            o5[g] = mfma16(vones, pf, o5[g]);
#pragma unroll
            for (int dt = 0; dt < 4; ++dt) { v4u vf; vf.x = vfa[k2][dt].x; vf.y = vfa[k2][dt].y; vf.z = vfb[k2][dt].x; vf.w = vfb[k2][dt].y; o[g][dt] = mfma16(vf, pf, o[g][dt]); } } }
}

__device__ __forceinline__ void nsa_attn(ArgP A, int l, int item, LAS unsigned char* lds, int tid, int wave, int lane) {
#define Z ((const bf16*)(A->ws + WS_Z))
#define MIX ((bf16*)(A->ws + WS_MIX))
#define VTS ((const bf16*)(A->ws + WS_VTS))
#define VTW ((const bf16*)(A->ws + WS_VTW))
#define KC ((const bf16*)(A->ws + WS_KC))
#define VCT ((const bf16*)(A->ws + WS_VCT))
    const int jq = item >> 8, ib = item & 255, b = 2 * (ib & 7) + ((ib >> 3) & 1), a = ib >> 4;
    const int tau = jq ? 31 - a : a;
    const int t0 = 64 * tau, curb = tau, wlo = (tau >= 8) ? tau - 8 : 0;
    LAS bf16* KT = (LAS bf16*)lds; LAS bf16* VT = KT + 9216;
    LAS bf16* TB = (LAS bf16*)(lds + 35840);
    LAS float* PS = (LAS float*)(lds + 72704) + wave * (16 * 132);
    LAS float* IMP = (LAS float*)(lds + 140288) + wave * 128;
    LAS unsigned* WANY = (LAS unsigned*)(lds + 144384);
    const int fr = lane & 15, q = lane >> 4, tt = fr >> 2, hh = fr & 3;
    const int skey = tid >> 3, spc = tid & 7;
    const size_t krow = (size_t)b * SEQ + skey;
#define KADDR(j, col) ZP(Z, krow + 64 * (j), (col) + 8 * spc)
    const size_t vbase = ((size_t)b * 64 + skey) * SEQ + 8 * spc;
    v4u kr = *(const v4u*)KADDR(0, ZC_KS), vr = *(const v4u*)(VTS + vbase);
    int tq[2]; size_t grow[2]; v4u qf[2][2]; float g0[2], g1[2], g2[2];
#pragma unroll
    for (int g = 0; g < 2; ++g) { tq[g] = t0 + 8 * wave + 4 * g + tt; grow[g] = (size_t)b * SEQ + tq[g];
#pragma unroll
        for (int ks = 0; ks < 2; ++ks) { const v4u w = *(const v4u*)ZP(Z, grow[g], ZC_Q + 64 * hh + 32 * ks + 8 * q);
            const float qs = 0.125f * 1.4426950408889634f;
            qf[g][ks].x = pk2(bflo(w.x) * qs, bfhi(w.x) * qs); qf[g][ks].y = pk2(bflo(w.y) * qs, bfhi(w.y) * qs);
            qf[g][ks].z = pk2(bflo(w.z) * qs, bfhi(w.z) * qs); qf[g][ks].w = pk2(bflo(w.w) * qs, bfhi(w.w) * qs); }
        g0[g] = sigmoidf_(bf2f(*ZP(Z, grow[g], ZC_G + 3 * hh + 0))); g1[g] = sigmoidf_(bf2f(*ZP(Z, grow[g], ZC_G + 3 * hh + 1))); g2[g] = sigmoidf_(bf2f(*ZP(Z, grow[g], ZC_G + 3 * hh + 2))); }
#pragma unroll
    for (int x = 0; x < 2; ++x) { const int pi = tid + 512 * x;
        { const int c = pi >> 3, pc = pi & 7; *(LAS v4u*)(KT + c * 72 + 8 * pc) = *(const v4u*)(KC + ((size_t)b * 128 + c) * 64 + 8 * pc); }
        { const int c = pi >> 3, pc = pi & 7; const v4u w = *(const v4u*)(VCT + ((size_t)b * 128 + c) * 64 + 8 * pc); LAS bf16* vp = VT + (8 * pc) * 136 + c;
            vp[0] = (bf16)(w.x & 0xffffu); vp[136] = (bf16)(w.x >> 16); vp[272] = (bf16)(w.y & 0xffffu); vp[408] = (bf16)(w.y >> 16);
            vp[544] = (bf16)(w.z & 0xffffu); vp[680] = (bf16)(w.z >> 16); vp[816] = (bf16)(w.w & 0xffffu); vp[952] = (bf16)(w.w >> 16); } }
    __syncthreads();
    f32x4 facc[2][4];
    unsigned msk[2], wny[2];
#pragma unroll 1
    for (int g = 0; g < 2; ++g) {
        const int t = t0 + 8 * wave + 4 * g + tt;
        const v4u q0 = g ? qf[1][0] : qf[0][0], q1 = g ? qf[1][1] : qf[0][1];
        f32x4 s[8];
#pragma unroll
        for (int nt = 0; nt < 8; ++nt) { const v4u k0 = *(const LAS v4u*)(KT + (16 * nt + fr) * 72 + 8 * q), k1 = *(const LAS v4u*)(KT + (16 * nt + fr) * 72 + 32 + 8 * q);
            s[nt] = mfma16(k0, q0, (f32x4){0.f, 0.f, 0.f, 0.f}); s[nt] = mfma16(k1, q1, s[nt]); }
        float mx = -1e30f;
#pragma unroll
        for (int nt = 0; nt < 8; ++nt)
#pragma unroll
            for (int rg = 0; rg < 4; ++rg) { const int c = 16 * nt + 4 * q + rg; const float v = (16 * c + 31 <= t) ? s[nt][rg] : -1e30f; s[nt][rg] = v; mx = fmaxf(mx, v); }
        mx = fmaxf(mx, __shfl_xor(mx, 16)); mx = fmaxf(mx, __shfl_xor(mx, 32));
        float sum = 0.f;
#pragma unroll
        for (int nt = 0; nt < 8; ++nt)
#pragma unroll
            for (int rg = 0; rg < 4; ++rg) { const float p = (s[nt][rg] > -5e29f) ? __builtin_amdgcn_exp2f(s[nt][rg] - mx) : 0.f; s[nt][rg] = p; sum += p; }
        sum += __shfl_xor(sum, 16); sum += __shfl_xor(sum, 32);
        const float inv = (t >= 31) ? 1.0f / sum : 0.f;
#pragma unroll
        for (int nt = 0; nt < 8; ++nt) { s[nt] = s[nt] * inv; *(LAS f32x4*)(PS + fr * 132 + 16 * nt + 4 * q) = s[nt]; }
        f32x4 oc[4];
#pragma unroll
        for (int dt = 0; dt < 4; ++dt) oc[dt] = (f32x4){0.f, 0.f, 0.f, 0.f};
#pragma unroll
        for (int k2 = 0; k2 < 4; ++k2) { v4u pf; pf.x = pk2(s[2 * k2][0], s[2 * k2][1]); pf.y = pk2(s[2 * k2][2], s[2 * k2][3]); pf.z = pk2(s[2 * k2 + 1][0], s[2 * k2 + 1][1]); pf.w = pk2(s[2 * k2 + 1][2], s[2 * k2 + 1][3]);
#pragma unroll
            for (int dt = 0; dt < 4; ++dt) { const v2u va = *(const LAS v2u*)(VT + (16 * dt + fr) * 136 + 32 * k2 + 4 * q), vb = *(const LAS v2u*)(VT + (16 * dt + fr) * 136 + 32 * k2 + 16 + 4 * q);
                v4u vf; vf.x = va.x; vf.y = va.y; vf.z = vb.x; vf.w = vb.y; oc[dt] = mfma16(vf, pf, oc[dt]); } }
        const float gg = g ? g0[1] : g0[0];
#pragma unroll
        for (int dt = 0; dt < 4; ++dt) { const f32x4 v = oc[dt] * gg; if (g) facc[1][dt] = v; else facc[0][dt] = v; }
        LDS_WAIT();
        const int tt2 = lane >> 4, jl = lane & 15, t2 = t0 + 8 * wave + 4 * g + tt2, cur = t2 >> 6;
        float key[2];
#pragma unroll
        for (int x = 0; x < 2; ++x) { const int j = jl + 16 * x; float im = 0.f;
#pragma unroll
            for (int i = 0; i < 5; ++i) { const int c = 4 * j - 1 + i;
                if (c >= 0 && c <= 126) { im += PS[(4 * tt2 + 0) * 132 + c]; im += PS[(4 * tt2 + 1) * 132 + c]; im += PS[(4 * tt2 + 2) * 132 + c]; im += PS[(4 * tt2 + 3) * 132 + c]; } }
            const bool valid = j <= cur, forced = (j == 0) | (j == cur) | (j == cur - 1);
            key[x] = valid ? (forced ? im + 1e4f : im) : -1e30f; IMP[tt2 * 32 + j] = key[x]; }
        LDS_WAIT();
        int rk0 = 0, rk1 = 0;
        f32x4 kq[8];
#pragma unroll
        for (int i = 0; i < 8; ++i) kq[i] = *(const LAS f32x4*)(IMP + tt2 * 32 + 4 * i);
#pragma unroll
        for (int j2 = 0; j2 < 32; ++j2) { const float k2 = kq[j2 >> 2][j2 & 3];
            rk0 += ((k2 > key[0]) || (k2 == key[0] && j2 < jl)) ? 1 : 0; rk1 += ((k2 > key[1]) || (k2 == key[1] && j2 < jl + 16)) ? 1 : 0; }
        const bool sel0 = (jl <= cur) && rk0 < 8, sel1 = (jl + 16 <= cur) && rk1 < 8;
        const unsigned long long bal0 = __ballot(sel0), bal1 = __ballot(sel1);
        const unsigned mk = (unsigned)((bal0 >> (16 * tt)) & 0xffffull) | ((unsigned)((bal1 >> (16 * tt)) & 0xffffull) << 16);
        unsigned wa = 0;
#pragma unroll
        for (int x = 0; x < 4; ++x) wa |= (unsigned)((bal0 >> (16 * x)) & 0xffffull) | ((unsigned)((bal1 >> (16 * x)) & 0xffffull) << 16);
        if (g) { msk[1] = mk; wny[1] = wa; } else { msk[0] = mk; wny[0] = wa; }
        LDS_WAIT();
    }
    if (lane == 0) WANY[wave] = wny[0] | wny[1];
    *(LAS v4u*)(TB + skey * 72 + 8 * spc) = kr; *(LAS v4u*)(TB + 4608 + skey * 72 + 8 * spc) = vr;
    __syncthreads();
    unsigned uni = 0;
#pragma unroll
    for (int w = 0; w < 8; ++w) uni |= WANY[w];
    int cph = 0, cj = 0, nph = 0, nj = 0, tb = 0;
#define ATT_ADV(ph, j) do { if (ph == 0) { const unsigned rem = uni & ~((2u << j) - 1u); if (rem) j = __builtin_ctz(rem); else { ph = 1; j = wlo; } } else if (++j > curb) ph = 2; } while (0)
    ATT_ADV(nph, nj);
    float m_run[2] = {-1e4f, -1e4f}; f32x4 o5[2], o[2][4];
#pragma unroll
    for (int g = 0; g < 2; ++g) { o5[g] = (f32x4){0.f, 0.f, 0.f, 0.f};
#pragma unroll
        for (int dt = 0; dt < 4; ++dt) o[g][dt] = (f32x4){0.f, 0.f, 0.f, 0.f}; }
    while (cph != 2) {
        if (nph != 2) { kr = *(const v4u*)KADDR(nj, nph ? ZC_KW : ZC_KS); vr = *(const v4u*)((nph ? VTW : VTS) + vbase + 64 * nj); }
        { const LAS bf16* Kb = TB + tb * 9216; const LAS bf16* Vb = Kb + 4608; const int kb = 64 * cj;
            const bool need[2] = { cph ? true : (bool)((wny[0] >> cj) & 1u), cph ? true : (bool)((wny[1] >> cj) & 1u) };
            if (need[0] || need[1]) { const float rb[2] = { (cph || ((msk[0] >> cj) & 1u)) ? 0.f : -1e30f, (cph || ((msk[1] >> cj) & 1u)) ? 0.f : -1e30f };
                const int tA = tq[0], tB = tq[1], wl = cph ? 512 : (1 << 30);
                attn_tile2(Kb, Vb, qf, fr, q, m_run, o5, o, need, rb, (cj == curb) || (cph && cj <= wlo),
                           [=](int g, int kk) { const int kp = kb + kk, tg = g ? tB : tA; return (kp <= tg) && (kp > tg - wl); }); } }
        if (nph != 2) { LAS bf16* Kn = TB + (tb ^ 1) * 9216; *(LAS v4u*)(Kn + skey * 72 + 8 * spc) = kr; *(LAS v4u*)(Kn + 4608 + skey * 72 + 8 * spc) = vr; }
        if (cph == 0 && nph == 1) {
#pragma unroll
            for (int g = 0; g < 2; ++g) { const float lt = __shfl(o5[g][0], fr); const float sc = g1[g] / lt;
#pragma unroll
                for (int dt = 0; dt < 4; ++dt) { facc[g][dt] = facc[g][dt] + o[g][dt] * sc; o[g][dt] = (f32x4){0.f, 0.f, 0.f, 0.f}; }
                m_run[g] = -1e4f; o5[g] = (f32x4){0.f, 0.f, 0.f, 0.f}; } }
        __syncthreads();
        cph = nph; cj = nj; tb ^= 1; ATT_ADV(nph, nj);
    }
#undef ATT_ADV
#pragma unroll
    for (int g = 0; g < 2; ++g) { const float lt = __shfl(o5[g][0], fr); const float sc = g2[g] / lt;
#pragma unroll
        for (int dt = 0; dt < 4; ++dt) { const f32x4 v = facc[g][dt] + o[g][dt] * sc; v2u w; w.x = pk2(v.x, v.y); w.y = pk2(v.z, v.w);
            *(v2u*)(MIX + grow[g] * DM + 512 + 64 * hh + 16 * dt + 4 * q) = w; } }
}
#undef KADDR
#undef Z
#undef MIX
#undef VTS
#undef VTW
#undef KC
#undef VCT

#define XB_TMO      128
#define XB_XCNT(j)  (256  + 64 * (j))
#define XB_XSUB(j)  (1280 + 64 * (j))
#define XB_XGEN(j)  (2304 + 64 * (j))
#define XB_TOP      3328
#define XB_TOPGEN   3392
#define XCD_BAR_WORDS 3456
#define XB_SPIN_CAP (1u << 18)

__device__ __forceinline__ unsigned xb_ld(unsigned* p)              { return __hip_atomic_load(p, __ATOMIC_RELAXED, __HIP_MEMORY_SCOPE_AGENT); }
__device__ __forceinline__ unsigned xb_add(unsigned* p, unsigned v) { return __hip_atomic_fetch_add(p, v, __ATOMIC_RELAXED, __HIP_MEMORY_SCOPE_AGENT); }
__device__ __forceinline__ unsigned xb_xcc_id() { return (unsigned)__builtin_amdgcn_s_getreg((3 << 11) | 20) & 0xFu; }
#define XB_SPIN(cond, bar) do { unsigned _sp = 0; while (cond) { __builtin_amdgcn_s_sleep(1); \
    if ((++_sp & 255u) == 0u) { if (xb_ld(&(bar)[XB_TMO])) break; if (_sp > XB_SPIN_CAP) { atomicAdd(&(bar)[XB_TMO], 1u); break; } } } } while (0)

struct XcdBarrier {
    unsigned* bar; unsigned x;
    volatile LAS unsigned* st;
};

__device__ __forceinline__ XcdBarrier xcd_barrier_post(unsigned* bar, volatile LAS unsigned* st) {
    XcdBarrier b; b.bar = bar; b.x = xb_xcc_id(); b.st = st;
    if (threadIdx.x == 0) (void)xb_add(&bar[XB_XCNT(b.x)], 1u);
    return b;
}
__device__ __forceinline__ void xcd_barrier_complete(unsigned* bar, unsigned x, unsigned& nloc, unsigned& nx) {
    const unsigned G = gridDim.x * gridDim.y * gridDim.z;
    unsigned sum, cnt, mine, sp = 0u;
    for (;;) {
        sum = 0u; cnt = 0u; mine = 0u;
#pragma unroll
        for (unsigned j = 0; j < 16; ++j) { const unsigned c = xb_ld(&bar[XB_XCNT(j)]); sum += c; cnt += (c > 0u) ? 1u : 0u; mine = (j == x) ? c : mine; }
        if (sum == G) break;
        __builtin_amdgcn_s_sleep(1);
        if ((++sp & 255u) == 0u) { if (xb_ld(&bar[XB_TMO])) break; if (sp > XB_SPIN_CAP) { atomicAdd(&bar[XB_TMO], 1u); break; } }
    }
    nloc = mine > 0u ? mine : 1u; nx = cnt > 0u ? cnt : 1u;
}

__device__ __forceinline__ void xcd_barrier(const XcdBarrier& b) {
    asm volatile("s_waitcnt vmcnt(0)" ::: "memory");
    __syncthreads();
    if (threadIdx.x == 0) {
        unsigned* bar = b.bar;
        __builtin_amdgcn_s_waitcnt(0);
        unsigned nloc = b.st[0], nx = b.st[1];
        if (nloc == 0u) { xcd_barrier_complete(bar, b.x, nloc, nx); b.st[0] = nloc; b.st[1] = nx; }
        const unsigned old = xb_add(&bar[XB_XSUB(b.x)], 1u);
        const unsigned gen = old / nloc;
        if (old + 1u == (gen + 1u) * nloc) {
            __builtin_amdgcn_fence(__ATOMIC_RELEASE, "agent");
            asm volatile("s_waitcnt vmcnt(0)" ::: "memory");
            const unsigned og = xb_add(&bar[XB_TOP], 1u);
            const unsigned tg = og / nx;
            if (og + 1u == (tg + 1u) * nx) xb_add(&bar[XB_TOPGEN], 1u);
            else XB_SPIN(xb_ld(&bar[XB_TOPGEN]) == tg, bar);
            __builtin_amdgcn_fence(__ATOMIC_ACQUIRE, "agent");
            xb_add(&bar[XB_XGEN(b.x)], 1u);
            asm volatile("s_waitcnt vmcnt(0)" ::: "memory");
        } else {
            XB_SPIN(xb_ld(&bar[XB_XGEN(b.x)]) == gen, bar);
            __builtin_amdgcn_fence(__ATOMIC_ACQUIRE, "agent");
            asm volatile("s_waitcnt vmcnt(0)" ::: "memory");
        }
    }
    __syncthreads();
}

#ifndef POSTBAR_SLEEP
#define POSTBAR_SLEEP do {} while (0)
#endif
#ifndef MIXD_NEW
#define MIXD_NEW 1
#endif
#ifndef MIXB_LNNEW
#define MIXB_LNNEW 1
#endif
#ifndef ATDRY
#define ATDRY 0
#endif
#ifndef ITREP
#define ITREP 0
#endif
#ifndef REPMASK
#define REPMASK 0
#endif
#ifndef PHSEL
#define PHSEL 0xfff
#endif
constexpr int N_PHASES = 1 + 8 * DEPTH;
__global__ void __launch_bounds__(NTHREADS) hybrid_fwd(Args KA) {
    extern __shared__ __attribute__((aligned(16))) unsigned char lds_raw[];
    LAS unsigned char* lds = (LAS unsigned char*)lds_raw;
    cg::grid_group grid = cg::this_grid();
    volatile LAS unsigned* MISC = (volatile LAS unsigned*)(lds + LDS_BYTES - 64);
    if (threadIdx.x < 16) MISC[threadIdx.x] = 0u;
    __syncthreads();
    const XcdBarrier bar = xcd_barrier_post((unsigned*)(KA.ws + WS_CTL), MISC);
#define SEAM(first) do { if (first) { __threadfence(); asm volatile("s_waitcnt vmcnt(0)" ::: "memory"); grid.sync(); __builtin_amdgcn_fence(__ATOMIC_ACQUIRE, "agent"); asm volatile("s_waitcnt vmcnt(0)" ::: "memory"); __syncthreads(); } else { xcd_barrier(bar); POSTBAR_SLEEP; } } while (0)
#if REPMASK
    for (int ph2 = 2 * KA.ph_lo; ph2 < 2 * KA.ph_hi; ++ph2) {
        const int ph = ph2 >> 1;
        if (ph2 & 1) { const int stx = (ph == 0) ? 8 : ((ph - 1) & 7); if (!(((REPMASK & ~0x90) >> stx) & 1) && !((REPMASK >> 9) & 1)) continue; }
        if (ph2 > 2 * KA.ph_lo) SEAM(ph2 == 2 * KA.ph_lo + 2);
        if (ph2 & 1) { const int stx = (ph == 0) ? 8 : ((ph - 1) & 7); if (!(((REPMASK & ~0x90) >> stx) & 1)) continue; }
#else
    for (int ph = KA.ph_lo; ph < KA.ph_hi; ++ph) {
        if (ph > KA.ph_lo) SEAM(ph == KA.ph_lo + 1);
#endif
        ArgP A = (ArgP)__builtin_amdgcn_kernarg_segment_ptr(); asm volatile("" : "+s"(A));
        int tid = threadIdx.x; asm volatile("" : "+v"(tid));
        int G = gridDim.x, bid = blockIdx.x; asm volatile("" : "+s"(G), "+s"(bid));
        const int ngw = G * NWAVES;
        const int lane = tid & 63, wave = __builtin_amdgcn_readfirstlane(tid >> 6), gw = bid * NWAVES + wave;
        unsigned char* ws = A->ws;
        bf16* H = (bf16*)(ws + WS_H); bf16* Zb = (bf16*)(ws + WS_Z); bf16* MIX = (bf16*)(ws + WS_MIX); bf16* HID = (bf16*)(ws + WS_HID); bf16* Y = (bf16*)(ws + WS_Y); float* R2 = (float*)(ws + WS_R2);
        if (ph == 0) {
#if PHSEL & 1
            LAS float* scr = (LAS float*)(lds + wave * 16384);
            for (int it = gw; it < DEPTH * TI_LAYER; it += ngw) prologue_item(A, it, scr, lane);
            for (int idx = bid * NTHREADS + tid; idx < DEPTH * 65536; idx += G * NTHREADS) { const int l = idx >> 16, rem = idx & 65535, tq = (rem >> 7) & 127, sq = rem & 127;
                ((bf16*)(ws + WS_W + (size_t)l * WS_WL + WO_SG))[rem] = (sq <= tq) ? (bf16)f2bf(A->in[I_SGW][idx]) : (bf16)0; }
            norm_first(A->in[I_X], H, R2, bid, G, wave, lane);
#endif
            continue;
        }
        const int l = (ph - 1) >> 3, st = (ph - 1) & 7;
        unsigned char* wl = ws + WS_W + (size_t)l * WS_WL;
        if (st == 0) {
#if PHSEL & 2
            pg8::Gemm g{H, (const bf16*)(wl + WO_IN), MROWS, ZC, DM}; pg8::StaticOrder S; S.init(MROWS, ZC, G, bid);
            pg8::EpiBf16RS E{Zb, 256, R2 + (size_t)(2 * l) * MROWS, ZT};
            pg8::gemm_phase<pg8::EpiBf16RS, pg8::StaticOrder, PG8_ALIGN, PG8_SP2>(lds, g, S, E);
#endif
        } else if (st == 1) {
#if PHSEL & 4
            for (int it0 = bid; it0 < 1536 + (ITREP ? 512 : 0); it0 += G) {
                int it = it0; int tid_i = tid; ArgP A_i = A; asm volatile("" : "+v"(tid_i), "+s"(A_i));
                const int lane_i = tid_i & 63, wave_i = __builtin_amdgcn_readfirstlane(tid_i >> 6);
                if (it0 >= 1536) { const int e = it0 - 1536; if (ITREP == 1) { if (e >= 256) continue; it = e; } else if (ITREP == 2) it = 256 + e; else if (ITREP == 4) it = 768 + e; else { if (e >= 256) continue; it = 1280 + e; } }
                if (it < 256) {
#if PHSEL & 256
                    mixer_a(A_i, l, it, lds, tid_i, wave_i, lane_i);
#endif
                } else if (it < 768) {
#if PHSEL & 512
                    mixer_b(A_i, l, it - 256, lds, tid_i, wave_i, lane_i);
#endif
                } else if (it < 1280) {
#if PHSEL & 1024
                    mixer_d(A_i, l, it - 768, lds, tid_i, wave_i, lane_i);
#endif
                } else {
#if PHSEL & 2048
                    nsa_compress(A_i, l, it - 1280, lds, tid_i, wave_i, lane_i);
#endif
                }
            }
#endif
        } else if (st == 2) {
#if PHSEL & 8
            for (int it = bid; it < 512; it += G) { int tid_i = tid; ArgP A_i = A; asm volatile("" : "+v"(tid_i), "+s"(A_i));
                nsa_attn(A_i, l, it, lds, tid_i, __builtin_amdgcn_readfirstlane(tid_i >> 6), tid_i & 63); }
#endif
        } else if (st == 3 || st == 6) {
#if PHSEL & 16
            pg8::Gemm g{st == 3 ? MIX : HID, (const bf16*)(wl + (st == 3 ? WO_OUT : WO_DN)), MROWS, DM, st == 3 ? DM : FFH}; pg8::StaticOrder S; S.init(MROWS, DM, G, bid);
            pg8::EpiBf16<0> E{Y, DM, nullptr, 0, 0, 1.f};
            pg8::gemm_phase<pg8::EpiBf16<0>, pg8::StaticOrder, PG8_ALIGN, PG8_SP2>(lds, g, S, E);
#endif
        } else if (st == 4) {
#if PHSEL & 32
#if (REPMASK >> 4) & 1
            norm_bf<false>(H, HID, Y, A->in[I_GQM] + l * DM, (float*)(ws + WS_MIX), nullptr, bid, G, wave, lane);
#endif
            norm_bf<false>(H, H, Y, A->in[I_GQM] + l * DM, R2 + (size_t)(2 * l + 1) * MROWS, nullptr, bid, G, wave, lane);
#endif
        } else if (st == 5) {
#if PHSEL & 64
            pg8::Gemm g{H, (const bf16*)(wl + WO_GU), MROWS, 2 * FFH, DM}; pg8::StaticOrder S; S.init(MROWS, 2 * FFH, G, bid);
            pg8::EpiSwiGLU E{HID, FFH, R2 + (size_t)(2 * l + 1) * MROWS};
            pg8::gemm_phase<pg8::EpiSwiGLU, pg8::StaticOrder, PG8_ALIGN, PG8_SP2>(lds, g, S, E);
#endif
        } else {
#if PHSEL & 128
            const bool last = (l == DEPTH - 1);
#if (REPMASK >> 7) & 1
            norm_bf<false>(H, HID, Y, A->in[I_GQF] + l * DM, (float*)(ws + WS_MIX), nullptr, bid, G, wave, lane);
#endif
            if (last) norm_bf<true>(H, H, Y, A->in[I_GQF] + l * DM, nullptr, A->out, bid, G, wave, lane);
            else norm_bf<false>(H, H, Y, A->in[I_GQF] + l * DM, R2 + (size_t)(2 * l + 2) * MROWS, nullptr, bid, G, wave, lane);
#endif
        }
    }
}

#ifndef MK_MULTI
#define MK_MULTI 0
#endif
extern "C" void kernel_launch(void* const* d_in, const int* in_sizes, int n_in, void* d_out, int out_size, void* d_ws, size_t ws_size, hipStream_t stream) {
    static int grid = 0;
    if (grid == 0) {
        if (n_in != 26 || out_size != MROWS * DM || ws_size < WS_END) { fprintf(stderr, "kernel_launch: unexpected shapes (n_in %d out %d ws %zu)\n", n_in, out_size, ws_size); grid = -1; return; }
        int dev = 0, cus = 0, per_cu = 0;
        hipGetDevice(&dev); hipDeviceGetAttribute(&cus, hipDeviceAttributeMultiprocessorCount, dev);
        hipFuncSetAttribute((const void*)hybrid_fwd, hipFuncAttributeMaxDynamicSharedMemorySize, LDS_BYTES);
        hipOccupancyMaxActiveBlocksPerMultiprocessor(&per_cu, (const void*)hybrid_fwd, NTHREADS, LDS_BYTES);
        if (per_cu < 1) per_cu = 1;
        grid = cus * per_cu;
        (void)hipGetLastError();
    }
    if (grid < 0) return;
    Args a{};
    for (int i = 0; i < 26; ++i) a.in[i] = (const float*)d_in[i];
    a.out = (float*)d_out; a.ws = (unsigned char*)d_ws;
    if (hipMemsetAsync((char*)d_ws + WS_CTL, 0, CTL_BYTES, stream) != hipSuccess) { fprintf(stderr, "kernel_launch: memset of the barrier words failed\n"); return; }
#if MK_MULTI
    for (int ph = 0; ph < N_PHASES; ++ph) { a.ph_lo = ph; a.ph_hi = ph + 1; hipLaunchKernelGGL(hybrid_fwd, dim3(grid), dim3(NTHREADS), LDS_BYTES, stream, a); }
#else
    a.ph_lo = 0; a.ph_hi = N_PHASES;
    void* args[] = {&a};
    hipError_t e = hipLaunchCooperativeKernel((const void*)hybrid_fwd, dim3(grid), dim3(NTHREADS), args, LDS_BYTES, stream);
    if (e != hipSuccess) fprintf(stderr, "cooperative launch failed: %s (grid %d)\n", hipGetErrorString(e), grid);
#endif
}
```

```cpp
#include <hip/hip_runtime.h>
#include <hip/hip_cooperative_groups.h>
#include <cstdio>
#include <cstdint>
namespace cg = cooperative_groups;
namespace pg8 {
#define PG8_LAS __attribute__((address_space(3)))
typedef unsigned short bf16_t;
typedef short bf16x8 __attribute__((ext_vector_type(8)));
typedef float f32x4 __attribute__((ext_vector_type(4)));
typedef unsigned u32x4 __attribute__((ext_vector_type(4)));
constexpr int BM = 256, BK = 64, HALF = 128, HTB = HALF * BK * 2  , STAGE_BYTES = 8 * HTB, NXCD = 8, WGM = 8;

__host__ __device__ __forceinline__ int lds_byte(int r, int c) { const int st = (r >> 4) * 2 + (c >> 5), rr = r & 15, cc = c & 31, ob = rr * 64 + cc * 2; return st * 1024 + (ob ^ (((ob >> 9) & 1) << 5)); }
__host__ __device__ __forceinline__ void stage_rc(int b, int& R, int& C) { const int st = b / 1024, sb = b % 1024, swz = sb ^ (((sb >> 9) & 1) << 5); R = (st >> 1) * 16 + swz / 64; C = (st & 1) * 32 + (swz % 64) / 2; }
__host__ __device__ __forceinline__ int perm32(int rho) { const int n = rho >> 4, i = rho & 15; return 8 * (i >> 2) + 4 * n + (i & 3); }

struct Unit { int pm, pn; };
struct Gemm { const bf16_t* A; const bf16_t* Bt; int M, N, K; };

struct StaticOrder {
    int nM, nN, nwg, G, c;
    __host__ __device__ void init(int M, int N, int G_, int c_) { nM = M / BM; nN = N / BM; nwg = nM * nN; G = G_; c = c_; }
    __host__ __device__ bool next(int i, Unit& u) const {
        const long L = (long)i * G + c; if (L >= nwg) return false;
        int wgid = (int)L; { const int q = nwg / NXCD, r = nwg % NXCD, xcd = wgid % NXCD, off = wgid / NXCD; wgid = (xcd < r ? xcd * (q + 1) : r * (q + 1) + (xcd - r) * q) + off; }
        const int nig = WGM * nN, gid = wgid / nig, fm = gid * WGM, gsz = (nM - fm) < WGM ? (nM - fm) : WGM;
        u.pm = fm + ((wgid % nig) % gsz); u.pn = (wgid % nig) / gsz; return true;
    }
    __device__ __forceinline__ void a_ready(const Unit&) const {}
    __device__ __forceinline__ void done(const Unit&) const {}
};

__device__ __forceinline__ unsigned cvt_pk_bf16(float lo, float hi) { unsigned r; asm volatile("v_cvt_pk_bf16_f32 %0, %1, %2" : "=v"(r) : "v"(lo), "v"(hi)); return r; }
typedef float f32x2 __attribute__((ext_vector_type(2)));
__device__ __forceinline__ f32x2 gelu_pk(f32x2 v) {
    const f32x2 av = __builtin_elementwise_abs(v), d = av * 0.2316418882f + 1.0f;
    f32x2 t; t.x = __builtin_amdgcn_rcpf(d.x); t.y = __builtin_amdgcn_rcpf(d.y);
    f32x2 q = t * 0.5307027145f + (-0.7265760135f); q = q * t + 0.7107068705f; q = q * t + (-0.142248368f); q = q * t + 0.127414796f; q = q * t;
    const f32x2 s = (v * v) * (-0.72134752044f);
    f32x2 e; e.x = __builtin_amdgcn_exp2f(s.x); e.y = __builtin_amdgcn_exp2f(s.y);
    const f32x2 m = v * (q * e), r = v - m;
    f32x2 o; o.x = v.x < 0.f ? m.x : r.x; o.y = v.y < 0.f ? m.y : r.y; return o;
}

template <int ACT  > struct EpiBf16 {
    static constexpr bool PERM = true, AFTER_DRAIN = false; static_assert(ACT == 0 || ACT == 1, "EpiBf16: ACT is 0 (none) or 1 (gelu_pk)");
    bf16_t* O; int ldc; const float* bias; int split_cols; size_t split_stride; float scale0;
    __device__ __forceinline__ void operator()(const f32x4 (&acc)[2][2][4][2], const Unit& u, int wr, int wc, int fr, int fq) const {
        const int row0 = u.pm * BM + wr * 64 + fr; int colt = u.pn * BM; bf16_t* base = O;
        float sc = 1.f; if (split_cols) { const int t = colt / split_cols; base += (size_t)t * split_stride; colt -= t * split_cols; if (t == 0) sc = scale0; }
        const int col0 = colt + wc * 32 + 8 * fq, bcol0 = u.pn * BM + wc * 32 + 8 * fq;
        f32x4 bv[2][2];
#pragma unroll
        for (int bj = 0; bj < 2; ++bj)
#pragma unroll
            for (int n = 0; n < 2; ++n) bv[bj][n] = bias ? *(const f32x4*)(bias + bcol0 + bj * HALF + 4 * n) : (f32x4){0.f, 0.f, 0.f, 0.f};
#pragma unroll
        for (int ai = 0; ai < 2; ++ai)
#pragma unroll
            for (int m = 0; m < 4; ++m) { bf16_t* rowp = base + (size_t)(row0 + ai * HALF + m * 16) * ldc + col0;
#pragma unroll
                for (int bj = 0; bj < 2; ++bj) { f32x4 v0 = acc[ai][bj][m][0] + bv[bj][0], v1 = acc[ai][bj][m][1] + bv[bj][1];
                    if (ACT == 1) { f32x2 a = gelu_pk((f32x2){v0[0], v0[1]}), b = gelu_pk((f32x2){v0[2], v0[3]}), c = gelu_pk((f32x2){v1[0], v1[1]}), d = gelu_pk((f32x2){v1[2], v1[3]});
                        v0 = (f32x4){a.x, a.y, b.x, b.y}; v1 = (f32x4){c.x, c.y, d.x, d.y}; }
                    v0 = v0 * sc; v1 = v1 * sc; u32x4 w; w.x = cvt_pk_bf16(v0[0], v0[1]); w.y = cvt_pk_bf16(v0[2], v0[3]); w.z = cvt_pk_bf16(v1[0], v1[1]); w.w = cvt_pk_bf16(v1[2], v1[3]);
                    *(u32x4*)(rowp + bj * HALF) = w; } }
    }
};
struct EpiF32 {
    static constexpr bool PERM = false, AFTER_DRAIN = false;
    float* O; int ldc;
    __device__ __forceinline__ void operator()(const f32x4 (&acc)[2][2][4][2], const Unit& u, int wr, int wc, int fr, int fq) const {
        const int row0 = u.pm * BM + wr * 64 + fr, col0 = u.pn * BM + wc * 32 + 4 * fq;
#pragma unroll
        for (int ai = 0; ai < 2; ++ai)
#pragma unroll
            for (int m = 0; m < 4; ++m) { float* rowp = O + (size_t)(row0 + ai * HALF + m * 16) * ldc + col0;
#pragma unroll
                for (int bj = 0; bj < 2; ++bj)
#pragma unroll
                    for (int n = 0; n < 2; ++n) *(f32x4*)(rowp + bj * HALF + n * 16) = acc[ai][bj][m][n]; }
    }
};
struct EpiSwiGLU {
    static constexpr bool PERM = true, AFTER_DRAIN = false;
    bf16_t* O; int ldc; const float* rs;
    __device__ __forceinline__ void operator()(const f32x4 (&acc)[2][2][4][2], const Unit& u, int wr, int wc, int fr, int fq) const {
        const int row0 = u.pm * BM + wr * 64 + fr, col0 = u.pn * HALF + wc * 32 + 8 * fq;
#pragma unroll
        for (int ai = 0; ai < 2; ++ai)
#pragma unroll
            for (int m = 0; m < 4; ++m) { bf16_t* rowp = O + (size_t)(row0 + ai * HALF + m * 16) * ldc + col0;
                const float r = rs[row0 + ai * HALF + m * 16];
                float h[8];
#pragma unroll
                for (int n = 0; n < 2; ++n)
#pragma unroll
                    for (int e = 0; e < 4; ++e) { const float g = acc[ai][0][m][n][e] * r, up = acc[ai][1][m][n][e] * r;
                        h[n * 4 + e] = g * __builtin_amdgcn_rcpf(1.0f + __builtin_amdgcn_exp2f(-1.4426950408889634f * g)) * up; }
                u32x4 w; w.x = cvt_pk_bf16(h[0], h[1]); w.y = cvt_pk_bf16(h[2], h[3]); w.z = cvt_pk_bf16(h[4], h[5]); w.w = cvt_pk_bf16(h[6], h[7]);
                *(u32x4*)rowp = w; }
    }
};
struct EpiBf16RS {
    static constexpr bool PERM = true, AFTER_DRAIN = false;
    bf16_t* O; int ldc; const float* rs; size_t ts;
    __device__ __forceinline__ void operator()(const f32x4 (&acc)[2][2][4][2], const Unit& u, int wr, int wc, int fr, int fq) const {
        const int row0 = u.pm * BM + wr * 64 + fr, col0 = wc * 32 + 8 * fq;
#pragma unroll
        for (int ai = 0; ai < 2; ++ai)
#pragma unroll
            for (int m = 0; m < 4; ++m) { bf16_t* rowp = O + (size_t)u.pn * ts + (size_t)(row0 + ai * HALF + m * 16) * ldc + col0; const float r = rs[row0 + ai * HALF + m * 16];
#pragma unroll
                for (int bj = 0; bj < 2; ++bj) { const f32x4 v0 = acc[ai][bj][m][0] * r, v1 = acc[ai][bj][m][1] * r;
                    u32x4 w; w.x = cvt_pk_bf16(v0[0], v0[1]); w.y = cvt_pk_bf16(v0[2], v0[3]); w.z = cvt_pk_bf16(v1[0], v1[1]); w.w = cvt_pk_bf16(v1[2], v1[3]);
                    *(u32x4*)(rowp + bj * HALF) = w; } }
    }
};
template <class Epi, class Sched, bool ALIGN_EPI = false, bool SP2 = false>
__device__ __forceinline__ void gemm_phase(PG8_LAS unsigned char* lds, const Gemm g, const Sched& S, const Epi& E) {
    int tid_l = threadIdx.x; asm volatile("" : "+v"(tid_l));
    const int tid = tid_l, wid = __builtin_amdgcn_readfirstlane(tid >> 6), lane = tid & 63, wr = wid >> 2, wc = wid & 3, fr = lane & 15, fq = lane >> 4;
    const int K = g.K, nt = K / BK;
    unsigned voffA[2], voffB[2];
#pragma unroll
    for (int i = 0; i < 2; ++i) { int R, C; stage_rc(tid * 16 + i * 8192, R, C); const int Rb = Epi::PERM ? ((R & ~31) + perm32(R & 31)) : R;
        voffA[i] = (unsigned)(R * K + C) * 2u; voffB[i] = (unsigned)(Rb * K + C) * 2u; }
    const size_t kstep = (size_t)(BK * 2);
    const size_t hstep = (size_t)HALF * K * 2;
    const size_t tstep = 2 * hstep;
    const unsigned ldsw = (unsigned)wid * 1024u;
    const int aoff = lds_byte(wr * 64 + fr, fq * 8), boff = lds_byte(wc * 32 + fr, fq * 8);
#define PG8_SA(b, h) (((b) * 2 + (h)) * HTB)
#define PG8_SB(b, h) ((4 + (b) * 2 + (h)) * HTB)
#define PG8_STAGE(bufoff, gbase, voff) do { _Pragma("unroll") for (int _i = 0; _i < 2; ++_i) \
        __builtin_amdgcn_global_load_lds((const unsigned*)((const char*)(gbase) + (voff)[_i]), (PG8_LAS unsigned*)(lds + (bufoff) + ldsw + _i * 8192), 16, 0, 0); } while (0)
#define PG8_LDA(dst, b, h) do { _Pragma("unroll") for (int m = 0; m < 4; ++m) _Pragma("unroll") for (int k = 0; k < 2; ++k) dst[m][k] = *(const PG8_LAS bf16x8*)(lds + PG8_SA(b, h) + aoff + m * 2048 + k * 1024); } while (0)
#define PG8_LDB(dst, b, h) do { _Pragma("unroll") for (int n = 0; n < 2; ++n) _Pragma("unroll") for (int k = 0; k < 2; ++k) dst[n][k] = *(const PG8_LAS bf16x8*)(lds + PG8_SB(b, h) + boff + n * 2048 + k * 1024); } while (0)
#define PG8_MMA(ai, bj, At, Bt) do { __builtin_amdgcn_s_setprio(1); _Pragma("unroll") for (int m = 0; m < 4; ++m) _Pragma("unroll") for (int n = 0; n < 2; ++n) _Pragma("unroll") for (int k = 0; k < 2; ++k) \
        acc[ai][bj][m][n] = __builtin_amdgcn_mfma_f32_16x16x32_bf16(Bt[n][k], At[m][k], acc[ai][bj][m][n], 0, 0, 0); __builtin_amdgcn_s_setprio(0); } while (0)
#define PG8_WAIT_V(n) asm volatile("s_waitcnt vmcnt(" #n ")" ::: "memory")
#define PG8_WAIT_L(n) asm volatile("s_waitcnt lgkmcnt(" #n ")" ::: "memory")
#define PG8_BAR __builtin_amdgcn_s_barrier()
#define PG8_SCHED __builtin_amdgcn_sched_barrier(0)
    Unit cur, nxt; int ui = 0;
    if (!S.next(0, cur)) return;
    f32x4 acc[2][2][4][2];
#pragma unroll
    for (int a = 0; a < 2; ++a)
#pragma unroll
        for (int b = 0; b < 2; ++b)
#pragma unroll
            for (int m = 0; m < 4; ++m)
#pragma unroll
                for (int n = 0; n < 2; ++n) acc[a][b][m][n] = (f32x4){0.f, 0.f, 0.f, 0.f};
    bf16x8 At[4][2], B0[2][2], B1[2][2];
    const char* cA = (const char*)g.A + (size_t)cur.pm * tstep; const char* cB = (const char*)g.Bt + (size_t)cur.pn * tstep;
    S.a_ready(cur);
    if constexpr (SP2) {
        PG8_STAGE(PG8_SB(0, 0), cB, voffB); PG8_STAGE(PG8_SB(0, 1), cB + hstep, voffB); PG8_STAGE(PG8_SA(0, 0), cA, voffA); PG8_STAGE(PG8_SA(0, 1), cA + hstep, voffA);
        if (wr == 1) PG8_BAR;
        PG8_WAIT_V(2); PG8_BAR;
        PG8_STAGE(PG8_SB(1, 0), cB + kstep, voffB); PG8_STAGE(PG8_SA(1, 0), cA + kstep, voffA); PG8_STAGE(PG8_SB(1, 1), cB + hstep + kstep, voffB);
        PG8_WAIT_V(6); PG8_BAR;
    } else {
        PG8_STAGE(PG8_SB(0, 0), cB, voffB); PG8_STAGE(PG8_SA(0, 0), cA, voffA); PG8_STAGE(PG8_SB(0, 1), cB + hstep, voffB); PG8_STAGE(PG8_SA(0, 1), cA + hstep, voffA);
        if (wr == 1) PG8_BAR;
        PG8_WAIT_V(4); PG8_BAR;
        PG8_STAGE(PG8_SB(1, 0), cB + kstep, voffB); PG8_STAGE(PG8_SA(1, 0), cA + kstep, voffA); PG8_STAGE(PG8_SB(1, 1), cB + hstep + kstep, voffB);
        PG8_WAIT_V(6); PG8_BAR;
    }
    for (;;) {
        const bool has_next = S.next(ui + 1, nxt);
        const char* nA = has_next ? (const char*)g.A + (size_t)nxt.pm * tstep : cA; const char* nB = has_next ? (const char*)g.Bt + (size_t)nxt.pn * tstep : cB;
        for (int t = 0; t < nt; t += 2) {
            const bool last = (t == nt - 2);
            const char* a1 = cA + (size_t)(t + 1) * kstep;
            const char* a2 = last ? nA : cA + (size_t)(t + 2) * kstep; const char* b2 = last ? nB : cB + (size_t)(t + 2) * kstep;
            const char* a3 = a2 + kstep; const char* b3 = b2 + kstep;
            if (last && has_next) S.a_ready(nxt);
            if constexpr (SP2) {
            PG8_LDB(B0, 0, 0); PG8_LDB(B1, 0, 1); PG8_SCHED; PG8_LDA(At, 0, 0); PG8_STAGE(PG8_SA(1, 1), a1 + hstep, voffA);
            PG8_WAIT_V(8); PG8_WAIT_L(0); PG8_BAR; PG8_MMA(0, 0, At, B0); PG8_MMA(0, 1, At, B1); PG8_BAR; PG8_SCHED;
            PG8_LDA(At, 0, 1); PG8_STAGE(PG8_SB(0, 0), b2, voffB); PG8_STAGE(PG8_SB(0, 1), b2 + hstep, voffB); PG8_STAGE(PG8_SA(0, 0), a2, voffA);
            PG8_WAIT_V(8); PG8_WAIT_L(0); PG8_BAR; PG8_MMA(1, 0, At, B0); PG8_MMA(1, 1, At, B1); PG8_BAR; PG8_SCHED;
            PG8_LDB(B0, 1, 0); PG8_LDB(B1, 1, 1); PG8_SCHED; PG8_LDA(At, 1, 0); PG8_STAGE(PG8_SA(0, 1), a2 + hstep, voffA);
            PG8_WAIT_V(8); PG8_WAIT_L(0); PG8_BAR; PG8_MMA(0, 0, At, B0); PG8_MMA(0, 1, At, B1); PG8_BAR; PG8_SCHED;
            PG8_LDA(At, 1, 1); PG8_STAGE(PG8_SB(1, 0), b3, voffB); PG8_STAGE(PG8_SB(1, 1), b3 + hstep, voffB); PG8_STAGE(PG8_SA(1, 0), a3, voffA);
            PG8_WAIT_V(8); PG8_WAIT_L(0); PG8_BAR; PG8_MMA(1, 0, At, B0); PG8_MMA(1, 1, At, B1); PG8_BAR; PG8_SCHED;
            } else {
            PG8_LDB(B0, 0, 0); PG8_SCHED; PG8_LDA(At, 0, 0); PG8_STAGE(PG8_SA(1, 1), a1 + hstep, voffA);
            PG8_WAIT_L(8); PG8_BAR; PG8_WAIT_L(0); PG8_MMA(0, 0, At, B0); PG8_BAR; PG8_SCHED;
            PG8_LDB(B1, 0, 1); PG8_STAGE(PG8_SB(0, 0), b2, voffB);
            PG8_BAR; PG8_WAIT_L(0); PG8_MMA(0, 1, At, B1); PG8_BAR;
            PG8_LDA(At, 0, 1); PG8_STAGE(PG8_SA(0, 0), a2, voffA);
            PG8_BAR; PG8_WAIT_L(0); PG8_MMA(1, 0, At, B0); PG8_BAR; PG8_SCHED;
            PG8_STAGE(PG8_SB(0, 1), b2 + hstep, voffB);
            PG8_WAIT_V(6); PG8_BAR; PG8_MMA(1, 1, At, B1); PG8_BAR;
            PG8_LDB(B0, 1, 0); PG8_SCHED; PG8_LDA(At, 1, 0); PG8_STAGE(PG8_SA(0, 1), a2 + hstep, voffA);
            PG8_WAIT_L(8); PG8_BAR; PG8_WAIT_L(0); PG8_MMA(0, 0, At, B0); PG8_BAR; PG8_SCHED;
            PG8_LDB(B1, 1, 1); PG8_STAGE(PG8_SB(1, 0), b3, voffB);
            PG8_BAR; PG8_WAIT_L(0); PG8_MMA(0, 1, At, B1); PG8_BAR;
            PG8_LDA(At, 1, 1); PG8_STAGE(PG8_SA(1, 0), a3, voffA);
            PG8_BAR; PG8_WAIT_L(0); PG8_MMA(1, 0, At, B0); PG8_BAR; PG8_SCHED;
            PG8_STAGE(PG8_SB(1, 1), b3 + hstep, voffB);
            PG8_WAIT_V(6); PG8_BAR; PG8_MMA(1, 1, At, B1); PG8_BAR;
            }
        }
        if constexpr (ALIGN_EPI) { if (wr == 0) PG8_BAR; }
        if constexpr (!Epi::AFTER_DRAIN) { E(acc, cur, wr, wc, fr, fq); S.done(cur); }
        if (!has_next) break;
#pragma unroll
        for (int a = 0; a < 2; ++a)
#pragma unroll
            for (int b = 0; b < 2; ++b)
#pragma unroll
                for (int m = 0; m < 4; ++m)
#pragma unroll
                    for (int n = 0; n < 2; ++n) acc[a][b][m][n] = (f32x4){0.f, 0.f, 0.f, 0.f};
        cur = nxt; cA = nA; cB = nB; ++ui;
        if constexpr (ALIGN_EPI) { if (wr == 1) PG8_BAR; }
    }
    PG8_WAIT_V(0);
    if constexpr (!ALIGN_EPI) { if (wr == 0) PG8_BAR; }
    PG8_BAR;
    if constexpr (Epi::AFTER_DRAIN) { E.fused(acc, cur, wr, wc, fr, fq, lds, wid, lane); S.done(cur); }
#undef PG8_SA
#undef PG8_SB
#undef PG8_STAGE
#undef PG8_LDA
#undef PG8_LDB
#undef PG8_MMA
#undef PG8_WAIT_V
#undef PG8_WAIT_L
#undef PG8_BAR
#undef PG8_SCHED
}
}

#ifndef PG8_SP2
#define PG8_SP2 true
#endif
#ifndef PG8_ALIGN
#define PG8_ALIGN true
#endif

#define LAS __attribute__((address_space(3)))
typedef unsigned short bf16;
typedef unsigned v4u __attribute__((ext_vector_type(4)));
typedef unsigned v2u __attribute__((ext_vector_type(2)));
typedef float f32x4 __attribute__((ext_vector_type(4)));
typedef short bf16x8 __attribute__((ext_vector_type(8)));

constexpr int DM = 1024, NBATCH = 16, SEQ = 2048, DEPTH = 4, MROWS = NBATCH * SEQ, INC = 1932, ZC = 2048, FFH = 2816;
constexpr int NTHREADS = 512, NWAVES = 8;
constexpr int LDS_BYTES = 147456;
constexpr int ZC_AU = 0, ZC_AV = 256, ZC_BA = 512, ZC_BG = 768, ZC_Q = 1024, ZC_KC = 1280, ZC_VC = 1344, ZC_KS = 1408, ZC_VS = 1472, ZC_KW = 1536, ZC_VW = 1600, ZC_G = 1664, ZC_D = 1792;
constexpr size_t ZT = (size_t)NBATCH * SEQ * 256;
#define ZP(Zb, row, col) ((Zb) + (size_t)((col) >> 8) * ZT + (size_t)(row) * 256 + ((col) & 255))
constexpr size_t MiB = 1u << 20;
constexpr size_t WS_CTL = 0, CTL_BYTES = 16384;
constexpr size_t WS_W = 1 * MiB, WS_WL = 24 * MiB;
constexpr size_t WO_IN = 0, WO_OUT = 4 * MiB, WO_GU = 6 * MiB, WO_DN = 17 * MiB, WO_SG = 23 * MiB - 512 * 1024, WO_PW = WO_SG + 131072, WO_POOL = WO_PW + 131072, WO_W1K = WO_POOL + 32768, WO_W1V = WO_W1K + 262144;
static_assert(WO_DN + (size_t)1024 * 2816 * 2 <= WO_SG && WO_W1V + 262144 <= WS_WL, "weight map");
constexpr size_t WS_H = 98 * MiB, WS_Z = 162 * MiB, WS_MIX = 290 * MiB, WS_HID = 162 * MiB, WS_Y = 354 * MiB;
constexpr size_t WS_VTS = 482 * MiB, WS_VTW = 486 * MiB, WS_KC = 490 * MiB, WS_VCT = 490 * MiB + 262144, WS_R2 = 491 * MiB, WS_END = 493 * MiB;
static_assert(WS_HID + (size_t)MROWS * FFH * 2 <= WS_Y, "hid overlay");

#define LDS_WAIT() asm volatile("s_waitcnt lgkmcnt(0)" ::: "memory")
__device__ __forceinline__ float bflo(unsigned w) { return __uint_as_float(w << 16); }
__device__ __forceinline__ float bfhi(unsigned w) { return __uint_as_float(w & 0xffff0000u); }
__device__ __forceinline__ float bf2f(bf16 v) { return __uint_as_float((unsigned)v << 16); }
__device__ __forceinline__ unsigned f2bf(float f) { unsigned u = __float_as_uint(f); return (u + 0x7fffu + ((u >> 16) & 1u)) >> 16; }
__device__ __forceinline__ unsigned pk2(float lo, float hi) { unsigned r; asm("v_cvt_pk_bf16_f32 %0, %1, %2" : "=v"(r) : "v"(lo), "v"(hi)); return r; }
__device__ __forceinline__ float sigmoidf_(float x) { return __builtin_amdgcn_rcpf(1.0f + __builtin_amdgcn_exp2f(-1.4426950408889634f * x)); }
__device__ __forceinline__ float siluf_(float x) { return x * sigmoidf_(x); }
__device__ __forceinline__ float wave_sum(float v) {
#pragma unroll
    for (int o = 1; o < 64; o <<= 1) v += __shfl_xor(v, o);
    return v;
}
__device__ __forceinline__ f32x4 mfma16(v4u a, v4u b, f32x4 c) {
    return __builtin_amdgcn_mfma_f32_16x16x32_bf16(__builtin_bit_cast(bf16x8, a), __builtin_bit_cast(bf16x8, b), c, 0, 0, 0);
}

struct Args { const float* in[26]; float* out; unsigned char* ws; int ph_lo, ph_hi; };
typedef const __attribute__((address_space(4))) Args* ArgP;
enum { I_X = 0, I_GPM, I_GQM, I_GPF, I_GQF, I_WIN, I_SGLN, I_SGW, I_SGB, I_CVW, I_CVB, I_CVLG, I_CVLB, I_CVPW, I_CVPB, I_POSK, I_POSV, I_W1K, I_W2K, I_W1V, I_W2V, I_POOLW, I_POOLS, I_WOUT, I_GU, I_DN };

__device__ __forceinline__ void tr_item(const float* __restrict__ src, int Nsrc, int K, bf16* dst, int k0, int n0d, int nsrc0, int nvalid, LAS float* scr, int lane, const float* gk = nullptr) {
    const int kk8 = lane >> 3, n4 = (lane & 7) * 4; const bool ok = n4 < nvalid;
#pragma unroll
    for (int i = 0; i < 8; ++i) { const int kk = 8 * i + kk8; f32x4 v = (f32x4){0.f, 0.f, 0.f, 0.f};
        if (ok) { v = *(const f32x4*)(src + (size_t)(k0 + kk) * Nsrc + nsrc0 + n4); if (gk) v = v * gk[k0 + kk]; }
        LAS float* sp = scr + kk * 33 + n4; sp[0] = v.x; sp[1] = v.y; sp[2] = v.z; sp[3] = v.w; }
    LDS_WAIT();
    const int c = lane & 7;
#pragma unroll
    for (int j = 0; j < 4; ++j) { const int n = (lane >> 3) + 8 * j; const LAS float* s = scr + (8 * c) * 33 + n;
        v4u o; o.x = pk2(s[0 * 33], s[1 * 33]); o.y = pk2(s[2 * 33], s[3 * 33]); o.z = pk2(s[4 * 33], s[5 * 33]); o.w = pk2(s[6 * 33], s[7 * 33]);
        *(v4u*)(dst + (size_t)(n0d + n) * K + k0 + 8 * c) = o; }
    LDS_WAIT();
}
constexpr int TI_IN = 1024, TI_OUT = 512, TI_GU = 2816, TI_DN = 1408, TI_PW = 32, TI_POOL = 8, TI_W1 = 64;
constexpr int TI_LAYER = TI_IN + TI_OUT + TI_GU + TI_DN + TI_PW + TI_POOL + 2 * TI_W1;

__device__ __forceinline__ void prologue_item(ArgP A, int it, LAS float* scr, int lane) {
    const int l = it / TI_LAYER; int r = it % TI_LAYER;
    unsigned char* wl = A->ws + WS_W + (size_t)l * WS_WL;
    if (r < TI_IN) { const int kb = r >> 6, nb = r & 63, n0d = 32 * nb; int ns = n0d, nv = 32;
        if (n0d >= ZC_D) ns = 1676 + (n0d - ZC_D); else if (n0d == ZC_G) { ns = 1664; nv = 12; } else if (n0d > ZC_G) { ns = 0; nv = 0; }
        tr_item(A->in[I_WIN] + (size_t)l * DM * INC, INC, DM, (bf16*)(wl + WO_IN), 64 * kb, n0d, ns, nv, scr, lane, A->in[I_GPM] + l * DM); return; }
    r -= TI_IN;
    if (r < TI_OUT) { const int kb = r >> 5, nb = r & 31;
        tr_item(A->in[I_WOUT] + (size_t)l * DM * DM, DM, DM, (bf16*)(wl + WO_OUT), 64 * kb, 32 * nb, 32 * nb, 32, scr, lane); return; }
    r -= TI_OUT;
    if (r < TI_GU) { const int kb = r / 176, nb = r % 176, n0d = 32 * nb, pn = n0d >> 8, bj = (n0d >> 7) & 1, i0 = n0d & 127;
        tr_item(A->in[I_GU] + (size_t)l * DM * 2 * FFH, 2 * FFH, DM, (bf16*)(wl + WO_GU), 64 * kb, n0d, bj * FFH + 128 * pn + i0, 32, scr, lane, A->in[I_GPF] + l * DM); return; }
    r -= TI_GU;
    if (r < TI_DN) { const int kb = r >> 5, nb = r & 31;
        tr_item(A->in[I_DN] + (size_t)l * FFH * DM, DM, FFH, (bf16*)(wl + WO_DN), 64 * kb, 32 * nb, 32 * nb, 32, scr, lane); return; }
    r -= TI_DN;
    if (r < TI_PW) { const int kb = r >> 3, nb = r & 7;
        tr_item(A->in[I_CVPW] + (size_t)l * 65536, 256, 256, (bf16*)(wl + WO_PW), 64 * kb, 32 * nb, 32 * nb, 32, scr, lane); return; }
    r -= TI_PW;
    if (r < TI_POOL) { const int g = r >> 1, nb = r & 1;
        tr_item(A->in[I_POOLW] + (size_t)l * 16384 + g * 4096, 64, 64, (bf16*)(wl + WO_POOL) + g * 4096, 0, 32 * nb, 32 * nb, 32, scr, lane); return; }
    r -= TI_POOL;
    if (r < TI_W1) { const int kb = r >> 1, nb = r & 1;
        tr_item(A->in[I_W1K] + (size_t)l * 131072, 64, 2048, (bf16*)(wl + WO_W1K), 64 * kb, 32 * nb, 32 * nb, 32, scr, lane); return; }
    r -= TI_W1;
    { const int kb = r >> 1, nb = r & 1;
        tr_item(A->in[I_W1V] + (size_t)l * 131072, 64, 2048, (bf16*)(wl + WO_W1V), 64 * kb, 32 * nb, 32 * nb, 32, scr, lane); }
}

struct NRow { f32x4 x[4], y[4]; };
template <bool HASY>
__device__ __forceinline__ void nr_load(NRow& r, const float* xin, const float* y, int m, int lane) {
    const f32x4* xr = (const f32x4*)(xin + (size_t)m * DM) + lane;
#pragma unroll
    for (int j = 0; j < 4; ++j) r.x[j] = xr[64 * j];
    if (HASY) { const f32x4* yr = (const f32x4*)(y + (size_t)m * DM) + lane;
#pragma unroll
        for (int j = 0; j < 4; ++j) r.y[j] = yr[64 * j]; }
}
template <bool HASY, bool HASH>
__device__ __forceinline__ void nr_proc(NRow& r, const float* g1, float* xout, const float* g2, bf16* Hout, int m, int lane) {
    if (HASY) { float ss = 0.f;
#pragma unroll
        for (int j = 0; j < 4; ++j) ss += (r.y[j].x * r.y[j].x + r.y[j].y * r.y[j].y) + (r.y[j].z * r.y[j].z + r.y[j].w * r.y[j].w);
        const float rr = 1.0f / sqrtf(wave_sum(ss) * (1.0f / DM) + 1e-6f);
        f32x4* xo = (f32x4*)(xout + (size_t)m * DM) + lane;
#pragma unroll
        for (int j = 0; j < 4; ++j) { const f32x4 g = ((const f32x4*)g1)[lane + 64 * j]; r.x[j] = r.x[j] + (r.y[j] * rr) * g; xo[64 * j] = r.x[j]; } }
    if (HASH) { float ss = 0.f;
#pragma unroll
        for (int j = 0; j < 4; ++j) ss += (r.x[j].x * r.x[j].x + r.x[j].y * r.x[j].y) + (r.x[j].z * r.x[j].z + r.x[j].w * r.x[j].w);
        const float rr = 1.0f / sqrtf(wave_sum(ss) * (1.0f / DM) + 1e-6f);
        v2u* ho = (v2u*)(Hout + (size_t)m * DM) + lane;
#pragma unroll
        for (int j = 0; j < 4; ++j) { const f32x4 g = ((const f32x4*)g2)[lane + 64 * j]; const f32x4 o = (r.x[j] * rr) * g; v2u w; w.x = pk2(o.x, o.y); w.y = pk2(o.z, o.w); ho[64 * j] = w; } }
}
template <bool HASY, bool HASH>
__device__ __forceinline__ void norm_rows(const float* xin, const float* y, const float* g1, float* xout, const float* g2, bf16* Hout, int gw, int ngw, int lane) {
    if ((MROWS % (2 * ngw)) == 0) {
        for (int m = gw; m < MROWS; m += 2 * ngw) {
            NRow ra, rb;
            nr_load<HASY>(ra, xin, y, m, lane); nr_load<HASY>(rb, xin, y, m + ngw, lane);
            nr_proc<HASY, HASH>(ra, g1, xout, g2, Hout, m, lane); nr_proc<HASY, HASH>(rb, g1, xout, g2, Hout, m + ngw, lane);
        }
    } else {
        for (int m = gw; m < MROWS; m += ngw) { NRow ra; nr_load<HASY>(ra, xin, y, m, lane); nr_proc<HASY, HASH>(ra, g1, xout, g2, Hout, m, lane); }
    }
}

__device__ __forceinline__ void norm_first(const float* xin, bf16* XB, float* R2, int bid, int G, int wave, int lane) {
    for (int c = bid; c < MROWS / 32; c += G)
        for (int i = 0; i < 4; ++i) { const int m = 32 * c + wave + 8 * i;
            const f32x4* xr = (const f32x4*)(xin + (size_t)m * DM) + lane; f32x4 xv[4]; float ss = 0.f;
#pragma unroll
            for (int j = 0; j < 4; ++j) { xv[j] = xr[64 * j]; ss += (xv[j].x * xv[j].x + xv[j].y * xv[j].y) + (xv[j].z * xv[j].z + xv[j].w * xv[j].w); }
            const float r = 1.0f / sqrtf(wave_sum(ss) * (1.0f / DM) + 1e-6f);
            if (lane == 0) R2[m] = r;
            v2u* ho = (v2u*)(XB + (size_t)m * DM) + lane;
#pragma unroll
            for (int j = 0; j < 4; ++j) { v2u w; w.x = pk2(xv[j].x, xv[j].y); w.y = pk2(xv[j].z, xv[j].w); ho[64 * j] = w; }
        }
}
template <bool LAST, int NR>
__device__ __forceinline__ void norm_bf_rows(const bf16* XB, bf16* XO, const bf16* Yb, const f32x4 (&g)[2][2], float* R2, float* out, int m0, int ngw, int lane) {
    v4u xw[NR][2], yw[NR][2];
#pragma unroll
    for (int r = 0; r < NR; ++r)
#pragma unroll
        for (int j = 0; j < 2; ++j) { const size_t o = (size_t)(m0 + r * ngw) * DM + 8 * lane + 512 * j; xw[r][j] = *(const v4u*)(XB + o); yw[r][j] = *(const v4u*)(Yb + o); }
#pragma unroll
    for (int r = 0; r < NR; ++r) { const int m = m0 + r * ngw;
        float xv[2][8], yv[2][8]; float ss = 0.f;
#pragma unroll
        for (int j = 0; j < 2; ++j) {
            xv[j][0] = bflo(xw[r][j].x); xv[j][1] = bfhi(xw[r][j].x); xv[j][2] = bflo(xw[r][j].y); xv[j][3] = bfhi(xw[r][j].y); xv[j][4] = bflo(xw[r][j].z); xv[j][5] = bfhi(xw[r][j].z); xv[j][6] = bflo(xw[r][j].w); xv[j][7] = bfhi(xw[r][j].w);
            yv[j][0] = bflo(yw[r][j].x); yv[j][1] = bfhi(yw[r][j].x); yv[j][2] = bflo(yw[r][j].y); yv[j][3] = bfhi(yw[r][j].y); yv[j][4] = bflo(yw[r][j].z); yv[j][5] = bfhi(yw[r][j].z); yv[j][6] = bflo(yw[r][j].w); yv[j][7] = bfhi(yw[r][j].w);
#pragma unroll
            for (int e = 0; e < 8; ++e) ss += yv[j][e] * yv[j][e]; }
        const float rr = 1.0f / sqrtf(wave_sum(ss) * (1.0f / DM) + 1e-6f);
        float s2 = 0.f;
#pragma unroll
        for (int j = 0; j < 2; ++j)
#pragma unroll
            for (int e = 0; e < 8; ++e) { xv[j][e] = xv[j][e] + (yv[j][e] * rr) * g[j][e >> 2][e & 3]; s2 += xv[j][e] * xv[j][e]; }
        if (LAST) {
#pragma unroll
            for (int j = 0; j < 2; ++j) { f32x4* op = (f32x4*)(out + (size_t)m * DM + 8 * lane + 512 * j); op[0] = (f32x4){xv[j][0], xv[j][1], xv[j][2], xv[j][3]}; op[1] = (f32x4){xv[j][4], xv[j][5], xv[j][6], xv[j][7]}; }
        } else {
            const float r2 = 1.0f / sqrtf(wave_sum(s2) * (1.0f / DM) + 1e-6f);
            if (lane == 0) R2[m] = r2;
#pragma unroll
            for (int j = 0; j < 2; ++j) { v4u w; w.x = pk2(xv[j][0], xv[j][1]); w.y = pk2(xv[j][2], xv[j][3]); w.z = pk2(xv[j][4], xv[j][5]); w.w = pk2(xv[j][6], xv[j][7]);
                *(v4u*)(XO + (size_t)m * DM + 8 * lane + 512 * j) = w; }
        }
    }
}
template <bool LAST>
__device__ __forceinline__ void norm_bf(const bf16* XB, bf16* XO, const bf16* Yb, const float* g1, float* R2, float* out, int bid, int G, int wave, int lane) {
    f32x4 g[2][2];
#pragma unroll
    for (int j = 0; j < 2; ++j) { g[j][0] = *(const f32x4*)(g1 + 8 * lane + 512 * j); g[j][1] = *(const f32x4*)(g1 + 8 * lane + 512 * j + 4); }
    for (int c = bid; c < MROWS / 32; c += G) norm_bf_rows<LAST, 4>(XB, XO, Yb, g, R2, out, 32 * c + wave, 8, lane);
}

__device__ __forceinline__ void mixer_a(ArgP A, int l, int item, LAS unsigned char* lds, int tid, int wave, int lane) {
    const bf16* Z = (const bf16*)(A->ws + WS_Z); bf16* MIX = (bf16*)(A->ws + WS_MIX);
    const bf16* sgw = (const bf16*)(A->ws + WS_W + (size_t)l * WS_WL + WO_SG);
    const int b = item >> 4, ch = item & 15; const size_t r0 = (size_t)b * SEQ + 128 * ch;
    LAS bf16* VT = (LAS bf16*)lds;
    LAS float* ST = (LAS float*)(lds + 69632);
    { const int s = tid >> 2, qd = tid & 3; float sm = 0.f, sq = 0.f;
#pragma unroll
        for (int i = 0; i < 8; ++i) { const v4u w = *(const v4u*)ZP(Z, r0 + s, ZC_AV + 64 * qd + 8 * i);
            const float a0 = bflo(w.x), a1 = bfhi(w.x), a2 = bflo(w.y), a3 = bfhi(w.y), a4 = bflo(w.z), a5 = bfhi(w.z), a6 = bflo(w.w), a7 = bfhi(w.w);
            sm += ((a0 + a1) + (a2 + a3)) + ((a4 + a5) + (a6 + a7)); sq += ((a0 * a0 + a1 * a1) + (a2 * a2 + a3 * a3)) + ((a4 * a4 + a5 * a5) + (a6 * a6 + a7 * a7)); }
        sm += __shfl_xor(sm, 1); sq += __shfl_xor(sq, 1); sm += __shfl_xor(sm, 2); sq += __shfl_xor(sq, 2);
        const float mu = sm * (1.0f / 256.0f), var = fmaxf(sq * (1.0f / 256.0f) - mu * mu, 0.f);
        if (qd == 0) { ST[2 * s] = mu; ST[2 * s + 1] = 1.0f / sqrtf(var + 1e-5f); } }
    __syncthreads();
    { const int s = tid & 127, og = tid >> 7; const float mu = ST[2 * s], rs = ST[2 * s + 1];
        const float* gp = A->in[I_SGLN] + l * 256;
#pragma unroll
        for (int i = 0; i < 8; ++i) { const int oct = og + 4 * i;
            const v4u w = *(const v4u*)ZP(Z, r0 + s, ZC_AV + 8 * oct);
            const f32x4 g0 = *(const f32x4*)(gp + 8 * oct), g1 = *(const f32x4*)(gp + 8 * oct + 4);
            LAS bf16* vp = VT + (8 * oct) * 136 + s;
            vp[0 * 136] = (bf16)f2bf((bflo(w.x) - mu) * rs * g0.x); vp[1 * 136] = (bf16)f2bf((bfhi(w.x) - mu) * rs * g0.y);
            vp[2 * 136] = (bf16)f2bf((bflo(w.y) - mu) * rs * g0.z); vp[3 * 136] = (bf16)f2bf((bfhi(w.y) - mu) * rs * g0.w);
            vp[4 * 136] = (bf16)f2bf((bflo(w.z) - mu) * rs * g1.x); vp[5 * 136] = (bf16)f2bf((bfhi(w.z) - mu) * rs * g1.y);
            vp[6 * 136] = (bf16)f2bf((bflo(w.w) - mu) * rs * g1.z); vp[7 * 136] = (bf16)f2bf((bfhi(w.w) - mu) * rs * g1.w); } }
    __syncthreads();
    const int h = wave >> 1, th = wave & 1, fr = lane & 15, q = lane >> 4;
    f32x4 acc[4][4];
#pragma unroll
    for (int a = 0; a < 4; ++a)
#pragma unroll
        for (int c = 0; c < 4; ++c) acc[a][c] = (f32x4){0.f, 0.f, 0.f, 0.f};
    const bf16* Wb = sgw + (size_t)h * 128 * 128;
    v2u uwv[4][4]; float sgbv[4];
#pragma unroll
    for (int mt = 0; mt < 4; ++mt) { const int t = 64 * th + 16 * mt + fr; sgbv[mt] = A->in[I_SGB][l * 512 + h * 128 + t];
#pragma unroll
        for (int nt = 0; nt < 4; ++nt) uwv[mt][nt] = *(const v2u*)ZP(Z, r0 + t, ZC_AU + 64 * h + 16 * nt + 4 * q); }
#pragma unroll
    for (int ks = 0; ks < 4; ++ks) {
        v4u vf[4];
#pragma unroll
        for (int nt = 0; nt < 4; ++nt) vf[nt] = *(const LAS v4u*)(VT + (64 * h + 16 * nt + fr) * 136 + 32 * ks + 8 * q);
#pragma unroll
        for (int mt = 0; mt < 4; ++mt) { const int t = 64 * th + 16 * mt + fr; const v4u wf = *(const v4u*)(Wb + t * 128 + 32 * ks + 8 * q);
#pragma unroll
            for (int nt = 0; nt < 4; ++nt) acc[mt][nt] = mfma16(vf[nt], wf, acc[mt][nt]); }
    }
#pragma unroll
    for (int mt = 0; mt < 4; ++mt) { const int t = 64 * th + 16 * mt + fr; const float bias = sgbv[mt];
#pragma unroll
        for (int nt = 0; nt < 4; ++nt) { const int d0 = 64 * h + 16 * nt + 4 * q;
            const v2u uw = uwv[mt][nt]; const f32x4 a = acc[mt][nt];
            v2u o; o.x = pk2(bflo(uw.x) * (a.x + bias), bfhi(uw.x) * (a.y + bias)); o.y = pk2(bflo(uw.y) * (a.z + bias), bfhi(uw.y) * (a.w + bias));
            *(v2u*)(MIX + (r0 + t) * DM + d0) = o; } }
    __syncthreads();
}

__device__ __forceinline__ void mixer_b(ArgP A, int l, int item, LAS unsigned char* lds, int tid, int wave, int lane) {
    const bf16* Z = (const bf16*)(A->ws + WS_Z); bf16* MIX = (bf16*)(A->ws + WS_MIX);
    const bf16* pwt = (const bf16*)(A->ws + WS_W + (size_t)l * WS_WL + WO_PW);
    const int b = item >> 5, tau = item & 31, t0 = 64 * tau; const size_t r0 = (size_t)b * SEQ + t0;
    LAS bf16* Ht = (LAS bf16*)lds;
    LAS float* CO = (LAS float*)(lds + 49152);
    LAS bf16* AT = (LAS bf16*)lds;
    float wt[31];
#pragma unroll
    for (int w = 0; w < 31; ++w) wt[w] = A->in[I_CVW][(size_t)l * 31 * 256 + w * 256 + (tid & 255)];
    const float bias = A->in[I_CVB][l * 256 + (tid & 255)];
    {
        v4u av[6], gv[6];
#pragma unroll
        for (int it_ = 0; it_ < 6; ++it_) { int idx = tid + it_ * NTHREADS; idx = idx < 94 * 32 ? idx : 94 * 32 - 1; const int i = idx >> 5, oct = idx & 31, t = t0 - 30 + i;
            const size_t zr = (size_t)b * SEQ + (t > 0 ? t : 0); av[it_] = *(const v4u*)ZP(Z, zr, ZC_BA + 8 * oct); gv[it_] = *(const v4u*)ZP(Z, zr, ZC_BG + 8 * oct); }
#pragma unroll
        for (int it_ = 0; it_ < 6; ++it_) { const int idx = tid + it_ * NTHREADS; if (idx < 94 * 32) { const int i = idx >> 5, oct = idx & 31, t = t0 - 30 + i; v4u o = (v4u){0u, 0u, 0u, 0u};
                if (t >= 0) { const v4u a = av[it_], g = gv[it_];
                    o.x = pk2(bflo(a.x) * sigmoidf_(bflo(g.x)), bfhi(a.x) * sigmoidf_(bfhi(g.x))); o.y = pk2(bflo(a.y) * sigmoidf_(bflo(g.y)), bfhi(a.y) * sigmoidf_(bfhi(g.y)));
                    o.z = pk2(bflo(a.z) * sigmoidf_(bflo(g.z)), bfhi(a.z) * sigmoidf_(bfhi(g.z))); o.w = pk2(bflo(a.w) * sigmoidf_(bflo(g.w)), bfhi(a.w) * sigmoidf_(bfhi(g.w))); }
                *(LAS v4u*)(Ht + i * 256 + 8 * oct) = o; } }
    }
    __syncthreads();
    { const int c = tid & 255, half = tid >> 8;
#pragma unroll 1
        for (int tg = 0; tg < 4; ++tg) { const int tb = 32 * half + 8 * tg; float ac[8];
#pragma unroll
            for (int j = 0; j < 8; ++j) ac[j] = bias;
#pragma unroll
            for (int i = 0; i < 38; ++i) { const float hv = bf2f(Ht[(tb + i) * 256 + c]);
#pragma unroll
                for (int j = 0; j < 8; ++j) if (i - j >= 0 && i - j < 31) ac[j] += hv * wt[i - j]; }
#pragma unroll
            for (int j = 0; j < 8; ++j) CO[(tb + j) * 256 + c] = ac[j]; } }
    __syncthreads();
    v4u bpf[8][2];
#pragma unroll
    for (int ks = 0; ks < 8; ++ks)
#pragma unroll
        for (int nt = 0; nt < 2; ++nt) bpf[ks][nt] = *(const v4u*)(pwt + (32 * wave + 16 * nt + (lane & 15)) * 256 + 32 * ks + 8 * (lane >> 4));
    { const f32x4 g = *(const f32x4*)(A->in[I_CVLG] + l * 256 + 4 * lane), bb = *(const f32x4*)(A->in[I_CVLB] + l * 256 + 4 * lane);
#if MIXB_LNNEW
        f32x4 v[8]; float sm[8];
#pragma unroll
        for (int i = 0; i < 8; ++i) { v[i] = *(const LAS f32x4*)(CO + (8 * wave + i) * 256 + 4 * lane); sm[i] = (v[i].x + v[i].y) + (v[i].z + v[i].w); }
#pragma unroll
        for (int o = 1; o < 64; o <<= 1)
#pragma unroll
            for (int i = 0; i < 8; ++i) sm[i] += __shfl_xor(sm[i], o);
#pragma unroll
        for (int i = 0; i < 8; ++i) { v[i] = v[i] - sm[i] * (1.0f / 256.0f); sm[i] = (v[i].x * v[i].x + v[i].y * v[i].y) + (v[i].z * v[i].z + v[i].w * v[i].w); }
#pragma unroll
        for (int o = 1; o < 64; o <<= 1)
#pragma unroll
            for (int i = 0; i < 8; ++i) sm[i] += __shfl_xor(sm[i], o);
#pragma unroll
        for (int i = 0; i < 8; ++i) { const float rs = 1.0f / sqrtf(sm[i] * (1.0f / 256.0f) + 1e-5f);
            const f32x4 y = (v[i] * rs) * g + bb; v2u o; o.x = pk2(siluf_(y.x), siluf_(y.y)); o.y = pk2(siluf_(y.z), siluf_(y.w));
            *(LAS v2u*)(AT + (8 * wave + i) * 264 + 4 * lane) = o; } }
#else
        for (int i = 0; i < 8; ++i) { const int t = 8 * wave + i; const f32x4 v = *(const LAS f32x4*)(CO + t * 256 + 4 * lane);
            const float mu = wave_sum((v.x + v.y) + (v.z + v.w)) * (1.0f / 256.0f); const f32x4 d = v - mu;
            const float var = wave_sum((d.x * d.x + d.y * d.y) + (d.z * d.z + d.w * d.w)) * (1.0f / 256.0f); const float rs = 1.0f / sqrtf(var + 1e-5f);
            const f32x4 y = (d * rs) * g + bb; v2u o; o.x = pk2(siluf_(y.x), siluf_(y.y)); o.y = pk2(siluf_(y.z), siluf_(y.w));
            *(LAS v2u*)(AT + t * 264 + 4 * lane) = o; } }
#endif
    __syncthreads();
    const int fr = lane & 15, q = lane >> 4;
    f32x4 acc[4][2];
#pragma unroll
    for (int a = 0; a < 4; ++a)
#pragma unroll
        for (int c = 0; c < 2; ++c) acc[a][c] = (f32x4){0.f, 0.f, 0.f, 0.f};
#pragma unroll
    for (int ks = 0; ks < 8; ++ks) {
#pragma unroll
        for (int mt = 0; mt < 4; ++mt) { const v4u af = *(const LAS v4u*)(AT + (16 * mt + fr) * 264 + 32 * ks + 8 * q);
#pragma unroll
            for (int nt = 0; nt < 2; ++nt) acc[mt][nt] = mfma16(bpf[ks][nt], af, acc[mt][nt]); } }
#pragma unroll
    for (int mt = 0; mt < 4; ++mt)
#pragma unroll
        for (int nt = 0; nt < 2; ++nt) { const int n0 = 32 * wave + 16 * nt + 4 * q; const f32x4 pb = *(const f32x4*)(A->in[I_CVPB] + l * 256 + n0); const f32x4 o = acc[mt][nt] + pb;
            v2u w; w.x = pk2(o.x, o.y); w.y = pk2(o.z, o.w); *(v2u*)(MIX + (r0 + 16 * mt + fr) * DM + 256 + n0) = w; }
    __syncthreads();
}

template <int W>
__device__ __forceinline__ void pool_means(const LAS bf16* Xt, LAS bf16* AT, int c, int half, int t0) {
    float xv[47];
#pragma unroll
    for (int i = 0; i < 47; ++i) xv[i] = (i >= 16 - W) ? bf2f(Xt[(32 * half + i) * 256 + c]) : 0.f;
    float s = 0.f;
#pragma unroll
    for (int i = 0; i < W; ++i) s += xv[15 - i];
#pragma unroll
    for (int j = 0; j < 32; ++j) { const int jj = 32 * half + j, t = t0 + jj;
        if (j > 0) s += xv[15 + j] - xv[15 + j - W];
        const int cnt = (t + 1 < W) ? (t + 1) : W;
        AT[jj * 264 + c] = (bf16)f2bf(s / (float)cnt - xv[15 + j]); }
}

__device__ __forceinline__ void mixer_d(ArgP A, int l, int item, LAS unsigned char* lds, int tid, int wave, int lane) {
    const bf16* Z = (const bf16*)(A->ws + WS_Z); bf16* MIX = (bf16*)(A->ws + WS_MIX);
    const bf16* poolt = (const bf16*)(A->ws + WS_W + (size_t)l * WS_WL + WO_POOL);
    bf16* VTS = (bf16*)(A->ws + WS_VTS); bf16* VTW = (bf16*)(A->ws + WS_VTW);
    const int b = item >> 5, tau = item & 31, t0 = 64 * tau; const size_t r0 = (size_t)b * SEQ + t0;
    LAS bf16* Xt = (LAS bf16*)lds;
    LAS bf16* AT = (LAS bf16*)(lds + 40960);
    LAS bf16* TS = (LAS bf16*)(lds + 75776);
    v4u pbf[2][2];
#pragma unroll
    for (int ks = 0; ks < 2; ++ks)
#pragma unroll
        for (int nt = 0; nt < 2; ++nt) pbf[ks][nt] = *(const v4u*)(poolt + (wave >> 1) * 4096 + (32 * (wave & 1) + 16 * nt + (lane & 15)) * 64 + 32 * ks + 8 * (lane >> 4));
    {
        v4u xv[5];
#pragma unroll
        for (int it_ = 0; it_ < 5; ++it_) { int idx = tid + it_ * NTHREADS; idx = idx < 79 * 32 ? idx : 79 * 32 - 1; const int i = idx >> 5, oct = idx & 31, t = t0 - 15 + i;
            xv[it_] = *(const v4u*)ZP(Z, (size_t)b * SEQ + (t > 0 ? t : 0), ZC_D + 8 * oct); }
#pragma unroll
        for (int it_ = 0; it_ < 5; ++it_) { const int idx = tid + it_ * NTHREADS; if (idx < 79 * 32) { const int i = idx >> 5, oct = idx & 31, t = t0 - 15 + i;
                *(LAS v4u*)(Xt + i * 256 + 8 * oct) = (t >= 0) ? xv[it_] : (v4u){0u, 0u, 0u, 0u}; } }
    }
    { const int tok = tid & 63, oct = tid >> 6;
        const v4u a = *(const v4u*)ZP(Z, r0 + tok, ZC_VS + 8 * oct), c = *(const v4u*)ZP(Z, r0 + tok, ZC_VW + 8 * oct);
        LAS bf16* p0 = TS + (8 * oct) * 72 + tok; LAS bf16* p1 = p0 + 4608;
        p0[0] = (bf16)(a.x & 0xffffu); p0[72] = (bf16)(a.x >> 16); p0[144] = (bf16)(a.y & 0xffffu); p0[216] = (bf16)(a.y >> 16);
        p0[288] = (bf16)(a.z & 0xffffu); p0[360] = (bf16)(a.z >> 16); p0[432] = (bf16)(a.w & 0xffffu); p0[504] = (bf16)(a.w >> 16);
        p1[0] = (bf16)(c.x & 0xffffu); p1[72] = (bf16)(c.x >> 16); p1[144] = (bf16)(c.y & 0xffffu); p1[216] = (bf16)(c.y >> 16);
        p1[288] = (bf16)(c.z & 0xffffu); p1[360] = (bf16)(c.z >> 16); p1[432] = (bf16)(c.w & 0xffffu); p1[504] = (bf16)(c.w >> 16); }
    __syncthreads();
#if MIXD_NEW
    { const int c = tid & 255, half = tid >> 8, g = c >> 6;
        if (g == 0) pool_means<2>(Xt, AT, c, half, t0); else if (g == 1) pool_means<4>(Xt, AT, c, half, t0); else if (g == 2) pool_means<8>(Xt, AT, c, half, t0); else pool_means<16>(Xt, AT, c, half, t0); }
#else
    { const int c = tid & 255, half = tid >> 8, g = c >> 6, w = 2 << g;
        for (int j = 0; j < 32; ++j) { const int jj = 32 * half + j, t = t0 + jj; float s = 0.f;
            for (int i = 0; i < w; ++i) s += bf2f(Xt[(15 + jj - i) * 256 + c]);
            const int cnt = (t + 1 < w) ? (t + 1) : w;
            const float mval = s / (float)cnt - bf2f(Xt[(15 + jj) * 256 + c]);
            AT[jj * 264 + c] = (bf16)f2bf(mval); } }
#endif
    { const int d = tid >> 3, pc = tid & 7;
        *(v4u*)(VTS + ((size_t)b * 64 + d) * SEQ + t0 + 8 * pc) = *(const LAS v4u*)(TS + d * 72 + 8 * pc);
        *(v4u*)(VTW + ((size_t)b * 64 + d) * SEQ + t0 + 8 * pc) = *(const LAS v4u*)(TS + 4608 + d * 72 + 8 * pc); }
    __syncthreads();
    const int fr = lane & 15, q = lane >> 4, g = wave >> 1, nh = wave & 1;
    f32x4 acc[4][2];
#pragma unroll
    for (int a = 0; a < 4; ++a)
#pragma unroll
        for (int c = 0; c < 2; ++c) acc[a][c] = (f32x4){0.f, 0.f, 0.f, 0.f};
#pragma unroll
    for (int ks = 0; ks < 2; ++ks) {
#pragma unroll
        for (int mt = 0; mt < 4; ++mt) { const v4u af = *(const LAS v4u*)(AT + (16 * mt + fr) * 264 + 64 * g + 32 * ks + 8 * q);
#pragma unroll
            for (int nt = 0; nt < 2; ++nt) acc[mt][nt] = mfma16(pbf[ks][nt], af, acc[mt][nt]); } }
#pragma unroll
    for (int mt = 0; mt < 4; ++mt)
#pragma unroll
        for (int nt = 0; nt < 2; ++nt) { const int n0 = 64 * g + 32 * nh + 16 * nt + 4 * q; const f32x4 sc = *(const f32x4*)(A->in[I_POOLS] + l * 256 + n0); const f32x4 o = acc[mt][nt] * sc;
            v2u w; w.x = pk2(o.x, o.y); w.y = pk2(o.z, o.w); *(v2u*)(MIX + (r0 + 16 * mt + fr) * DM + 768 + n0) = w; }
    __syncthreads();
}

__device__ __forceinline__ void nsa_compress(ArgP A, int l, int item, LAS unsigned char* lds, int tid, int wave, int lane) {
    const bf16* Z = (const bf16*)(A->ws + WS_Z);
    bf16* KC = (bf16*)(A->ws + WS_KC); bf16* VCT = (bf16*)(A->ws + WS_VCT);
    const int b = item >> 4, kv = (item >> 3) & 1, mt = item & 7;
    const int colb = kv ? ZC_VC : ZC_KC;
    const float* pos = A->in[kv ? I_POSV : I_POSK] + l * 2048;
    const bf16* w1t = (const bf16*)(A->ws + WS_W + (size_t)l * WS_WL + (kv ? WO_W1V : WO_W1K));
    const float* w2 = A->in[kv ? I_W2V : I_W2K] + l * 4096;
    LAS float* RED = (LAS float*)lds;
    LAS float* H1 = (LAS float*)(lds + 32768);
    const int fr = lane & 15, q = lane >> 4, c = 16 * mt + fr; const bool cok = c < 127;
    f32x4 acc[4];
#pragma unroll
    for (int n = 0; n < 4; ++n) acc[n] = (f32x4){0.f, 0.f, 0.f, 0.f};
#pragma unroll 4
    for (int kk = 0; kk < 8; ++kk) { const int ks = 8 * wave + kk, ltok = ks >> 1, dd = 32 * (ks & 1) + 8 * q;
        v4u af = (v4u){0u, 0u, 0u, 0u};
        if (cok) { const v4u zw = *(const v4u*)ZP(Z, (size_t)b * SEQ + 16 * c + ltok, colb + dd);
            const f32x4 p0 = *(const f32x4*)(pos + ltok * 64 + dd), p1 = *(const f32x4*)(pos + ltok * 64 + dd + 4);
            af.x = pk2(bflo(zw.x) + p0.x, bfhi(zw.x) + p0.y); af.y = pk2(bflo(zw.y) + p0.z, bfhi(zw.y) + p0.w);
            af.z = pk2(bflo(zw.z) + p1.x, bfhi(zw.z) + p1.y); af.w = pk2(bflo(zw.w) + p1.z, bfhi(zw.w) + p1.w); }
#pragma unroll
        for (int nt = 0; nt < 4; ++nt) { const v4u bfr = *(const v4u*)(w1t + (16 * nt + fr) * 2048 + 32 * ks + 8 * q); acc[nt] = mfma16(af, bfr, acc[nt]); } }
#pragma unroll
    for (int nt = 0; nt < 4; ++nt)
#pragma unroll
        for (int rg = 0; rg < 4; ++rg) RED[(wave * 16 + 4 * q + rg) * 64 + 16 * nt + fr] = acc[nt][rg];
    __syncthreads();
#pragma unroll
    for (int x = 0; x < 2; ++x) { const int o = tid + 512 * x, cc = o >> 6, n = o & 63; float s = 0.f;
#pragma unroll
        for (int w = 0; w < 8; ++w) s += RED[(w * 16 + cc) * 64 + n];
        H1[o] = siluf_(s); }
    __syncthreads();
#pragma unroll
    for (int x = 0; x < 2; ++x) { const int o = tid + 512 * x, cc = o >> 6, n2 = o & 63; float s = 0.f;
        for (int n = 0; n < 64; ++n) s += H1[cc * 64 + n] * w2[n * 64 + n2];
        const int cg_ = 16 * mt + cc;
        (kv == 0 ? KC : VCT)[((size_t)b * 128 + cg_) * 64 + n2] = (bf16)f2bf(s); }
    __syncthreads();
}

template <int HA, int HB, class MaskA, class MaskB>
__device__ __forceinline__ void attn_pair(const LAS bf16* KT, const LAS bf16* VT, const v4u (&qf)[2], int fr, int q, float& m_run, f32x4& o5, f32x4 (&o)[4],
                                          float rba, float rbb, bool ma, bool mb, MaskA okA, MaskB okB) {
    constexpr int N0 = HA ? 0 : 4, N1 = HB ? 8 : 4, K0 = HA ? 0 : 2, K1 = HB ? 4 : 2;
    v4u kf0[8], kf1[8];
#pragma unroll
    for (int nt = N0; nt < N1; ++nt) { kf0[nt] = *(const LAS v4u*)(KT + (16 * nt + fr) * 72 + 8 * q); kf1[nt] = *(const LAS v4u*)(KT + (16 * nt + fr) * 72 + 32 + 8 * q); }
    __builtin_amdgcn_sched_barrier(0);
    f32x4 s[8];
#pragma unroll
    for (int nt = N0; nt < N1; ++nt) { const float rb = nt < 4 ? rba : rbb;
        s[nt] = mfma16(kf0[nt], qf[0], (f32x4){rb, rb, rb, rb}); s[nt] = mfma16(kf1[nt], qf[1], s[nt]); }
    __builtin_amdgcn_sched_barrier(0);
    v2u vfa[4][4], vfb[4][4];
#pragma unroll
    for (int k2 = K0; k2 < K1; ++k2)
#pragma unroll
        for (int dt = 0; dt < 4; ++dt) { vfa[k2][dt] = *(const LAS v2u*)(VT + (16 * dt + fr) * 136 + 32 * k2 + 4 * q); vfb[k2][dt] = *(const LAS v2u*)(VT + (16 * dt + fr) * 136 + 32 * k2 + 16 + 4 * q); }
    __builtin_amdgcn_sched_barrier(0);
    if (HA && ma) {
#pragma unroll
        for (int nt = 0; nt < 4; ++nt)
#pragma unroll
            for (int rg = 0; rg < 4; ++rg) s[nt][rg] = okA(16 * nt + 4 * q + rg) ? s[nt][rg] : -1e30f; }
    if (HB && mb) {
#pragma unroll
        for (int nt = 0; nt < 4; ++nt)
#pragma unroll
            for (int rg = 0; rg < 4; ++rg) s[4 + nt][rg] = okB(16 * nt + 4 * q + rg) ? s[4 + nt][rg] : -1e30f; }
    float mx = m_run;
#pragma unroll
    for (int nt = N0; nt < N1; ++nt)
#pragma unroll
        for (int rg = 0; rg < 4; ++rg) mx = fmaxf(mx, s[nt][rg]);
    mx = fmaxf(mx, __shfl_xor(mx, 16)); mx = fmaxf(mx, __shfl_xor(mx, 32));
    if (__ballot(mx != m_run) != 0ull) {
        const float sc = __builtin_amdgcn_exp2f(m_run - mx); m_run = mx; o5 = o5 * sc;
#pragma unroll
        for (int dt = 0; dt < 4; ++dt) o[dt] = o[dt] * sc; }
#pragma unroll
    for (int nt = N0; nt < N1; ++nt)
#pragma unroll
        for (int rg = 0; rg < 4; ++rg) s[nt][rg] = __builtin_amdgcn_exp2f(s[nt][rg] - mx);
    const unsigned onesw = (fr == 0) ? 0x3f803f80u : 0u; const v4u vones = (v4u){onesw, onesw, onesw, onesw};
#pragma unroll
    for (int k2 = K0; k2 < K1; ++k2) { v4u pf; pf.x = pk2(s[2 * k2][0], s[2 * k2][1]); pf.y = pk2(s[2 * k2][2], s[2 * k2][3]); pf.z = pk2(s[2 * k2 + 1][0], s[2 * k2 + 1][1]); pf.w = pk2(s[2 * k2 + 1][2], s[2 * k2 + 1][3]);
        o5 = mfma16(vones, pf, o5);
#pragma unroll
        for (int dt = 0; dt < 4; ++dt) { v4u vf; vf.x = vfa[k2][dt].x; vf.y = vfa[k2][dt].y; vf.z = vfb[k2][dt].x; vf.w = vfb[k2][dt].y; o[dt] = mfma16(vf, pf, o[dt]); } }
}

template <class MaskF>
__device__ __forceinline__ void attn_tile2(const LAS bf16* KT, const LAS bf16* VT, const v4u (&qf)[2][2], int fr, int q, float (&m_run)[2], f32x4 (&o5)[2], f32x4 (&o)[2][4],
                                           const bool (&need)[2], const float (&rb)[2], bool masked, MaskF okf) {
    v4u kf0[4], kf1[4];
#pragma unroll
    for (int nt = 0; nt < 4; ++nt) { kf0[nt] = *(const LAS v4u*)(KT + (16 * nt + fr) * 72 + 8 * q); kf1[nt] = *(const LAS v4u*)(KT + (16 * nt + fr) * 72 + 32 + 8 * q); }
    __builtin_amdgcn_sched_barrier(0);
    f32x4 s[2][4];
#pragma unroll
    for (int g = 0; g < 2; ++g) if (need[g]) {
#pragma unroll
        for (int nt = 0; nt < 4; ++nt) { s[g][nt] = mfma16(kf0[nt], qf[g][0], (f32x4){rb[g], rb[g], rb[g], rb[g]}); s[g][nt] = mfma16(kf1[nt], qf[g][1], s[g][nt]); } }
    __builtin_amdgcn_sched_barrier(0);
    v2u vfa[2][4], vfb[2][4];
#pragma unroll
    for (int k2 = 0; k2 < 2; ++k2)
#pragma unroll
        for (int dt = 0; dt < 4; ++dt) { vfa[k2][dt] = *(const LAS v2u*)(VT + (16 * dt + fr) * 72 + 32 * k2 + 4 * q); vfb[k2][dt] = *(const LAS v2u*)(VT + (16 * dt + fr) * 72 + 32 * k2 + 16 + 4 * q); }
    __builtin_amdgcn_sched_barrier(0);
    const unsigned onesw = (fr == 0) ? 0x3f803f80u : 0u; const v4u vones = (v4u){onesw, onesw, onesw, onesw};
#pragma unroll
    for (int g = 0; g < 2; ++g) if (need[g]) {
        if (masked) {
#pragma unroll
            for (int nt = 0; nt < 4; ++nt)
#pragma unroll
                for (int rg = 0; rg < 4; ++rg) s[g][nt][rg] = okf(g, 16 * nt + 4 * q + rg) ? s[g][nt][rg] : -1e30f; }
        float mx = m_run[g];
#pragma unroll
        for (int nt = 0; nt < 4; ++nt)
#pragma unroll
            for (int rg = 0; rg < 4; ++rg) mx = fmaxf(mx, s[g][nt][rg]);
        mx = fmaxf(mx, __shfl_xor(mx, 16)); mx = fmaxf(mx, __shfl_xor(mx, 32));
        if (__ballot(mx != m_run[g]) != 0ull) { const float sc = __builtin_amdgcn_exp2f(m_run[g] - mx); m_run[g] = mx; o5[g] = o5[g] * sc;
#pragma unroll
            for (int dt = 0; dt < 4; ++dt) o[g][dt] = o[g][dt] * sc; }
#pragma unroll
        for (int nt = 0; nt < 4; ++nt)
#pragma unroll
            for (int rg = 0; rg < 4; ++rg) s[g][nt][rg] = __builtin_amdgcn_exp2f(s[g][nt][rg] - mx);
#pragma unroll
        for (int k2 = 0; k2 < 2; ++k2) { v4u pf; pf.x = pk2(s[g][2 * k2][0], s[g][2 * k2][1]); pf.y = pk2(s[g][2 * k2][2], s[g][2 * k2][3]); pf.z = pk2(s[g][2 * k2 + 1][0], s[g][2 * k2 + 1][1]); pf.w = pk2(s[g][2 * k2 + 1][2], s[g][2 * k2 + 1][3]);
            o5[g] = mfma16(vones, pf, o5[g]);
#pragma unroll
            for (int dt = 0; dt < 4; ++dt) { v4u vf; vf.x = vfa[k2][dt].x; vf.y = vfa[k2][dt].y; vf.z = vfb[k2][dt].x; vf.w = vfb[k2][dt].y; o[g][dt] = mfma16(vf, pf, o[g][dt]); } } }
}

__device__ __forceinline__ void nsa_attn(ArgP A, int l, int item, LAS unsigned char* lds, int tid, int wave, int lane) {
#define Z ((const bf16*)(A->ws + WS_Z))
#define MIX ((bf16*)(A->ws + WS_MIX))
#define VTS ((const bf16*)(A->ws + WS_VTS))
#define VTW ((const bf16*)(A->ws + WS_VTW))
#define KC ((const bf16*)(A->ws + WS_KC))
#define VCT ((const bf16*)(A->ws + WS_VCT))
    const int jq = item >> 8, ib = item & 255, b = 2 * (ib & 7) + ((ib >> 3) & 1), a = ib >> 4;
    const int tau = jq ? 31 - a : a;
    const int t0 = 64 * tau, curb = tau, wlo = (tau >= 8) ? tau - 8 : 0;
    LAS bf16* KT = (LAS bf16*)lds; LAS bf16* VT = KT + 9216;
    LAS bf16* TB = (LAS bf16*)(lds + 35840);
    LAS float* PS = (LAS float*)(lds + 72704) + wave * (16 * 132);
    LAS float* IMP = (LAS float*)(lds + 140288) + wave * 128;
    LAS unsigned* WANY = (LAS unsigned*)(lds + 144384);
    const int fr = lane & 15, q = lane >> 4, tt = fr >> 2, hh = fr & 3;
    const int skey = tid >> 3, spc = tid & 7;
    const size_t krow = (size_t)b * SEQ + skey;
#define KADDR(j, col) ZP(Z, krow + 64 * (j), (col) + 8 * spc)
    const size_t vbase = ((size_t)b * 64 + skey) * SEQ + 8 * spc;
    v4u kr = *(const v4u*)KADDR(0, ZC_KS), vr = *(const v4u*)(VTS + vbase);
    int tq[2]; size_t grow[2]; v4u qf[2][2]; float g0[2], g1[2], g2[2];
#pragma unroll
    for (int g = 0; g < 2; ++g) { tq[g] = t0 + 8 * wave + 4 * g + tt; grow[g] = (size_t)b * SEQ + tq[g];
#pragma unroll
        for (int ks = 0; ks < 2; ++ks) { const v4u w = *(const v4u*)ZP(Z, grow[g], ZC_Q + 64 * hh + 32 * ks + 8 * q);
            const float qs = 0.125f * 1.4426950408889634f;
            qf[g][ks].x = pk2(bflo(w.x) * qs, bfhi(w.x) * qs); qf[g][ks].y = pk2(bflo(w.y) * qs, bfhi(w.y) * qs);
            qf[g][ks].z = pk2(bflo(w.z) * qs, bfhi(w.z) * qs); qf[g][ks].w = pk2(bflo(w.w) * qs, bfhi(w.w) * qs); }
        g0[g] = sigmoidf_(bf2f(*ZP(Z, grow[g], ZC_G + 3 * hh + 0))); g1[g] = sigmoidf_(bf2f(*ZP(Z, grow[g], ZC_G + 3 * hh + 1))); g2[g] = sigmoidf_(bf2f(*ZP(Z, grow[g], ZC_G + 3 * hh + 2))); }
#pragma unroll
    for (int x = 0; x < 2; ++x) { const int pi = tid + 512 * x;
        { const int c = pi >> 3, pc = pi & 7; *(LAS v4u*)(KT + c * 72 + 8 * pc) = *(const v4u*)(KC + ((size_t)b * 128 + c) * 64 + 8 * pc); }
        { const int c = pi >> 3, pc = pi & 7; const v4u w = *(const v4u*)(VCT + ((size_t)b * 128 + c) * 64 + 8 * pc); LAS bf16* vp = VT + (8 * pc) * 136 + c;
            vp[0] = (bf16)(w.x & 0xffffu); vp[136] = (bf16)(w.x >> 16); vp[272] = (bf16)(w.y & 0xffffu); vp[408] = (bf16)(w.y >> 16);
            vp[544] = (bf16)(w.z & 0xffffu); vp[680] = (bf16)(w.z >> 16); vp[816] = (bf16)(w.w & 0xffffu); vp[952] = (bf16)(w.w >> 16); } }
    __syncthreads();
    f32x4 facc[2][4];
    unsigned msk[2], wny[2];
#pragma unroll 1
    for (int g = 0; g < 2; ++g) {
        const int t = t0 + 8 * wave + 4 * g + tt;
        const v4u q0 = g ? qf[1][0] : qf[0][0], q1 = g ? qf[1][1] : qf[0][1];
        f32x4 s[8];
#pragma unroll
        for (int nt = 0; nt < 8; ++nt) { const v4u k0 = *(const LAS v4u*)(KT + (16 * nt + fr) * 72 + 8 * q), k1 = *(const LAS v4u*)(KT + (16 * nt + fr) * 72 + 32 + 8 * q);
            s[nt] = mfma16(k0, q0, (f32x4){0.f, 0.f, 0.f, 0.f}); s[nt] = mfma16(k1, q1, s[nt]); }
        float mx = -1e30f;
#pragma unroll
        for (int nt = 0; nt < 8; ++nt)
#pragma unroll
            for (int rg = 0; rg < 4; ++rg) { const int c = 16 * nt + 4 * q + rg; const float v = (16 * c + 31 <= t) ? s[nt][rg] : -1e30f; s[nt][rg] = v; mx = fmaxf(mx, v); }
        mx = fmaxf(mx, __shfl_xor(mx, 16)); mx = fmaxf(mx, __shfl_xor(mx, 32));
        float sum = 0.f;
#pragma unroll
        for (int nt = 0; nt < 8; ++nt)
#pragma unroll
            for (int rg = 0; rg < 4; ++rg) { const float p = (s[nt][rg] > -5e29f) ? __builtin_amdgcn_exp2f(s[nt][rg] - mx) : 0.f; s[nt][rg] = p; sum += p; }
        sum += __shfl_xor(sum, 16); sum += __shfl_xor(sum, 32);
        const float inv = (t >= 31) ? 1.0f / sum : 0.f;
#pragma unroll
        for (int nt = 0; nt < 8; ++nt) { s[nt] = s[nt] * inv; *(LAS f32x4*)(PS + fr * 132 + 16 * nt + 4 * q) = s[nt]; }
        f32x4 oc[4];
#pragma unroll
        for (int dt = 0; dt < 4; ++dt) oc[dt] = (f32x4){0.f, 0.f, 0.f, 0.f};
#pragma unroll
        for (int k2 = 0; k2 < 4; ++k2) { v4u pf; pf.x = pk2(s[2 * k2][0], s[2 * k2][1]); pf.y = pk2(s[2 * k2][2], s[2 * k2][3]); pf.z = pk2(s[2 * k2 + 1][0], s[2 * k2 + 1][1]); pf.w = pk2(s[2 * k2 + 1][2], s[2 * k2 + 1][3]);
#pragma unroll
            for (int dt = 0; dt < 4; ++dt) { const v2u va = *(const LAS v2u*)(VT + (16 * dt + fr) * 136 + 32 * k2 + 4 * q), vb = *(const LAS v2u*)(VT + (16 * dt + fr) * 136 + 32 * k2 + 16 + 4 * q);
                v4u vf; vf.x = va.x; vf.y = va.y; vf.z = vb.x; vf.w = vb.y; oc[dt] = mfma16(vf, pf, oc[dt]); } }
        const float gg = g ? g0[1] : g0[0];
#pragma unroll
        for (int dt = 0; dt < 4; ++dt) { const f32x4 v = oc[dt] * gg; if (g) facc[1][dt] = v; else facc[0][dt] = v; }
        LDS_WAIT();
        const int tt2 = lane >> 4, jl = lane & 15, t2 = t0 + 8 * wave + 4 * g + tt2, cur = t2 >> 6;
        float key[2];
#pragma unroll
        for (int x = 0; x < 2; ++x) { const int j = jl + 16 * x; float im = 0.f;
#pragma unroll
            for (int i = 0; i < 5; ++i) { const int c = 4 * j - 1 + i;
                if (c >= 0 && c <= 126) { im += PS[(4 * tt2 + 0) * 132 + c]; im += PS[(4 * tt2 + 1) * 132 + c]; im += PS[(4 * tt2 + 2) * 132 + c]; im += PS[(4 * tt2 + 3) * 132 + c]; } }
            const bool valid = j <= cur, forced = (j == 0) | (j == cur) | (j == cur - 1);
            key[x] = valid ? (forced ? im + 1e4f : im) : -1e30f; IMP[tt2 * 32 + j] = key[x]; }
        LDS_WAIT();
        int rk0 = 0, rk1 = 0;
        f32x4 kq[8];
#pragma unroll
        for (int i = 0; i < 8; ++i) kq[i] = *(const LAS f32x4*)(IMP + tt2 * 32 + 4 * i);
#pragma unroll
        for (int j2 = 0; j2 < 32; ++j2) { const float k2 = kq[j2 >> 2][j2 & 3];
            rk0 += ((k2 > key[0]) || (k2 == key[0] && j2 < jl)) ? 1 : 0; rk1 += ((k2 > key[1]) || (k2 == key[1] && j2 < jl + 16)) ? 1 : 0; }
        const bool sel0 = (jl <= cur) && rk0 < 8, sel1 = (jl + 16 <= cur) && rk1 < 8;
        const unsigned long long bal0 = __ballot(sel0), bal1 = __ballot(sel1);
        const unsigned mk = (unsigned)((bal0 >> (16 * tt)) & 0xffffull) | ((unsigned)((bal1 >> (16 * tt)) & 0xffffull) << 16);
        unsigned wa = 0;
#pragma unroll
        for (int x = 0; x < 4; ++x) wa |= (unsigned)((bal0 >> (16 * x)) & 0xffffull) | ((unsigned)((bal1 >> (16 * x)) & 0xffffull) << 16);
        if (g) { msk[1] = mk; wny[1] = wa; } else { msk[0] = mk; wny[0] = wa; }
        LDS_WAIT();
    }
    if (lane == 0) WANY[wave] = wny[0] | wny[1];
    *(LAS v4u*)(TB + skey * 72 + 8 * spc) = kr; *(LAS v4u*)(TB + 4608 + skey * 72 + 8 * spc) = vr;
    __syncthreads();
    unsigned uni = 0;
#pragma unroll
    for (int w = 0; w < 8; ++w) uni |= WANY[w];
    int cph = 0, cj = 0, nph = 0, nj = 0, tb = 0;
#define ATT_ADV(ph, j) do { if (ph == 0) { const unsigned rem = uni & ~((2u << j) - 1u); if (rem) j = __builtin_ctz(rem); else { ph = 1; j = wlo; } } else if (++j > curb) ph = 2; } while (0)
    ATT_ADV(nph, nj);
    float m_run[2] = {-1e4f, -1e4f}; f32x4 o5[2], o[2][4];
#pragma unroll
    for (int g = 0; g < 2; ++g) { o5[g] = (f32x4){0.f, 0.f, 0.f, 0.f};
#pragma unroll
        for (int dt = 0; dt < 4; ++dt) o[g][dt] = (f32x4){0.f, 0.f, 0.f, 0.f}; }
    while (cph != 2) {
        if (nph != 2) { kr = *(const v4u*)KADDR(nj, nph ? ZC_KW : ZC_KS); vr = *(const v4u*)((nph ? VTW : VTS) + vbase + 64 * nj); }
        { const LAS bf16* Kb = TB + tb * 9216; const LAS bf16* Vb = Kb + 4608; const int kb = 64 * cj;
            const bool need[2] = { cph ? true : (bool)((wny[0] >> cj) & 1u), cph ? true : (bool)((wny[1] >> cj) & 1u) };
            if (need[0] || need[1]) { const float rb[2] = { (cph || ((msk[0] >> cj) & 1u)) ? 0.f : -1e30f, (cph || ((msk[1] >> cj) & 1u)) ? 0.f : -1e30f };
                const int tA = tq[0], tB = tq[1], wl = cph ? 512 : (1 << 30);
                attn_tile2(Kb, Vb, qf, fr, q, m_run, o5, o, need, rb, (cj == curb) || (cph && cj <= wlo),
                           [=](int g, int kk) { const int kp = kb + kk, tg = g ? tB : tA; return (kp <= tg) && (kp > tg - wl); }); } }
        if (nph != 2) { LAS bf16* Kn = TB + (tb ^ 1) * 9216; *(LAS v4u*)(Kn + skey * 72 + 8 * spc) = kr; *(LAS v4u*)(Kn + 4608 + skey * 72 + 8 * spc) = vr; }
        if (cph == 0 && nph == 1) {
#pragma unroll
            for (int g = 0; g < 2; ++g) { const float lt = __shfl(o5[g][0], fr); const float sc = g1[g] / lt;
#pragma unroll
                for (int dt = 0; dt < 4; ++dt) { facc[g][dt] = facc[g][dt] + o[g][dt] * sc; o[g][dt] = (f32x4){0.f, 0.f, 0.f, 0.f}; }
                m_run[g] = -1e4f; o5[g] = (f32x4){0.f, 0.f, 0.f, 0.f}; } }
        __syncthreads();
        cph = nph; cj = nj; tb ^= 1; ATT_ADV(nph, nj);
    }
#undef ATT_ADV
#pragma unroll
    for (int g = 0; g < 2; ++g) { const float lt = __shfl(o5[g][0], fr); const float sc = g2[g] / lt;
#pragma unroll
        for (int dt = 0; dt < 4; ++dt) { const f32x4 v = facc[g][dt] + o[g][dt] * sc; v2u w; w.x = pk2(v.x, v.y); w.y = pk2(v.z, v.w);
            *(v2u*)(MIX + grow[g] * DM + 512 + 64 * hh + 16 * dt + 4 * q) = w; } }
}
#undef KADDR
#undef Z
#undef MIX
#undef VTS
#undef VTW
#undef KC
#undef VCT

#define XB_TMO      128
#define XB_XCNT(j)  (256  + 64 * (j))
#define XB_XSUB(j)  (1280 + 64 * (j))
#define XB_XGEN(j)  (2304 + 64 * (j))
#define XB_TOP      3328
#define XB_TOPGEN   3392
#define XCD_BAR_WORDS 3456
#define XB_SPIN_CAP (1u << 18)

__device__ __forceinline__ unsigned xb_ld(unsigned* p)              { return __hip_atomic_load(p, __ATOMIC_RELAXED, __HIP_MEMORY_SCOPE_AGENT); }
__device__ __forceinline__ unsigned xb_add(unsigned* p, unsigned v) { return __hip_atomic_fetch_add(p, v, __ATOMIC_RELAXED, __HIP_MEMORY_SCOPE_AGENT); }
__device__ __forceinline__ unsigned xb_xcc_id() { return (unsigned)__builtin_amdgcn_s_getreg((3 << 11) | 20) & 0xFu; }
#define XB_SPIN(cond, bar) do { unsigned _sp = 0; while (cond) { __builtin_amdgcn_s_sleep(1); \
    if ((++_sp & 255u) == 0u) { if (xb_ld(&(bar)[XB_TMO])) break; if (_sp > XB_SPIN_CAP) { atomicAdd(&(bar)[XB_TMO], 1u); break; } } } } while (0)

struct XcdBarrier {
    unsigned* bar; unsigned x;
    volatile LAS unsigned* st;
};

__device__ __forceinline__ XcdBarrier xcd_barrier_post(unsigned* bar, volatile LAS unsigned* st) {
    XcdBarrier b; b.bar = bar; b.x = xb_xcc_id(); b.st = st;
    if (threadIdx.x == 0) (void)xb_add(&bar[XB_XCNT(b.x)], 1u);
    return b;
}
__device__ __forceinline__ void xcd_barrier_complete(unsigned* bar, unsigned x, unsigned& nloc, unsigned& nx) {
    const unsigned G = gridDim.x * gridDim.y * gridDim.z;
    unsigned sum, cnt, mine, sp = 0u;
    for (;;) {
        sum = 0u; cnt = 0u; mine = 0u;
#pragma unroll
        for (unsigned j = 0; j < 16; ++j) { const unsigned c = xb_ld(&bar[XB_XCNT(j)]); sum += c; cnt += (c > 0u) ? 1u : 0u; mine = (j == x) ? c : mine; }
        if (sum == G) break;
        __builtin_amdgcn_s_sleep(1);
        if ((++sp & 255u) == 0u) { if (xb_ld(&bar[XB_TMO])) break; if (sp > XB_SPIN_CAP) { atomicAdd(&bar[XB_TMO], 1u); break; } }
    }
    nloc = mine > 0u ? mine : 1u; nx = cnt > 0u ? cnt : 1u;
}

__device__ __forceinline__ void xcd_barrier(const XcdBarrier& b) {
    asm volatile("s_waitcnt vmcnt(0)" ::: "memory");
    __syncthreads();
    if (threadIdx.x == 0) {
        unsigned* bar = b.bar;
        __builtin_amdgcn_s_waitcnt(0);
        unsigned nloc = b.st[0], nx = b.st[1];
        if (nloc == 0u) { xcd_barrier_complete(bar, b.x, nloc, nx); b.st[0] = nloc; b.st[1] = nx; }
        const unsigned old = xb_add(&bar[XB_XSUB(b.x)], 1u);
        const unsigned gen = old / nloc;
        if (old + 1u == (gen + 1u) * nloc) {
            __builtin_amdgcn_fence(__ATOMIC_RELEASE, "agent");
            asm volatile("s_waitcnt vmcnt(0)" ::: "memory");
            const unsigned og = xb_add(&bar[XB_TOP], 1u);
            const unsigned tg = og / nx;
            if (og + 1u == (tg + 1u) * nx) xb_add(&bar[XB_TOPGEN], 1u);
            else XB_SPIN(xb_ld(&bar[XB_TOPGEN]) == tg, bar);
            __builtin_amdgcn_fence(__ATOMIC_ACQUIRE, "agent");
            xb_add(&bar[XB_XGEN(b.x)], 1u);
            asm volatile("s_waitcnt vmcnt(0)" ::: "memory");
        } else {
            XB_SPIN(xb_ld(&bar[XB_XGEN(b.x)]) == gen, bar);
            __builtin_amdgcn_fence(__ATOMIC_ACQUIRE, "agent");
            asm volatile("s_waitcnt vmcnt(0)" ::: "memory");
        }
    }
    __syncthreads();
}

#ifndef POSTBAR_SLEEP
#define POSTBAR_SLEEP do {} while (0)
#endif
#ifndef MIXD_NEW
#define MIXD_NEW 1
#endif
#ifndef MIXB_LNNEW
#define MIXB_LNNEW 1
#endif
#ifndef ATDRY
#define ATDRY 0
#endif
#ifndef ITREP
#define ITREP 0
#endif
#ifndef REPMASK
#define REPMASK 0
#endif
#ifndef PHSEL
#define PHSEL 0xfff
#endif
constexpr int N_PHASES = 1 + 8 * DEPTH;
__global__ void __launch_bounds__(NTHREADS) hybrid_fwd(Args KA) {
    extern __shared__ __attribute__((aligned(16))) unsigned char lds_raw[];
    LAS unsigned char* lds = (LAS unsigned char*)lds_raw;
    cg::grid_group grid = cg::this_grid();
    volatile LAS unsigned* MISC = (volatile LAS unsigned*)(lds + LDS_BYTES - 64);
    if (threadIdx.x < 16) MISC[threadIdx.x] = 0u;
    __syncthreads();
    const XcdBarrier bar = xcd_barrier_post((unsigned*)(KA.ws + WS_CTL), MISC);
#define SEAM(first) do { if (first) { __threadfence(); asm volatile("s_waitcnt vmcnt(0)" ::: "memory"); grid.sync(); __builtin_amdgcn_fence(__ATOMIC_ACQUIRE, "agent"); asm volatile("s_waitcnt vmcnt(0)" ::: "memory"); __syncthreads(); } else { xcd_barrier(bar); POSTBAR_SLEEP; } } while (0)
#if REPMASK
    for (int ph2 = 2 * KA.ph_lo; ph2 < 2 * KA.ph_hi; ++ph2) {
        const int ph = ph2 >> 1;
        if (ph2 & 1) { const int stx = (ph == 0) ? 8 : ((ph - 1) & 7); if (!(((REPMASK & ~0x90) >> stx) & 1) && !((REPMASK >> 9) & 1)) continue; }
        if (ph2 > 2 * KA.ph_lo) SEAM(ph2 == 2 * KA.ph_lo + 2);
        if (ph2 & 1) { const int stx = (ph == 0) ? 8 : ((ph - 1) & 7); if (!(((REPMASK & ~0x90) >> stx) & 1)) continue; }
#else
    for (int ph = KA.ph_lo; ph < KA.ph_hi; ++ph) {
        if (ph > KA.ph_lo) SEAM(ph == KA.ph_lo + 1);
#endif
        ArgP A = (ArgP)__builtin_amdgcn_kernarg_segment_ptr(); asm volatile("" : "+s"(A));
        int tid = threadIdx.x; asm volatile("" : "+v"(tid));
        int G = gridDim.x, bid = blockIdx.x; asm volatile("" : "+s"(G), "+s"(bid));
        const int ngw = G * NWAVES;
        const int lane = tid & 63, wave = __builtin_amdgcn_readfirstlane(tid >> 6), gw = bid * NWAVES + wave;
        unsigned char* ws = A->ws;
        bf16* H = (bf16*)(ws + WS_H); bf16* Zb = (bf16*)(ws + WS_Z); bf16* MIX = (bf16*)(ws + WS_MIX); bf16* HID = (bf16*)(ws + WS_HID); bf16* Y = (bf16*)(ws + WS_Y); float* R2 = (float*)(ws + WS_R2);
        if (ph == 0) {
#if PHSEL & 1
            LAS float* scr = (LAS float*)(lds + wave * 16384);
            for (int it = gw; it < DEPTH * TI_LAYER; it += ngw) prologue_item(A, it, scr, lane);
            for (int idx = bid * NTHREADS + tid; idx < DEPTH * 65536; idx += G * NTHREADS) { const int l = idx >> 16, rem = idx & 65535, tq = (rem >> 7) & 127, sq = rem & 127;
                ((bf16*)(ws + WS_W + (size_t)l * WS_WL + WO_SG))[rem] = (sq <= tq) ? (bf16)f2bf(A->in[I_SGW][idx]) : (bf16)0; }
            norm_first(A->in[I_X], H, R2, bid, G, wave, lane);
#endif
            continue;
        }
        const int l = (ph - 1) >> 3, st = (ph - 1) & 7;
        unsigned char* wl = ws + WS_W + (size_t)l * WS_WL;
        if (st == 0) {
#if PHSEL & 2
            pg8::Gemm g{H, (const bf16*)(wl + WO_IN), MROWS, ZC, DM}; pg8::StaticOrder S; S.init(MROWS, ZC, G, bid);
            pg8::EpiBf16RS E{Zb, 256, R2 + (size_t)(2 * l) * MROWS, ZT};
            pg8::gemm_phase<pg8::EpiBf16RS, pg8::StaticOrder, PG8_ALIGN, PG8_SP2>(lds, g, S, E);
#endif
        } else if (st == 1) {
#if PHSEL & 4
            for (int it0 = bid; it0 < 1536 + (ITREP ? 512 : 0); it0 += G) {
                int it = it0; int tid_i = tid; ArgP A_i = A; asm volatile("" : "+v"(tid_i), "+s"(A_i));
                const int lane_i = tid_i & 63, wave_i = __builtin_amdgcn_readfirstlane(tid_i >> 6);
                if (it0 >= 1536) { const int e = it0 - 1536; if (ITREP == 1) { if (e >= 256) continue; it = e; } else if (ITREP == 2) it = 256 + e; else if (ITREP == 4) it = 768 + e; else { if (e >= 256) continue; it = 1280 + e; } }
                if (it < 256) {
#if PHSEL & 256
                    mixer_a(A_i, l, it, lds, tid_i, wave_i, lane_i);
#endif
                } else if (it < 768) {
#if PHSEL & 512
                    mixer_b(A_i, l, it - 256, lds, tid_i, wave_i, lane_i);
#endif
                } else if (it < 1280) {
#if PHSEL & 1024
                    mixer_d(A_i, l, it - 768, lds, tid_i, wave_i, lane_i);
#endif
                } else {
#if PHSEL & 2048
                    nsa_compress(A_i, l, it - 1280, lds, tid_i, wave_i, lane_i);
#endif
                }
            }
#endif
        } else if (st == 2) {
#if PHSEL & 8
            for (int it = bid; it < 512; it += G) { int tid_i = tid; ArgP A_i = A; asm volatile("" : "+v"(tid_i), "+s"(A_i));
                nsa_attn(A_i, l, it, lds, tid_i, __builtin_amdgcn_readfirstlane(tid_i >> 6), tid_i & 63); }
#endif
        } else if (st == 3 || st == 6) {
#if PHSEL & 16
            pg8::Gemm g{st == 3 ? MIX : HID, (const bf16*)(wl + (st == 3 ? WO_OUT : WO_DN)), MROWS, DM, st == 3 ? DM : FFH}; pg8::StaticOrder S; S.init(MROWS, DM, G, bid);
            pg8::EpiBf16<0> E{Y, DM, nullptr, 0, 0, 1.f};
            pg8::gemm_phase<pg8::EpiBf16<0>, pg8::StaticOrder, PG8_ALIGN, PG8_SP2>(lds, g, S, E);
#endif
        } else if (st == 4) {
#if PHSEL & 32
#if (REPMASK >> 4) & 1
            norm_bf<false>(H, HID, Y, A->in[I_GQM] + l * DM, (float*)(ws + WS_MIX), nullptr, bid, G, wave, lane);
#endif
            norm_bf<false>(H, H, Y, A->in[I_GQM] + l * DM, R2 + (size_t)(2 * l + 1) * MROWS, nullptr, bid, G, wave, lane);
#endif
        } else if (st == 5) {
#if PHSEL & 64
            pg8::Gemm g{H, (const bf16*)(wl + WO_GU), MROWS, 2 * FFH, DM}; pg8::StaticOrder S; S.init(MROWS, 2 * FFH, G, bid);
            pg8::EpiSwiGLU E{HID, FFH, R2 + (size_t)(2 * l + 1) * MROWS};
            pg8::gemm_phase<pg8::EpiSwiGLU, pg8::StaticOrder, PG8_ALIGN, PG8_SP2>(lds, g, S, E);
#endif
        } else {
#if PHSEL & 128
            const bool last = (l == DEPTH - 1);
#if (REPMASK >> 7) & 1
            norm_bf<false>(H, HID, Y, A->in[I_GQF] + l * DM, (float*)(ws + WS_MIX), nullptr, bid, G, wave, lane);
#endif
            if (last) norm_bf<true>(H, H, Y, A->in[I_GQF] + l * DM, nullptr, A->out, bid, G, wave, lane);
            else norm_bf<false>(H, H, Y, A->in[I_GQF] + l * DM, R2 + (size_t)(2 * l + 2) * MROWS, nullptr, bid, G, wave, lane);
#endif
        }
    }
}

#ifndef MK_MULTI
#define MK_MULTI 0
#endif
extern "C" void kernel_launch(void* const* d_in, const int* in_sizes, int n_in, void* d_out, int out_size, void* d_ws, size_t ws_size, hipStream_t stream) {
    static int grid = 0;
    if (grid == 0) {
        if (n_in != 26 || out_size != MROWS * DM || ws_size < WS_END) { fprintf(stderr, "kernel_launch: unexpected shapes (n_in %d out %d ws %zu)\n", n_in, out_size, ws_size); grid = -1; return; }
        int dev = 0, cus = 0, per_cu = 0;
        hipGetDevice(&dev); hipDeviceGetAttribute(&cus, hipDeviceAttributeMultiprocessorCount, dev);
        hipFuncSetAttribute((const void*)hybrid_fwd, hipFuncAttributeMaxDynamicSharedMemorySize, LDS_BYTES);
        hipOccupancyMaxActiveBlocksPerMultiprocessor(&per_cu, (const void*)hybrid_fwd, NTHREADS, LDS_BYTES);
        if (per_cu < 1) per_cu = 1;
        grid = cus * per_cu;
        (void)hipGetLastError();
    }
    if (grid < 0) return;
    Args a{};
    for (int i = 0; i < 26; ++i) a.in[i] = (const float*)d_in[i];
    a.out = (float*)d_out; a.ws = (unsigned char*)d_ws;
    if (hipMemsetAsync((char*)d_ws + WS_CTL, 0, CTL_BYTES, stream) != hipSuccess) { fprintf(stderr, "kernel_launch: memset of the barrier words failed\n"); return; }
#if MK_MULTI
    for (int ph = 0; ph < N_PHASES; ++ph) { a.ph_lo = ph; a.ph_hi = ph + 1; hipLaunchKernelGGL(hybrid_fwd, dim3(grid), dim3(NTHREADS), LDS_BYTES, stream, a); }
#else
    a.ph_lo = 0; a.ph_hi = N_PHASES;
    void* args[] = {&a};
    hipError_t e = hipLaunchCooperativeKernel((const void*)hybrid_fwd, dim3(grid), dim3(NTHREADS), args, LDS_BYTES, stream);
    if (e != hipSuccess) fprintf(stderr, "cooperative launch failed: %s (grid %d)\n", hipGetErrorString(e), grid);
#endif
}
```

```cpp
#include <hip/hip_runtime.h>
#include <hip/hip_cooperative_groups.h>
#include <cstdio>
#include <cstdint>
namespace cg = cooperative_groups;
namespace pg8 {
#define PG8_LAS __attribute__((address_space(3)))
typedef unsigned short bf16_t;
typedef short bf16x8 __attribute__((ext_vector_type(8)));
typedef float f32x4 __attribute__((ext_vector_type(4)));
typedef unsigned u32x4 __attribute__((ext_vector_type(4)));
constexpr int BM = 256, BK = 64, HALF = 128, HTB = HALF * BK * 2  , STAGE_BYTES = 8 * HTB, NXCD = 8, WGM = 8;

__host__ __device__ __forceinline__ int lds_byte(int r, int c) { const int st = (r >> 4) * 2 + (c >> 5), rr = r & 15, cc = c & 31, ob = rr * 64 + cc * 2; return st * 1024 + (ob ^ (((ob >> 9) & 1) << 5)); }
__host__ __device__ __forceinline__ void stage_rc(int b, int& R, int& C) { const int st = b / 1024, sb = b % 1024, swz = sb ^ (((sb >> 9) & 1) << 5); R = (st >> 1) * 16 + swz / 64; C = (st & 1) * 32 + (swz % 64) / 2; }
__host__ __device__ __forceinline__ int perm32(int rho) { const int n = rho >> 4, i = rho & 15; return 8 * (i >> 2) + 4 * n + (i & 3); }

struct Unit { int pm, pn; };
struct Gemm { const bf16_t* A; const bf16_t* Bt; int M, N, K; };

struct StaticOrder {
    int nM, nN, nwg, G, c;
    __host__ __device__ void init(int M, int N, int G_, int c_) { nM = M / BM; nN = N / BM; nwg = nM * nN; G = G_; c = c_; }
    __host__ __device__ bool next(int i, Unit& u) const {
        const long L = (long)i * G + c; if (L >= nwg) return false;
        int wgid = (int)L; { const int q = nwg / NXCD, r = nwg % NXCD, xcd = wgid % NXCD, off = wgid / NXCD; wgid = (xcd < r ? xcd * (q + 1) : r * (q + 1) + (xcd - r) * q) + off; }
        const int nig = WGM * nN, gid = wgid / nig, fm = gid * WGM, gsz = (nM - fm) < WGM ? (nM - fm) : WGM;
        u.pm = fm + ((wgid % nig) % gsz); u.pn = (wgid % nig) / gsz; return true;
    }
    __device__ __forceinline__ void a_ready(const Unit&) const {}
    __device__ __forceinline__ void done(const Unit&) const {}
};

__device__ __forceinline__ unsigned cvt_pk_bf16(float lo, float hi) { unsigned r; asm volatile("v_cvt_pk_bf16_f32 %0, %1, %2" : "=v"(r) : "v"(lo), "v"(hi)); return r; }
typedef float f32x2 __attribute__((ext_vector_type(2)));
__device__ __forceinline__ f32x2 gelu_pk(f32x2 v) {
    const f32x2 av = __builtin_elementwise_abs(v), d = av * 0.2316418882f + 1.0f;
    f32x2 t; t.x = __builtin_amdgcn_rcpf(d.x); t.y = __builtin_amdgcn_rcpf(d.y);
    f32x2 q = t * 0.5307027145f + (-0.7265760135f); q = q * t + 0.7107068705f; q = q * t + (-0.142248368f); q = q * t + 0.127414796f; q = q * t;
    const f32x2 s = (v * v) * (-0.72134752044f);
    f32x2 e; e.x = __builtin_amdgcn_exp2f(s.x); e.y = __builtin_amdgcn_exp2f(s.y);
    const f32x2 m = v * (q * e), r = v - m;
    f32x2 o; o.x = v.x < 0.f ? m.x : r.x; o.y = v.y < 0.f ? m.y : r.y; return o;
}

template <int ACT  > struct EpiBf16 {
    static constexpr bool PERM = true, AFTER_DRAIN = false; static_assert(ACT == 0 || ACT == 1, "EpiBf16: ACT is 0 (none) or 1 (gelu_pk)");
    bf16_t* O; int ldc; const float* bias; int split_cols; size_t split_stride; float scale0;
    __device__ __forceinline__ void operator()(const f32x4 (&acc)[2][2][4][2], const Unit& u, int wr, int wc, int fr, int fq) const {
        const int row0 = u.pm * BM + wr * 64 + fr; int colt = u.pn * BM; bf16_t* base = O;
        float sc = 1.f; if (split_cols) { const int t = colt / split_cols; base += (size_t)t * split_stride; colt -= t * split_cols; if (t == 0) sc = scale0; }
        const int col0 = colt + wc * 32 + 8 * fq, bcol0 = u.pn * BM + wc * 32 + 8 * fq;
        f32x4 bv[2][2];
#pragma unroll
        for (int bj = 0; bj < 2; ++bj)
#pragma unroll
            for (int n = 0; n < 2; ++n) bv[bj][n] = bias ? *(const f32x4*)(bias + bcol0 + bj * HALF + 4 * n) : (f32x4){0.f, 0.f, 0.f, 0.f};
#pragma unroll
        for (int ai = 0; ai < 2; ++ai)
#pragma unroll
            for (int m = 0; m < 4; ++m) { bf16_t* rowp = base + (size_t)(row0 + ai * HALF + m * 16) * ldc + col0;
#pragma unroll
                for (int bj = 0; bj < 2; ++bj) { f32x4 v0 = acc[ai][bj][m][0] + bv[bj][0], v1 = acc[ai][bj][m][1] + bv[bj][1];
                    if (ACT == 1) { f32x2 a = gelu_pk((f32x2){v0[0], v0[1]}), b = gelu_pk((f32x2){v0[2], v0[3]}), c = gelu_pk((f32x2){v1[0], v1[1]}), d = gelu_pk((f32x2){v1[2], v1[3]});
                        v0 = (f32x4){a.x, a.y, b.x, b.y}; v1 = (f32x4){c.x, c.y, d.x, d.y}; }
                    v0 = v0 * sc; v1 = v1 * sc; u32x4 w; w.x = cvt_pk_bf16(v0[0], v0[1]); w.y = cvt_pk_bf16(v0[2], v0[3]); w.z = cvt_pk_bf16(v1[0], v1[1]); w.w = cvt_pk_bf16(v1[2], v1[3]);
                    *(u32x4*)(rowp + bj * HALF) = w; } }
    }
};
struct EpiF32 {
    static constexpr bool PERM = false, AFTER_DRAIN = false;
    float* O; int ldc;
    __device__ __forceinline__ void operator()(const f32x4 (&acc)[2][2][4][2], const Unit& u, int wr, int wc, int fr, int fq) const {
        const int row0 = u.pm * BM + wr * 64 + fr, col0 = u.pn * BM + wc * 32 + 4 * fq;
#pragma unroll
        for (int ai = 0; ai < 2; ++ai)
#pragma unroll
            for (int m = 0; m < 4; ++m) { float* rowp = O + (size_t)(row0 + ai * HALF + m * 16) * ldc + col0;
#pragma unroll
                for (int bj = 0; bj < 2; ++bj)
#pragma unroll
                    for (int n = 0; n < 2; ++n) *(f32x4*)(rowp + bj * HALF + n * 16) = acc[ai][bj][m][n]; }
    }
};
struct EpiSwiGLU {
    static constexpr bool PERM = true, AFTER_DRAIN = false;
    bf16_t* O; int ldc; const float* rs;
    __device__ __forceinline__ void operator()(const f32x4 (&acc)[2][2][4][2], const Unit& u, int wr, int wc, int fr, int fq) const {
        const int row0 = u.pm * BM + wr * 64 + fr, col0 = u.pn * HALF + wc * 32 + 8 * fq;
#pragma unroll
        for (int ai = 0; ai < 2; ++ai)
#pragma unroll
            for (int m = 0; m < 4; ++m) { bf16_t* rowp = O + (size_t)(row0 + ai * HALF + m * 16) * ldc + col0;
                const float r = rs[row0 + ai * HALF + m * 16];
                float h[8];
#pragma unroll
                for (int n = 0; n < 2; ++n)
#pragma unroll
                    for (int e = 0; e < 4; ++e) { const float g = acc[ai][0][m][n][e] * r, up = acc[ai][1][m][n][e] * r;
                        h[n * 4 + e] = g * __builtin_amdgcn_rcpf(1.0f + __builtin_amdgcn_exp2f(-1.4426950408889634f * g)) * up; }
                u32x4 w; w.x = cvt_pk_bf16(h[0], h[1]); w.y = cvt_pk_bf16(h[2], h[3]); w.z = cvt_pk_bf16(h[4], h[5]); w.w = cvt_pk_bf16(h[6], h[7]);
                *(u32x4*)rowp = w; }
    }
};
struct EpiBf16RS {
    static constexpr bool PERM = true, AFTER_DRAIN = false;
    bf16_t* O; int ldc; const float* rs; size_t ts;
    __device__ __forceinline__ void operator()(const f32x4 (&acc)[2][2][4][2], const Unit& u, int wr, int wc, int fr, int fq) const {
        const int row0 = u.pm * BM + wr * 64 + fr, col0 = wc * 32 + 8 * fq;
#pragma unroll
        for (int ai = 0; ai < 2; ++ai)
#pragma unroll
            for (int m = 0; m < 4; ++m) { bf16_t* rowp = O + (size_t)u.pn * ts + (size_t)(row0 + ai * HALF + m * 16) * ldc + col0; const float r = rs[row0 + ai * HALF + m * 16];
#pragma unroll
                for (int bj = 0; bj < 2; ++bj) { const f32x4 v0 = acc[ai][bj][m][0] * r, v1 = acc[ai][bj][m][1] * r;
                    u32x4 w; w.x = cvt_pk_bf16(v0[0], v0[1]); w.y = cvt_pk_bf16(v0[2], v0[3]); w.z = cvt_pk_bf16(v1[0], v1[1]); w.w = cvt_pk_bf16(v1[2], v1[3]);
                    *(u32x4*)(rowp + bj * HALF) = w; } }
    }
};
template <class Epi, class Sched, bool ALIGN_EPI = false, bool SP2 = false>
__device__ __forceinline__ void gemm_phase(PG8_LAS unsigned char* lds, const Gemm g, const Sched& S, const Epi& E) {
    int tid_l = threadIdx.x; asm volatile("" : "+v"(tid_l));
    const int tid = tid_l, wid = __builtin_amdgcn_readfirstlane(tid >> 6), lane = tid & 63, wr = wid >> 2, wc = wid & 3, fr = lane & 15, fq = lane >> 4;
    const int K = g.K, nt = K / BK;
    unsigned voffA[2], voffB[2];
#pragma unroll
    for (int i = 0; i < 2; ++i) { int R, C; stage_rc(tid * 16 + i * 8192, R, C); const int Rb = Epi::PERM ? ((R & ~31) + perm32(R & 31)) : R;
        voffA[i] = (unsigned)(R * K + C) * 2u; voffB[i] = (unsigned)(Rb * K + C) * 2u; }
    const size_t kstep = (size_t)(BK * 2);
    const size_t hstep = (size_t)HALF * K * 2;
    const size_t tstep = 2 * hstep;
    const unsigned ldsw = (unsigned)wid * 1024u;
    const int aoff = lds_byte(wr * 64 + fr, fq * 8), boff = lds_byte(wc * 32 + fr, fq * 8);
#define PG8_SA(b, h) (((b) * 2 + (h)) * HTB)
#define PG8_SB(b, h) ((4 + (b) * 2 + (h)) * HTB)
#define PG8_STAGE(bufoff, gbase, voff) do { _Pragma("unroll") for (int _i = 0; _i < 2; ++_i) \
        __builtin_amdgcn_global_load_lds((const unsigned*)((const char*)(gbase) + (voff)[_i]), (PG8_LAS unsigned*)(lds + (bufoff) + ldsw + _i * 8192), 16, 0, 0); } while (0)
#define PG8_LDA(dst, b, h) do { _Pragma("unroll") for (int m = 0; m < 4; ++m) _Pragma("unroll") for (int k = 0; k < 2; ++k) dst[m][k] = *(const PG8_LAS bf16x8*)(lds + PG8_SA(b, h) + aoff + m * 2048 + k * 1024); } while (0)
#define PG8_LDB(dst, b, h) do { _Pragma("unroll") for (int n = 0; n < 2; ++n) _Pragma("unroll") for (int k = 0; k < 2; ++k) dst[n][k] = *(const PG8_LAS bf16x8*)(lds + PG8_SB(b, h) + boff + n * 2048 + k * 1024); } while (0)
#define PG8_MMA(ai, bj, At, Bt) do { __builtin_amdgcn_s_setprio(1); _Pragma("unroll") for (int m = 0; m < 4; ++m) _Pragma("unroll") for (int n = 0; n < 2; ++n) _Pragma("unroll") for (int k = 0; k < 2; ++k) \
        acc[ai][bj][m][n] = __builtin_amdgcn_mfma_f32_16x16x32_bf16(Bt[n][k], At[m][k], acc[ai][bj][m][n], 0, 0, 0); __builtin_amdgcn_s_setprio(0); } while (0)
#define PG8_WAIT_V(n) asm volatile("s_waitcnt vmcnt(" #n ")" ::: "memory")
#define PG8_WAIT_L(n) asm volatile("s_waitcnt lgkmcnt(" #n ")" ::: "memory")
#define PG8_BAR __builtin_amdgcn_s_barrier()
#define PG8_SCHED __builtin_amdgcn_sched_barrier(0)
    Unit cur, nxt; int ui = 0;
    if (!S.next(0, cur)) return;
    f32x4 acc[2][2][4][2];
#pragma unroll
    for (int a = 0; a < 2; ++a)
#pragma unroll
        for (int b = 0; b < 2; ++b)
#pragma unroll
            for (int m = 0; m < 4; ++m)
#pragma unroll
                for (int n = 0; n < 2; ++n) acc[a][b][m][n] = (f32x4){0.f, 0.f, 0.f, 0.f};
    bf16x8 At[4][2], B0[2][2], B1[2][2];
    const char* cA = (const char*)g.A + (size_t)cur.pm * tstep; const char* cB = (const char*)g.Bt + (size_t)cur.pn * tstep;
    S.a_ready(cur);
    if constexpr (SP2) {
        PG8_STAGE(PG8_SB(0, 0), cB, voffB); PG8_STAGE(PG8_SB(0, 1), cB + hstep, voffB); PG8_STAGE(PG8_SA(0, 0), cA, voffA); PG8_STAGE(PG8_SA(0, 1), cA + hstep, voffA);
        if (wr == 1) PG8_BAR;
        PG8_WAIT_V(2); PG8_BAR;
        PG8_STAGE(PG8_SB(1, 0), cB + kstep, voffB); PG8_STAGE(PG8_SA(1, 0), cA + kstep, voffA); PG8_STAGE(PG8_SB(1, 1), cB + hstep + kstep, voffB);
        PG8_WAIT_V(6); PG8_BAR;
    } else {
        PG8_STAGE(PG8_SB(0, 0), cB, voffB); PG8_STAGE(PG8_SA(0, 0), cA, voffA); PG8_STAGE(PG8_SB(0, 1), cB + hstep, voffB); PG8_STAGE(PG8_SA(0, 1), cA + hstep, voffA);
        if (wr == 1) PG8_BAR;
        PG8_WAIT_V(4); PG8_BAR;
        PG8_STAGE(PG8_SB(1, 0), cB + kstep, voffB); PG8_STAGE(PG8_SA(1, 0), cA + kstep, voffA); PG8_STAGE(PG8_SB(1, 1), cB + hstep + kstep, voffB);
        PG8_WAIT_V(6); PG8_BAR;
    }
    for (;;) {
        const bool has_next = S.next(ui + 1, nxt);
        const char* nA = has_next ? (const char*)g.A + (size_t)nxt.pm * tstep : cA; const char* nB = has_next ? (const char*)g.Bt + (size_t)nxt.pn * tstep : cB;
        for (int t = 0; t < nt; t += 2) {
            const bool last = (t == nt - 2);
            const char* a1 = cA + (size_t)(t + 1) * kstep;
            const char* a2 = last ? nA : cA + (size_t)(t + 2) * kstep; const char* b2 = last ? nB : cB + (size_t)(t + 2) * kstep;
            const char* a3 = a2 + kstep; const char* b3 = b2 + kstep;
            if (last && has_next) S.a_ready(nxt);
            if constexpr (SP2) {
            PG8_LDB(B0, 0, 0); PG8_LDB(B1, 0, 1); PG8_SCHED; PG8_LDA(At, 0, 0); PG8_STAGE(PG8_SA(1, 1), a1 + hstep, voffA);
            PG8_WAIT_V(8); PG8_WAIT_L(0); PG8_BAR; PG8_MMA(0, 0, At, B0); PG8_MMA(0, 1, At, B1); PG8_BAR; PG8_SCHED;
            PG8_LDA(At, 0, 1); PG8_STAGE(PG8_SB(0, 0), b2, voffB); PG8_STAGE(PG8_SB(0, 1), b2 + hstep, voffB); PG8_STAGE(PG8_SA(0, 0), a2, voffA);
            PG8_WAIT_V(8); PG8_WAIT_L(0); PG8_BAR; PG8_MMA(1, 0, At, B0); PG8_MMA(1, 1, At, B1); PG8_BAR; PG8_SCHED;
            PG8_LDB(B0, 1, 0); PG8_LDB(B1, 1, 1); PG8_SCHED; PG8_LDA(At, 1, 0); PG8_STAGE(PG8_SA(0, 1), a2 + hstep, voffA);
            PG8_WAIT_V(8); PG8_WAIT_L(0); PG8_BAR; PG8_MMA(0, 0, At, B0); PG8_MMA(0, 1, At, B1); PG8_BAR; PG8_SCHED;
            PG8_LDA(At, 1, 1); PG8_STAGE(PG8_SB(1, 0), b3, voffB); PG8_STAGE(PG8_SB(1, 1), b3 + hstep, voffB); PG8_STAGE(PG8_SA(1, 0), a3, voffA);
            PG8_WAIT_V(8); PG8_WAIT_L(0); PG8_BAR; PG8_MMA(1, 0, At, B0); PG8_MMA(1, 1, At, B1); PG8_BAR; PG8_SCHED;
            } else {
            PG8_LDB(B0, 0, 0); PG8_SCHED; PG8_LDA(At, 0, 0); PG8_STAGE(PG8_SA(1, 1), a1 + hstep, voffA);
            PG8_WAIT_L(8); PG8_BAR; PG8_WAIT_L(0); PG8_MMA(0, 0, At, B0); PG8_BAR; PG8_SCHED;
            PG8_LDB(B1, 0, 1); PG8_STAGE(PG8_SB(0, 0), b2, voffB);
            PG8_BAR; PG8_WAIT_L(0); PG8_MMA(0, 1, At, B1); PG8_BAR;
            PG8_LDA(At, 0, 1); PG8_STAGE(PG8_SA(0, 0), a2, voffA);
            PG8_BAR; PG8_WAIT_L(0); PG8_MMA(1, 0, At, B0); PG8_BAR; PG8_SCHED;
            PG8_STAGE(PG8_SB(0, 1), b2 + hstep, voffB);
            PG8_WAIT_V(6); PG8_BAR; PG8_MMA(1, 1, At, B1); PG8_BAR;
            PG8_LDB(B0, 1, 0); PG8_SCHED; PG8_LDA(At, 1, 0); PG8_STAGE(PG8_SA(0, 1), a2 + hstep, voffA);
            PG8_WAIT_L(8); PG8_BAR; PG8_WAIT_L(0); PG8_MMA(0, 0, At, B0); PG8_BAR; PG8_SCHED;
            PG8_LDB(B1, 1, 1); PG8_STAGE(PG8_SB(1, 0), b3, voffB);
            PG8_BAR; PG8_WAIT_L(0); PG8_MMA(0, 1, At, B1); PG8_BAR;
            PG8_LDA(At, 1, 1); PG8_STAGE(PG8_SA(1, 0), a3, voffA);
            PG8_BAR; PG8_WAIT_L(0); PG8_MMA(1, 0, At, B0); PG8_BAR; PG8_SCHED;
            PG8_STAGE(PG8_SB(1, 1), b3 + hstep, voffB);
            PG8_WAIT_V(6); PG8_BAR; PG8_MMA(1, 1, At, B1); PG8_BAR;
            }
        }
        if constexpr (ALIGN_EPI) { if (wr == 0) PG8_BAR; }
        if constexpr (!Epi::AFTER_DRAIN) { E(acc, cur, wr, wc, fr, fq); S.done(cur); }
        if (!has_next) break;
#pragma unroll
        for (int a = 0; a < 2; ++a)
#pragma unroll
            for (int b = 0; b < 2; ++b)
#pragma unroll
                for (int m = 0; m < 4; ++m)
#pragma unroll
                    for (int n = 0; n < 2; ++n) acc[a][b][m][n] = (f32x4){0.f, 0.f, 0.f, 0.f};
        cur = nxt; cA = nA; cB = nB; ++ui;
        if constexpr (ALIGN_EPI) { if (wr == 1) PG8_BAR; }
    }
    PG8_WAIT_V(0);
    if constexpr (!ALIGN_EPI) { if (wr == 0) PG8_BAR; }
    PG8_BAR;
    if constexpr (Epi::AFTER_DRAIN) { E.fused(acc, cur, wr, wc, fr, fq, lds, wid, lane); S.done(cur); }
#undef PG8_SA
#undef PG8_SB
#undef PG8_STAGE
#undef PG8_LDA
#undef PG8_LDB
#undef PG8_MMA
#undef PG8_WAIT_V
#undef PG8_WAIT_L
#undef PG8_BAR
#undef PG8_SCHED
}
}

#ifndef PG8_SP2
#define PG8_SP2 true
#endif
#ifndef PG8_ALIGN
#define PG8_ALIGN true
#endif

#define LAS __attribute__((address_space(3)))
typedef unsigned short bf16;
typedef unsigned v4u __attribute__((ext_vector_type(4)));
typedef unsigned v2u __attribute__((ext_vector_type(2)));
typedef float f32x4 __attribute__((ext_vector_type(4)));
typedef short bf16x8 __attribute__((ext_vector_type(8)));

constexpr int DM = 1024, NBATCH = 16, SEQ = 2048, DEPTH = 4, MROWS = NBATCH * SEQ, INC = 1932, ZC = 2048, FFH = 2816;
constexpr int NTHREADS = 512, NWAVES = 8;
constexpr int LDS_BYTES = 147456;
constexpr int ZC_AU = 0, ZC_AV = 256, ZC_BA = 512, ZC_BG = 768, ZC_Q = 1024, ZC_KC = 1280, ZC_VC = 1344, ZC_KS = 1408, ZC_VS = 1472, ZC_KW = 1536, ZC_VW = 1600, ZC_G = 1664, ZC_D = 1792;
constexpr size_t ZT = (size_t)NBATCH * SEQ * 256;
#define ZP(Zb, row, col) ((Zb) + (size_t)((col) >> 8) * ZT + (size_t)(row) * 256 + ((col) & 255))
constexpr size_t MiB = 1u << 20;
constexpr size_t WS_CTL = 0, CTL_BYTES = 16384;
constexpr size_t WS_W = 1 * MiB, WS_WL = 24 * MiB;
constexpr size_t WO_IN = 0, WO_OUT = 4 * MiB, WO_GU = 6 * MiB, WO_DN = 17 * MiB, WO_SG = 23 * MiB - 512 * 1024, WO_PW = WO_SG + 131072, WO_POOL = WO_PW + 131072, WO_W1K = WO_POOL + 32768, WO_W1V = WO_W1K + 262144;
static_assert(WO_DN + (size_t)1024 * 2816 * 2 <= WO_SG && WO_W1V + 262144 <= WS_WL, "weight map");
constexpr size_t WS_H = 98 * MiB, WS_Z = 162 * MiB, WS_MIX = 290 * MiB, WS_HID = 162 * MiB, WS_Y = 354 * MiB;
constexpr size_t WS_VTS = 482 * MiB, WS_VTW = 486 * MiB, WS_KC = 490 * MiB, WS_VCT = 490 * MiB + 262144, WS_R2 = 491 * MiB, WS_END = 493 * MiB;
static_assert(WS_HID + (size_t)MROWS * FFH * 2 <= WS_Y, "hid overlay");

#define LDS_WAIT() asm volatile("s_waitcnt lgkmcnt(0)" ::: "memory")
__device__ __forceinline__ float bflo(unsigned w) { return __uint_as_float(w << 16); }
__device__ __forceinline__ float bfhi(unsigned w) { return __uint_as_float(w & 0xffff0000u); }
__device__ __forceinline__ float bf2f(bf16 v) { return __uint_as_float((unsigned)v << 16); }
__device__ __forceinline__ unsigned f2bf(float f) { unsigned u = __float_as_uint(f); return (u + 0x7fffu + ((u >> 16) & 1u)) >> 16; }
__device__ __forceinline__ unsigned pk2(float lo, float hi) { unsigned r; asm("v_cvt_pk_bf16_f32 %0, %1, %2" : "=v"(r) : "v"(lo), "v"(hi)); return r; }
__device__ __forceinline__ float sigmoidf_(float x) { return __builtin_amdgcn_rcpf(1.0f + __builtin_amdgcn_exp2f(-1.4426950408889634f * x)); }
__device__ __forceinline__ float siluf_(float x) { return x * sigmoidf_(x); }
__device__ __forceinline__ float wave_sum(float v) {
#pragma unroll
    for (int o = 1; o < 64; o <<= 1) v += __shfl_xor(v, o);
    return v;
}
__device__ __forceinline__ f32x4 mfma16(v4u a, v4u b, f32x4 c) {
    return __builtin_amdgcn_mfma_f32_16x16x32_bf16(__builtin_bit_cast(bf16x8, a), __builtin_bit_cast(bf16x8, b), c, 0, 0, 0);
}

struct Args { const float* in[26]; float* out; unsigned char* ws; int ph_lo, ph_hi; };
typedef const __attribute__((address_space(4))) Args* ArgP;
enum { I_X = 0, I_GPM, I_GQM, I_GPF, I_GQF, I_WIN, I_SGLN, I_SGW, I_SGB, I_CVW, I_CVB, I_CVLG, I_CVLB, I_CVPW, I_CVPB, I_POSK, I_POSV, I_W1K, I_W2K, I_W1V, I_W2V, I_POOLW, I_POOLS, I_WOUT, I_GU, I_DN };

__device__ __forceinline__ void tr_item(const float* __restrict__ src, int Nsrc, int K, bf16* dst, int k0, int n0d, int nsrc0, int nvalid, LAS float* scr, int lane, const float* gk = nullptr) {
    const int kk8 = lane >> 3, n4 = (lane & 7) * 4; const bool ok = n4 < nvalid;
#pragma unroll
    for (int i = 0; i < 8; ++i) { const int kk = 8 * i + kk8; f32x4 v = (f32x4){0.f, 0.f, 0.f, 0.f};
        if (ok) { v = *(const f32x4*)(src + (size_t)(k0 + kk) * Nsrc + nsrc0 + n4); if (gk) v = v * gk[k0 + kk]; }
        LAS float* sp = scr + kk * 33 + n4; sp[0] = v.x; sp[1] = v.y; sp[2] = v.z; sp[3] = v.w; }
    LDS_WAIT();
    const int c = lane & 7;
#pragma unroll
    for (int j = 0; j < 4; ++j) { const int n = (lane >> 3) + 8 * j; const LAS float* s = scr + (8 * c) * 33 + n;
        v4u o; o.x = pk2(s[0 * 33], s[1 * 33]); o.y = pk2(s[2 * 33], s[3 * 33]); o.z = pk2(s[4 * 33], s[5 * 33]); o.w = pk2(s[6 * 33], s[7 * 33]);
        *(v4u*)(dst + (size_t)(n0d + n) * K + k0 + 8 * c) = o; }
    LDS_WAIT();
}
constexpr int TI_IN = 1024, TI_OUT = 512, TI_GU = 2816, TI_DN = 1408, TI_PW = 32, TI_POOL = 8, TI_W1 = 64;
constexpr int TI_LAYER = TI_IN + TI_OUT + TI_GU + TI_DN + TI_PW + TI_POOL + 2 * TI_W1;

__device__ __forceinline__ void prologue_item(ArgP A, int it, LAS float* scr, int lane) {
    const int l = it / TI_LAYER; int r = it % TI_LAYER;
    unsigned char* wl = A->ws + WS_W + (size_t)l * WS_WL;
    if (r < TI_IN) { const int kb = r >> 6, nb = r & 63, n0d = 32 * nb; int ns = n0d, nv = 32;
        if (n0d >= ZC_D) ns = 1676 + (n0d - ZC_D); else if (n0d == ZC_G) { ns = 1664; nv = 12; } else if (n0d > ZC_G) { ns = 0; nv = 0; }
        tr_item(A->in[I_WIN] + (size_t)l * DM * INC, INC, DM, (bf16*)(wl + WO_IN), 64 * kb, n0d, ns, nv, scr, lane, A->in[I_GPM] + l * DM); return; }
    r -= TI_IN;
    if (r < TI_OUT) { const int kb = r >> 5, nb = r & 31;
        tr_item(A->in[I_WOUT] + (size_t)l * DM * DM, DM, DM, (bf16*)(wl + WO_OUT), 64 * kb, 32 * nb, 32 * nb, 32, scr, lane); return; }
    r -= TI_OUT;
    if (r < TI_GU) { const int kb = r / 176, nb = r % 176, n0d = 32 * nb, pn = n0d >> 8, bj = (n0d >> 7) & 1, i0 = n0d & 127;
        tr_item(A->in[I_GU] + (size_t)l * DM * 2 * FFH, 2 * FFH, DM, (bf16*)(wl + WO_GU), 64 * kb, n0d, bj * FFH + 128 * pn + i0, 32, scr, lane, A->in[I_GPF] + l * DM); return; }
    r -= TI_GU;
    if (r < TI_DN) { const int kb = r >> 5, nb = r & 31;
        tr_item(A->in[I_DN] + (size_t)l * FFH * DM, DM, FFH, (bf16*)(wl + WO_DN), 64 * kb, 32 * nb, 32 * nb, 32, scr, lane); return; }
    r -= TI_DN;
    if (r < TI_PW) { const int kb = r >> 3, nb = r & 7;
        tr_item(A->in[I_CVPW] + (size_t)l * 65536, 256, 256, (bf16*)(wl + WO_PW), 64 * kb, 32 * nb, 32 * nb, 32, scr, lane); return; }
    r -= TI_PW;
    if (r < TI_POOL) { const int g = r >> 1, nb = r & 1;
        tr_item(A->in[I_POOLW] + (size_t)l * 16384 + g * 4096, 64, 64, (bf16*)(wl + WO_POOL) + g * 4096, 0, 32 * nb, 32 * nb, 32, scr, lane); return; }
    r -= TI_POOL;
    if (r < TI_W1) { const int kb = r >> 1, nb = r & 1;
        tr_item(A->in[I_W1K] + (size_t)l * 131072, 64, 2048, (bf16*)(wl + WO_W1K), 64 * kb, 32 * nb, 32 * nb, 32, scr, lane); return; }
    r -= TI_W1;
    { const int kb = r >> 1, nb = r & 1;
        tr_item(A->in[I_W1V] + (size_t)l * 131072, 64, 2048, (bf16*)(wl + WO_W1V), 64 * kb, 32 * nb, 32 * nb, 32, scr, lane); }
}

struct NRow { f32x4 x[4], y[4]; };
template <bool HASY>
__device__ __forceinline__ void nr_load(NRow& r, const float* xin, const float* y, int m, int lane) {
    const f32x4* xr = (const f32x4*)(xin + (size_t)m * DM) + lane;
#pragma unroll
    for (int j = 0; j < 4; ++j) r.x[j] = xr[64 * j];
    if (HASY) { const f32x4* yr = (const f32x4*)(y + (size_t)m * DM) + lane;
#pragma unroll
        for (int j = 0; j < 4; ++j) r.y[j] = yr[64 * j]; }
}
template <bool HASY, bool HASH>
__device__ __forceinline__ void nr_proc(NRow& r, const float* g1, float* xout, const float* g2, bf16* Hout, int m, int lane) {
    if (HASY) { float ss = 0.f;
#pragma unroll
        for (int j = 0; j < 4; ++j) ss += (r.y[j].x * r.y[j].x + r.y[j].y * r.y[j].y) + (r.y[j].z * r.y[j].z + r.y[j].w * r.y[j].w);
        const float rr = 1.0f / sqrtf(wave_sum(ss) * (1.0f / DM) + 1e-6f);
        f32x4* xo = (f32x4*)(xout + (size_t)m * DM) + lane;
#pragma unroll
        for (int j = 0; j < 4; ++j) { const f32x4 g = ((const f32x4*)g1)[lane + 64 * j]; r.x[j] = r.x[j] + (r.y[j] * rr) * g; xo[64 * j] = r.x[j]; } }
    if (HASH) { float ss = 0.f;
#pragma unroll
        for (int j = 0; j < 4; ++j) ss += (r.x[j].x * r.x[j].x + r.x[j].y * r.x[j].y) + (r.x[j].z * r.x[j].z + r.x[j].w * r.x[j].w);
        const float rr = 1.0f / sqrtf(wave_sum(ss) * (1.0f / DM) + 1e-6f);
        v2u* ho = (v2u*)(Hout + (size_t)m * DM) + lane;
#pragma unroll
        for (int j = 0; j < 4; ++j) { const f32x4 g = ((const f32x4*)g2)[lane + 64 * j]; const f32x4 o = (r.x[j] * rr) * g; v2u w; w.x = pk2(o.x, o.y); w.y = pk2(o.z, o.w); ho[64 * j] = w; } }
}
template <bool HASY, bool HASH>
__device__ __forceinline__ void norm_rows(const float* xin, const float* y, const float* g1, float* xout, const float* g2, bf16* Hout, int gw, int ngw, int lane) {
    if ((MROWS % (2 * ngw)) == 0) {
        for (int m = gw; m < MROWS; m += 2 * ngw) {
            NRow ra, rb;
            nr_load<HASY>(ra, xin, y, m, lane); nr_load<HASY>(rb, xin, y, m + ngw, lane);
            nr_proc<HASY, HASH>(ra, g1, xout, g2, Hout, m, lane); nr_proc<HASY, HASH>(rb, g1, xout, g2, Hout, m + ngw, lane);
        }
    } else {
        for (int m = gw; m < MROWS; m += ngw) { NRow ra; nr_load<HASY>(ra, xin, y, m, lane); nr_proc<HASY, HASH>(ra, g1, xout, g2, Hout, m, lane); }
    }
}

__device__ __forceinline__ void norm_first(const float* xin, bf16* XB, float* R2, int bid, int G, int wave, int lane) {
    for (int c = bid; c < MROWS / 32; c += G)
        for (int i = 0; i < 4; ++i) { const int m = 32 * c + wave + 8 * i;
            const f32x4* xr = (const f32x4*)(xin + (size_t)m * DM) + lane; f32x4 xv[4]; float ss = 0.f;
#pragma unroll
            for (int j = 0; j < 4; ++j) { xv[j] = xr[64 * j]; ss += (xv[j].x * xv[j].x + xv[j].y * xv[j].y) + (xv[j].z * xv[j].z + xv[j].w * xv[j].w); }
            const float r = 1.0f / sqrtf(wave_sum(ss) * (1.0f / DM) + 1e-6f);
            if (lane == 0) R2[m] = r;
            v2u* ho = (v2u*)(XB + (size_t)m * DM) + lane;
#pragma unroll
            for (int j = 0; j < 4; ++j) { v2u w; w.x = pk2(xv[j].x, xv[j].y); w.y = pk2(xv[j].z, xv[j].w); ho[64 * j] = w; }
        }
}
template <bool LAST, int NR>
__device__ __forceinline__ void norm_bf_rows(const bf16* XB, bf16* XO, const bf16* Yb, const f32x4 (&g)[2][2], float* R2, float* out, int m0, int ngw, int lane) {
    v4u xw[NR][2], yw[NR][2];
#pragma unroll
    for (int r = 0; r < NR; ++r)
#pragma unroll
        for (int j = 0; j < 2; ++j) { const size_t o = (size_t)(m0 + r * ngw) * DM + 8 * lane + 512 * j; xw[r][j] = *(const v4u*)(XB + o); yw[r][j] = *(const v4u*)(Yb + o); }
#pragma unroll
    for (int r = 0; r < NR; ++r) { const int m = m0 + r * ngw;
        float xv[2][8], yv[2][8]; float ss = 0.f;
#pragma unroll
        for (int j = 0; j < 2; ++j) {
            xv[j][0] = bflo(xw[r][j].x); xv[j][1] = bfhi(xw[r][j].x); xv[j][2] = bflo(xw[r][j].y); xv[j][3] = bfhi(xw[r][j].y); xv[j][4] = bflo(xw[r][j].z); xv[j][5] = bfhi(xw[r][j].z); xv[j][6] = bflo(xw[r][j].w); xv[j][7] = bfhi(xw[r][j].w);
            yv[j][0] = bflo(yw[r][j].x); yv[j][1] = bfhi(yw[r][j].x); yv[j][2] = bflo(yw[r][j].y); yv[j][3] = bfhi(yw[r][j].y); yv[j][4] = bflo(yw[r][j].z); yv[j][5] = bfhi(yw[r][j].z); yv[j][6] = bflo(yw[r][j].w); yv[j][7] = bfhi(yw[r][j].w);
#pragma unroll
            for (int e = 0; e < 8; ++e) ss += yv[j][e] * yv[j][e]; }
        const float rr = 1.0f / sqrtf(wave_sum(ss) * (1.0f / DM) + 1e-6f);
        float s2 = 0.f;
#pragma unroll
        for (int j = 0; j < 2; ++j)
#pragma unroll
            for (int e = 0; e < 8; ++e) { xv[j][e] = xv[j][e] + (yv[j][e] * rr) * g[j][e >> 2][e & 3]; s2 += xv[j][e] * xv[j][e]; }
        if (LAST) {
#pragma unroll
            for (int j = 0; j < 2; ++j) { f32x4* op = (f32x4*)(out + (size_t)m * DM + 8 * lane + 512 * j); op[0] = (f32x4){xv[j][0], xv[j][1], xv[j][2], xv[j][3]}; op[1] = (f32x4){xv[j][4], xv[j][5], xv[j][6], xv[j][7]}; }
        } else {
            const float r2 = 1.0f / sqrtf(wave_sum(s2) * (1.0f / DM) + 1e-6f);
            if (lane == 0) R2[m] = r2;
#pragma unroll
            for (int j = 0; j < 2; ++j) { v4u w; w.x = pk2(xv[j][0], xv[j][1]); w.y = pk2(xv[j][2], xv[j][3]); w.z = pk2(xv[j][4], xv[j][5]); w.w = pk2(xv[j][6], xv[j][7]);
                *(v4u*)(XO + (size_t)m * DM + 8 * lane + 512 * j) = w; }
        }
    }
}
template <bool LAST>
__device__ __forceinline__ void norm_bf(const bf16* XB, bf16* XO, const bf16* Yb, const float* g1, float* R2, float* out, int bid, int G, int wave, int lane) {
    f32x4 g[2][2];
#pragma unroll
    for (int j = 0; j < 2; ++j) { g[j][0] = *(const f32x4*)(g1 + 8 * lane + 512 * j); g[j][1] = *(const f32x4*)(g1 + 8 * lane + 512 * j + 4); }
    for (int c = bid; c < MROWS / 32; c += G) norm_bf_rows<LAST, 4>(XB, XO, Yb, g, R2, out, 32 * c + wave, 8, lane);
}

__device__ __forceinline__ void mixer_a(ArgP A, int l, int item, LAS unsigned char* lds, int tid, int wave, int lane) {
    const bf16* Z = (const bf16*)(A->ws + WS_Z); bf16* MIX = (bf16*)(A->ws + WS_MIX);
    const bf16* sgw = (const bf16*)(A->ws + WS_W + (size_t)l * WS_WL + WO_SG);
    const int b = item >> 4, ch = item & 15; const size_t r0 = (size_t)b * SEQ + 128 * ch;
    LAS bf16* VT = (LAS bf16*)lds;
    LAS float* ST = (LAS float*)(lds + 69632);
    { const int s = tid >> 2, qd = tid & 3; float sm = 0.f, sq = 0.f;
#pragma unroll
        for (int i = 0; i < 8; ++i) { const v4u w = *(const v4u*)ZP(Z, r0 + s, ZC_AV + 64 * qd + 8 * i);
            const float a0 = bflo(w.x), a1 = bfhi(w.x), a2 = bflo(w.y), a3 = bfhi(w.y), a4 = bflo(w.z), a5 = bfhi(w.z), a6 = bflo(w.w), a7 = bfhi(w.w);
            sm += ((a0 + a1) + (a2 + a3)) + ((a4 + a5) + (a6 + a7)); sq += ((a0 * a0 + a1 * a1) + (a2 * a2 + a3 * a3)) + ((a4 * a4 + a5 * a5) + (a6 * a6 + a7 * a7)); }
        sm += __shfl_xor(sm, 1); sq += __shfl_xor(sq, 1); sm += __shfl_xor(sm, 2); sq += __shfl_xor(sq, 2);
        const float mu = sm * (1.0f / 256.0f), var = fmaxf(sq * (1.0f / 256.0f) - mu * mu, 0.f);
        if (qd == 0) { ST[2 * s] = mu; ST[2 * s + 1] = 1.0f / sqrtf(var + 1e-5f); } }
    __syncthreads();
    { const int s = tid & 127, og = tid >> 7; const float mu = ST[2 * s], rs = ST[2 * s + 1];
        const float* gp = A->in[I_SGLN] + l * 256;
#pragma unroll
        for (int i = 0; i < 8; ++i) { const int oct = og + 4 * i;
            const v4u w = *(const v4u*)ZP(Z, r0 + s, ZC_AV + 8 * oct);
            const f32x4 g0 = *(const f32x4*)(gp + 8 * oct), g1 = *(const f32x4*)(gp + 8 * oct + 4);
            LAS bf16* vp = VT + (8 * oct) * 136 + s;
            vp[0 * 136] = (bf16)f2bf((bflo(w.x) - mu) * rs * g0.x); vp[1 * 136] = (bf16)f2bf((bfhi(w.x) - mu) * rs * g0.y);
            vp[2 * 136] = (bf16)f2bf((bflo(w.y) - mu) * rs * g0.z); vp[3 * 136] = (bf16)f2bf((bfhi(w.y) - mu) * rs * g0.w);
            vp[4 * 136] = (bf16)f2bf((bflo(w.z) - mu) * rs * g1.x); vp[5 * 136] = (bf16)f2bf((bfhi(w.z) - mu) * rs * g1.y);
            vp[6 * 136] = (bf16)f2bf((bflo(w.w) - mu) * rs * g1.z); vp[7 * 136] = (bf16)f2bf((bfhi(w.w) - mu) * rs * g1.w); } }
    __syncthreads();
    const int h = wave >> 1, th = wave & 1, fr = lane & 15, q = lane >> 4;
    f32x4 acc[4][4];
#pragma unroll
    for (int a = 0; a < 4; ++a)
#pragma unroll
        for (int c = 0; c < 4; ++c) acc[a][c] = (f32x4){0.f, 0.f, 0.f, 0.f};
    const bf16* Wb = sgw + (size_t)h * 128 * 128;
    v2u uwv[4][4]; float sgbv[4];
#pragma unroll
    for (int mt = 0; mt < 4; ++mt) { const int t = 64 * th + 16 * mt + fr; sgbv[mt] = A->in[I_SGB][l * 512 + h * 128 + t];
#pragma unroll
        for (int nt = 0; nt < 4; ++nt) uwv[mt][nt] = *(const v2u*)ZP(Z, r0 + t, ZC_AU + 64 * h + 16 * nt + 4 * q); }
#pragma unroll
    for (int ks = 0; ks < 4; ++ks) {
        v4u vf[4];
#pragma unroll
        for (int nt = 0; nt < 4; ++nt) vf[nt] = *(const LAS v4u*)(VT + (64 * h + 16 * nt + fr) * 136 + 32 * ks + 8 * q);
#pragma unroll
        for (int mt = 0; mt < 4; ++mt) { const int t = 64 * th + 16 * mt + fr; const v4u wf = *(const v4u*)(Wb + t * 128 + 32 * ks + 8 * q);
#pragma unroll
            for (int nt = 0; nt < 4; ++nt) acc[mt][nt] = mfma16(vf[nt], wf, acc[mt][nt]); }
    }
#pragma unroll
    for (int mt = 0; mt < 4; ++mt) { const int t = 64 * th + 16 * mt + fr; const float bias = sgbv[mt];
#pragma unroll
        for (int nt = 0; nt < 4; ++nt) { const int d0 = 64 * h + 16 * nt + 4 * q;
            const v2u uw = uwv[mt][nt]; const f32x4 a = acc[mt][nt];
            v2u o; o.x = pk2(bflo(uw.x) * (a.x + bias), bfhi(uw.x) * (a.y + bias)); o.y = pk2(bflo(uw.y) * (a.z + bias), bfhi(uw.y) * (a.w + bias));
            *(v2u*)(MIX + (r0 + t) * DM + d0) = o; } }
    __syncthreads();
}

__device__ __forceinline__ void mixer_b(ArgP A, int l, int item, LAS unsigned char* lds, int tid, int wave, int lane) {
    const bf16* Z = (const bf16*)(A->ws + WS_Z); bf16* MIX = (bf16*)(A->ws + WS_MIX);
    const bf16* pwt = (const bf16*)(A->ws + WS_W + (size_t)l * WS_WL + WO_PW);
    const int b = item >> 5, tau = item & 31, t0 = 64 * tau; const size_t r0 = (size_t)b * SEQ + t0;
    LAS bf16* Ht = (LAS bf16*)lds;
    LAS float* CO = (LAS float*)(lds + 49152);
    LAS bf16* AT = (LAS bf16*)lds;
    float wt[31];
#pragma unroll
    for (int w = 0; w < 31; ++w) wt[w] = A->in[I_CVW][(size_t)l * 31 * 256 + w * 256 + (tid & 255)];
    const float bias = A->in[I_CVB][l * 256 + (tid & 255)];
    {
        v4u av[6], gv[6];
#pragma unroll
        for (int it_ = 0; it_ < 6; ++it_) { int idx = tid + it_ * NTHREADS; idx = idx < 94 * 32 ? idx : 94 * 32 - 1; const int i = idx >> 5, oct = idx & 31, t = t0 - 30 + i;
            const size_t zr = (size_t)b * SEQ + (t > 0 ? t : 0); av[it_] = *(const v4u*)ZP(Z, zr, ZC_BA + 8 * oct); gv[it_] = *(const v4u*)ZP(Z, zr, ZC_BG + 8 * oct); }
#pragma unroll
        for (int it_ = 0; it_ < 6; ++it_) { const int idx = tid + it_ * NTHREADS; if (idx < 94 * 32) { const int i = idx >> 5, oct = idx & 31, t = t0 - 30 + i; v4u o = (v4u){0u, 0u, 0u, 0u};
                if (t >= 0) { const v4u a = av[it_], g = gv[it_];
                    o.x = pk2(bflo(a.x) * sigmoidf_(bflo(g.x)), bfhi(a.x) * sigmoidf_(bfhi(g.x))); o.y = pk2(bflo(a.y) * sigmoidf_(bflo(g.y)), bfhi(a.y) * sigmoidf_(bfhi(g.y)));
                    o.z = pk2(bflo(a.z) * sigmoidf_(bflo(g.z)), bfhi(a.z) * sigmoidf_(bfhi(g.z))); o.w = pk2(bflo(a.w) * sigmoidf_(bflo(g.w)), bfhi(a.w) * sigmoidf_(bfhi(g.w))); }
                *(LAS v4u*)(Ht + i * 256 + 8 * oct) = o; } }
    }
    __syncthreads();
    { const int c = tid & 255, half = tid >> 8;
#pragma unroll 1
        for (int tg = 0; tg < 4; ++tg) { const int tb = 32 * half + 8 * tg; float ac[8];
#pragma unroll
            for (int j = 0; j < 8; ++j) ac[j] = bias;
#pragma unroll
            for (int i = 0; i < 38; ++i) { const float hv = bf2f(Ht[(tb + i) * 256 + c]);
#pragma unroll
                for (int j = 0; j < 8; ++j) if (i - j >= 0 && i - j < 31) ac[j] += hv * wt[i - j]; }
#pragma unroll
            for (int j = 0; j < 8; ++j) CO[(tb + j) * 256 + c] = ac[j]; } }
    __syncthreads();
    v4u bpf[8][2];
#pragma unroll
    for (int ks = 0; ks < 8; ++ks)
#pragma unroll
        for (int nt = 0; nt < 2; ++nt) bpf[ks][nt] = *(const v4u*)(pwt + (32 * wave + 16 * nt + (lane & 15)) * 256 + 32 * ks + 8 * (lane >> 4));
    { const f32x4 g = *(const f32x4*)(A->in[I_CVLG] + l * 256 + 4 * lane), bb = *(const f32x4*)(A->in[I_CVLB] + l * 256 + 4 * lane);
#if MIXB_LNNEW
        f32x4 v[8]; float sm[8];
#pragma unroll
        for (int i = 0; i < 8; ++i) { v[i] = *(const LAS f32x4*)(CO + (8 * wave + i) * 256 + 4 * lane); sm[i] = (v[i].x + v[i].y) + (v[i].z + v[i].w); }
#pragma unroll
        for (int o = 1; o < 64; o <<= 1)
#pragma unroll
            for (int i = 0; i < 8; ++i) sm[i] += __shfl_xor(sm[i], o);
#pragma unroll
        for (int i = 0; i < 8; ++i) { v[i] = v[i] - sm[i] * (1.0f / 256.0f); sm[i] = (v[i].x * v[i].x + v[i].y * v[i].y) + (v[i].z * v[i].z + v[i].w * v[i].w); }
#pragma unroll
        for (int o = 1; o < 64; o <<= 1)
#pragma unroll
            for (int i = 0; i < 8; ++i) sm[i] += __shfl_xor(sm[i], o);
#pragma unroll
        for (int i = 0; i < 8; ++i) { const float rs = 1.0f / sqrtf(sm[i] * (1.0f / 256.0f) + 1e-5f);
            const f32x4 y = (v[i] * rs) * g + bb; v2u o; o.x = pk2(siluf_(y.x), siluf_(y.y)); o.y = pk2(siluf_(y.z), siluf_(y.w));
            *(LAS v2u*)(AT + (8 * wave + i) * 264 + 4 * lane) = o; } }
#else
        for (int i = 0; i < 8; ++i) { const int t = 8 * wave + i; const f32x4 v = *(const LAS f32x4*)(CO + t * 256 + 4 * lane);
            const float mu = wave_sum((v.x + v.y) + (v.z + v.w)) * (1.0f / 256.0f); const f32x4 d = v - mu;
            const float var = wave_sum((d.x * d.x + d.y * d.y) + (d.z * d.z + d.w * d.w)) * (1.0f / 256.0f); const float rs = 1.0f / sqrtf(var + 1e-5f);
            const f32x4 y = (d * rs) * g + bb; v2u o; o.x = pk2(siluf_(y.x), siluf_(y.y)); o.y = pk2(siluf_(y.z), siluf_(y.w));
            *(LAS v2u*)(AT + t * 264 + 4 * lane) = o; } }
#endif
    __syncthreads();
    const int fr = lane & 15, q = lane >> 4;
    f32x4 acc[4][2];
#pragma unroll
    for (int a = 0; a < 4; ++a)
#pragma unroll
        for (int c = 0; c < 2; ++c) acc[a][c] = (f32x4){0.f, 0.f, 0.f, 0.f};
#pragma unroll
    for (int ks = 0; ks < 8; ++ks) {
#pragma unroll
        for (int mt = 0; mt < 4; ++mt) { const v4u af = *(const LAS v4u*)(AT + (16 * mt + fr) * 264 + 32 * ks + 8 * q);
#pragma unroll
            for (int nt = 0; nt < 2; ++nt) acc[mt][nt] = mfma16(bpf[ks][nt], af, acc[mt][nt]); } }
#pragma unroll
    for (int mt = 0; mt < 4; ++mt)
#pragma unroll
        for (int nt = 0; nt < 2; ++nt) { const int n0 = 32 * wave + 16 * nt + 4 * q; const f32x4 pb = *(const f32x4*)(A->in[I_CVPB] + l * 256 + n0); const f32x4 o = acc[mt][nt] + pb;
            v2u w; w.x = pk2(o.x, o.y); w.y = pk2(o.z, o.w); *(v2u*)(MIX + (r0 + 16 * mt + fr) * DM + 256 + n0) = w; }
    __syncthreads();
}

template <int W>
__device__ __forceinline__ void pool_means(const LAS bf16* Xt, LAS bf16* AT, int c, int half, int t0) {
    float xv[47];
#pragma unroll
    for (int i = 0; i < 47; ++i) xv[i] = (i >= 16 - W) ? bf2f(Xt[(32 * half + i) * 256 + c]) : 0.f;
    float s = 0.f;
#pragma unroll
    for (int i = 0; i < W; ++i) s += xv[15 - i];
#pragma unroll
    for (int j = 0; j < 32; ++j) { const int jj = 32 * half + j, t = t0 + jj;
        if (j > 0) s += xv[15 + j] - xv[15 + j - W];
        const int cnt = (t + 1 < W) ? (t + 1) : W;
        AT[jj * 264 + c] = (bf16)f2bf(s / (float)cnt - xv[15 + j]); }
}

__device__ __forceinline__ void mixer_d(ArgP A, int l, int item, LAS unsigned char* lds, int tid, int wave, int lane) {
    const bf16* Z = (const bf16*)(A->ws + WS_Z); bf16* MIX = (bf16*)(A->ws + WS_MIX);
    const bf16* poolt = (const bf16*)(A->ws + WS_W + (size_t)l * WS_WL + WO_POOL);
    bf16* VTS = (bf16*)(A->ws + WS_VTS); bf16* VTW = (bf16*)(A->ws + WS_VTW);
    const int b = item >> 5, tau = item & 31, t0 = 64 * tau; const size_t r0 = (size_t)b * SEQ + t0;
    LAS bf16* Xt = (LAS bf16*)lds;
    LAS bf16* AT = (LAS bf16*)(lds + 40960);
    LAS bf16* TS = (LAS bf16*)(lds + 75776);
    v4u pbf[2][2];
#pragma unroll
    for (int ks = 0; ks < 2; ++ks)
#pragma unroll
        for (int nt = 0; nt < 2; ++nt) pbf[ks][nt] = *(const v4u*)(poolt + (wave >> 1) * 4096 + (32 * (wave & 1) + 16 * nt + (lane & 15)) * 64 + 32 * ks + 8 * (lane >> 4));
    {
        v4u xv[5];
#pragma unroll
        for (int it_ = 0; it_ < 5; ++it_) { int idx = tid + it_ * NTHREADS; idx = idx < 79 * 32 ? idx : 79 * 32 - 1; const int i = idx >> 5, oct = idx & 31, t = t0 - 15 + i;
            xv[it_] = *(const v4u*)ZP(Z, (size_t)b * SEQ + (t > 0 ? t : 0), ZC_D + 8 * oct); }
#pragma unroll
        for (int it_ = 0; it_ < 5; ++it_) { const int idx = tid + it_ * NTHREADS; if (idx < 79 * 32) { const int i = idx >> 5, oct = idx & 31, t = t0 - 15 + i;
                *(LAS v4u*)(Xt + i * 256 + 8 * oct) = (t >= 0) ? xv[it_] : (v4u){0u, 0u, 0u, 0u}; } }
    }
    { const int tok = tid & 63, oct = tid >> 6;
        const v4u a = *(const v4u*)ZP(Z, r0 + tok, ZC_VS + 8 * oct), c = *(const v4u*)ZP(Z, r0 + tok, ZC_VW + 8 * oct);
        LAS bf16* p0 = TS + (8 * oct) * 72 + tok; LAS bf16* p1 = p0 + 4608;
        p0[0] = (bf16)(a.x & 0xffffu); p0[72] = (bf16)(a.x >> 16); p0[144] = (bf16)(a.y & 0xffffu); p0[216] = (bf16)(a.y >> 16);
        p0[288] = (bf16)(a.z & 0xffffu); p0[360] = (bf16)(a.z >> 16); p0[432] = (bf16)(a.w & 0xffffu); p0[504] = (bf16)(a.w >> 16);
        p1[0] = (bf16)(c.x & 0xffffu); p1[72] = (bf16)(c.x >> 16); p1[144] = (bf16)(c.y & 0xffffu); p1[216] = (bf16)(c.y >> 16);
        p1[288] = (bf16)(c.z & 0xffffu); p1[360] = (bf16)(c.z >> 16); p1[432] = (bf16)(c.w & 0xffffu); p1[504] = (bf16)(c.w >> 16); }
    __syncthreads();
#if MIXD_NEW
    { const int c = tid & 255, half = tid >> 8, g = c >> 6;
        if (g == 0) pool_means<2>(Xt, AT, c, half, t0); else if (g == 1) pool_means<4>(Xt, AT, c, half, t0); else if (g == 2) pool_means<8>(Xt, AT, c, half, t0); else pool_means<16>(Xt, AT, c, half, t0); }
#else
    { const int c = tid & 255, half = tid >> 8, g = c >> 6, w = 2 << g;
        for (int j = 0; j < 32; ++j) { const int jj = 32 * half + j, t = t0 + jj; float s = 0.f;
            for (int i = 0; i < w; ++i) s += bf2f(Xt[(15 + jj - i) * 256 + c]);
            const int cnt = (t + 1 < w) ? (t + 1) : w;
            const float mval = s / (float)cnt - bf2f(Xt[(15 + jj) * 256 + c]);
            AT[jj * 264 + c] = (bf16)f2bf(mval); } }
#endif
    { const int d = tid >> 3, pc = tid & 7;
        *(v4u*)(VTS + ((size_t)b * 64 + d) * SEQ + t0 + 8 * pc) = *(const LAS v4u*)(TS + d * 72 + 8 * pc);
        *(v4u*)(VTW + ((size_t)b * 64 + d) * SEQ + t0 + 8 * pc) = *(const LAS v4u*)(TS + 4608 + d * 72 + 8 * pc); }
    __syncthreads();
    const int fr = lane & 15, q = lane >> 4, g = wave >> 1, nh = wave & 1;
    f32x4 acc[4][2];
#pragma unroll
    for (int a = 0; a < 4; ++a)
#pragma unroll
        for (int c = 0; c < 2; ++c) acc[a][c] = (f32x4){0.f, 0.f, 0.f, 0.f};
#pragma unroll
    for (int ks = 0; ks < 2; ++ks) {
#pragma unroll
        for (int mt = 0; mt < 4; ++mt) { const v4u af = *(const LAS v4u*)(AT + (16 * mt + fr) * 264 + 64 * g + 32 * ks + 8 * q);
#pragma unroll
            for (int nt = 0; nt < 2; ++nt) acc[mt][nt] = mfma16(pbf[ks][nt], af, acc[mt][nt]); } }
#pragma unroll
    for (int mt = 0; mt < 4; ++mt)
#pragma unroll
        for (int nt = 0; nt < 2; ++nt) { const int n0 = 64 * g + 32 * nh + 16 * nt + 4 * q; const f32x4 sc = *(const f32x4*)(A->in[I_POOLS] + l * 256 + n0); const f32x4 o = acc[mt][nt] * sc;
            v2u w; w.x = pk2(o.x, o.y); w.y = pk2(o.z, o.w); *(v2u*)(MIX + (r0 + 16 * mt + fr) * DM + 768 + n0) = w; }
    __syncthreads();
}

__device__ __forceinline__ void nsa_compress(ArgP A, int l, int item, LAS unsigned char* lds, int tid, int wave, int lane) {
    const bf16* Z = (const bf16*)(A->ws + WS_Z);
    bf16* KC = (bf16*)(A->ws + WS_KC); bf16* VCT = (bf16*)(A->ws + WS_VCT);
    const int b = item >> 4, kv = (item >> 3) & 1, mt = item & 7;
    const int colb = kv ? ZC_VC : ZC_KC;
    const float* pos = A->in[kv ? I_POSV : I_POSK] + l * 2048;
    const bf16* w1t = (const bf16*)(A->ws + WS_W + (size_t)l * WS_WL + (kv ? WO_W1V : WO_W1K));
    const float* w2 = A->in[kv ? I_W2V : I_W2K] + l * 4096;
    LAS float* RED = (LAS float*)lds;
    LAS float* H1 = (LAS float*)(lds + 32768);
    const int fr = lane & 15, q = lane >> 4, c = 16 * mt + fr; const bool cok = c < 127;
    f32x4 acc[4];
#pragma unroll
    for (int n = 0; n < 4; ++n) acc[n] = (f32x4){0.f, 0.f, 0.f, 0.f};
#pragma unroll 4
    for (int kk = 0; kk < 8; ++kk) { const int ks = 8 * wave + kk, ltok = ks >> 1, dd = 32 * (ks & 1) + 8 * q;
        v4u af = (v4u){0u, 0u, 0u, 0u};
        if (cok) { const v4u zw = *(const v4u*)ZP(Z, (size_t)b * SEQ + 16 * c + ltok, colb + dd);
            const f32x4 p0 = *(const f32x4*)(pos + ltok * 64 + dd), p1 = *(const f32x4*)(pos + ltok * 64 + dd + 4);
            af.x = pk2(bflo(zw.x) + p0.x, bfhi(zw.x) + p0.y); af.y = pk2(bflo(zw.y) + p0.z, bfhi(zw.y) + p0.w);
            af.z = pk2(bflo(zw.z) + p1.x, bfhi(zw.z) + p1.y); af.w = pk2(bflo(zw.w) + p1.z, bfhi(zw.w) + p1.w); }
#pragma unroll
        for (int nt = 0; nt < 4; ++nt) { const v4u bfr = *(const v4u*)(w1t + (16 * nt + fr) * 2048 + 32 * ks + 8 * q); acc[nt] = mfma16(af, bfr, acc[nt]); } }
#pragma unroll
    for (int nt = 0; nt < 4; ++nt)
#pragma unroll
        for (int rg = 0; rg < 4; ++rg) RED[(wave * 16 + 4 * q + rg) * 64 + 16 * nt + fr] = acc[nt][rg];
    __syncthreads();
#pragma unroll
    for (int x = 0; x < 2; ++x) { const int o = tid + 512 * x, cc = o >> 6, n = o & 63; float s = 0.f;
#pragma unroll
        for (int w = 0; w < 8; ++w) s += RED[(w * 16 + cc) * 64 + n];
        H1[o] = siluf_(s); }
    __syncthreads();
#pragma unroll
    for (int x = 0; x < 2; ++x) { const int o = tid + 512 * x, cc = o >> 6, n2 = o & 63; float s = 0.f;
        for (int n = 0; n < 64; ++n) s += H1[cc * 64 + n] * w2[n * 64 + n2];
        const int cg_ = 16 * mt + cc;
        (kv == 0 ? KC : VCT)[((size_t)b * 128 + cg_) * 64 + n2] = (bf16)f2bf(s); }
    __syncthreads();
}

template <int HA, int HB, class MaskA, class MaskB>
__device__ __forceinline__ void attn_pair(const LAS bf16* KT, const LAS bf16* VT, const v4u (&qf)[2], int fr, int q, float& m_run, f32x4& o5, f32x4 (&o)[4],
                                          float rba, float rbb, bool ma, bool mb, MaskA okA, MaskB okB) {
    constexpr int N0 = HA ? 0 : 4, N1 = HB ? 8 : 4, K0 = HA ? 0 : 2, K1 = HB ? 4 : 2;
    v4u kf0[8], kf1[8];
#pragma unroll
    for (int nt = N0; nt < N1; ++nt) { kf0[nt] = *(const LAS v4u*)(KT + (16 * nt + fr) * 72 + 8 * q); kf1[nt] = *(const LAS v4u*)(KT + (16 * nt + fr) * 72 + 32 + 8 * q); }
    __builtin_amdgcn_sched_barrier(0);
    f32x4 s[8];
#pragma unroll
    for (int nt = N0; nt < N1; ++nt) { const float rb = nt < 4 ? rba : rbb;
        s[nt] = mfma16(kf0[nt], qf[0], (f32x4){rb, rb, rb, rb}); s[nt] = mfma16(kf1[nt], qf[1], s[nt]); }
    __builtin_amdgcn_sched_barrier(0);
    v2u vfa[4][4], vfb[4][4];
#pragma unroll
    for (int k2 = K0; k2 < K1; ++k2)
#pragma unroll
        for (int dt = 0; dt < 4; ++dt) { vfa[k2][dt] = *(const LAS v2u*)(VT + (16 * dt + fr) * 136 + 32 * k2 + 4 * q); vfb[k2][dt] = *(const LAS v2u*)(VT + (16 * dt + fr) * 136 + 32 * k2 + 16 + 4 * q); }
    __builtin_amdgcn_sched_barrier(0);
    if (HA && ma) {
#pragma unroll
        for (int nt = 0; nt < 4; ++nt)
#pragma unroll
            for (int rg = 0; rg < 4; ++rg) s[nt][rg] = okA(16 * nt + 4 * q + rg) ? s[nt][rg] : -1e30f; }
    if (HB && mb) {
#pragma unroll
        for (int nt = 0; nt < 4; ++nt)
#pragma unroll
            for (int rg = 0; rg < 4; ++rg) s[4 + nt][rg] = okB(16 * nt + 4 * q + rg) ? s[4 + nt][rg] : -1e30f; }
    float mx = m_run;
#pragma unroll
    for (int nt = N0; nt < N1; ++nt)
#pragma unroll
        for (int rg = 0; rg < 4; ++rg) mx = fmaxf(mx, s[nt][rg]);
    mx = fmaxf(mx, __shfl_xor(mx, 16)); mx = fmaxf(mx, __shfl_xor(mx, 32));
    if (__ballot(mx != m_run) != 0ull) {
        const float sc = __builtin_amdgcn_exp2f(m_run - mx); m_run = mx; o5 = o5 * sc;
#pragma unroll
        for (int dt = 0; dt < 4; ++dt) o[dt] = o[dt] * sc; }
#pragma unroll
    for (int nt = N0; nt < N1; ++nt)
#pragma unroll
        for (int rg = 0; rg < 4; ++rg) s[nt][rg] = __builtin_amdgcn_exp2f(s[nt][rg] - mx);
    const unsigned onesw = (fr == 0) ? 0x3f803f80u : 0u; const v4u vones = (v4u){onesw, onesw, onesw, onesw};
#pragma unroll
    for (int k2 = K0; k2 < K1; ++k2) { v4u pf; pf.x = pk2(s[2 * k2][0], s[2 * k2][1]); pf.y = pk2(s[2 * k2][2], s[2 * k2][3]); pf.z = pk2(s[2 * k2 + 1][0], s[2 * k2 + 1][1]); pf.w = pk2(s[2 * k2 + 1][2], s[2 * k2 + 1][3]);
        o5 = mfma16(vones, pf, o5);
#pragma unroll
        for (int dt = 0; dt < 4; ++dt) { v4u vf; vf.x = vfa[k2][dt].x; vf.y = vfa[k2][dt].y; vf.z = vfb[k2][dt].x; vf.w = vfb[k2][dt].y; o[dt] = mfma16(vf, pf, o[dt]); } }
}

template <class MaskF>
__device__ __forceinline__ void attn_tile2(const LAS bf16* KT, const LAS bf16* VT, const v4u (&qf)[2][2], int fr, int q, float (&m_run)[2], f32x4 (&o5)[2], f32x4 (&o)[2][4],
                                           const bool (&need)[2], const float (&rb)[2], bool masked, MaskF okf) {
    v4u kf0[4], kf1[4];
#pragma unroll
    for (int nt = 0; nt < 4; ++nt) { kf0[nt] = *(const LAS v4u*)(KT + (16 * nt + fr) * 72 + 8 * q); kf1[nt] = *(const LAS v4u*)(KT + (16 * nt + fr) * 72 + 32 + 8 * q); }
    __builtin_amdgcn_sched_barrier(0);
    f32x4 s[2][4];
#pragma unroll
    for (int g = 0; g < 2; ++g) if (need[g]) {
#pragma unroll
        for (int nt = 0; nt < 4; ++nt) { s[g][nt] = mfma16(kf0[nt], qf[g][0], (f32x4){rb[g], rb[g], rb[g], rb[g]}); s[g][nt] = mfma16(kf1[nt], qf[g][1], s[g][nt]); } }
    __builtin_amdgcn_sched_barrier(0);
    v2u vfa[2][4], vfb[2][4];
#pragma unroll
    for (int k2 = 0; k2 < 2; ++k2)
#pragma unroll
        for (int dt = 0; dt < 4; ++dt) { vfa[k2][dt] = *(const LAS v2u*)(VT + (16 * dt + fr) * 72 + 32 * k2 + 4 * q); vfb[k2][dt] = *(const LAS v2u*)(VT + (16 * dt + fr) * 72 + 32 * k2 + 16 + 4 * q); }
    __builtin_amdgcn_sched_barrier(0);
    const unsigned onesw = (fr == 0) ? 0x3f803f80u : 0u; const v4u vones = (v4u){onesw, onesw, onesw, onesw};
#pragma unroll
    for (int g = 0; g < 2; ++g) if (need[g]) {
        if (masked) {
#pragma unroll
            for (int nt = 0; nt < 4; ++nt)
#pragma unroll
                for (int rg = 0; rg < 4; ++rg) s[g][nt][rg] = okf(g, 16 * nt + 4 * q + rg) ? s[g][nt][rg] : -1e30f; }
        float mx = m_run[g];
#pragma unroll
        for (int nt = 0; nt < 4; ++nt)
#pragma unroll
            for (int rg = 0; rg < 4; ++rg) mx = fmaxf(mx, s[g][nt][rg]);
        mx = fmaxf(mx, __shfl_xor(mx, 16)); mx = fmaxf(mx, __shfl_xor(mx, 32));
        if (__ballot(mx != m_run[g]) != 0ull) { const float sc = __builtin_amdgcn_exp2f(m_run[g] - mx); m_run[g] = mx; o5[g] = o5[g] * sc;
#pragma unroll
            for (int dt = 0; dt < 4; ++dt) o[g][dt] = o[g][dt] * sc; }
#pragma unroll
        for (int nt = 0; nt < 4; ++nt)
#pragma unroll
            for (int rg = 0; rg < 4; ++rg) s[g][nt][rg] = __builtin_amdgcn_exp2f(s[g][nt][rg] - mx);
#pragma unroll
        for (int k2 = 0; k2 < 2; ++k2) { v4u pf; pf.x = pk2(s[g][2 * k2][0], s[g][2 * k2][1]); pf.y = pk2(s[g][2 * k2][2], s[g][2 * k2][3]); pf.z = pk2(s[g][2 * k2 + 1][0], s[g][2 * k2 + 1][1]); pf.w = pk2(s[g][2 * k2 + 1][2], s[g][2 * k2 + 1][3]);
            o5[g] = mfma16(vones, pf, o5[g]);
#pragma unroll
            for (int dt = 0; dt < 4; ++dt) { v4u vf; vf.x = vfa[k2][dt].x; vf.y = vfa[k2][dt].y; vf.z = vfb[k2][dt].x; vf.w = vfb[k2][dt].y; o[g][dt] = mfma16(vf, pf, o[g][dt]); } } }
}

__device__ __forceinline__ void nsa_attn(ArgP A, int l, int item, LAS unsigned char* lds, int tid, int wave, int lane) {
#define Z ((const bf16*)(A->ws + WS_Z))
#define MIX ((bf16*)(A->ws + WS_MIX))
#define VTS ((const bf16*)(A->ws + WS_VTS))
#define VTW ((const bf16*)(A->ws + WS_VTW))
#define KC ((const bf16*)(A->ws + WS_KC))
#define VCT ((const bf16*)(A->ws + WS_VCT))
    const int jq = item >> 8, ib = item & 255, b = 2 * (ib & 7) + ((ib >> 3) & 1), a = ib >> 4;
    const int tau = jq ? 31 - a : a;
    const int t0 = 64 * tau, curb = tau, wlo = (tau >= 8) ? tau - 8 : 0;
    LAS bf16* KT = (LAS bf16*)lds; LAS bf16* VT = KT + 9216;
    LAS bf16* TB = (LAS bf16*)(lds + 35840);
    LAS float* PS = (LAS float*)(lds + 72704) + wave * (16 * 132);
    LAS float* IMP = (LAS float*)(lds + 140288) + wave * 128;
    LAS unsigned* WANY = (LAS unsigned*)(lds + 144384);
    const int fr = lane & 15, q = lane >> 4, tt = fr >> 2, hh = fr & 3;
    const int skey = tid >> 3, spc = tid & 7;
    const size_t krow = (size_t)b * SEQ + skey;
#define KADDR(j, col) ZP(Z, krow + 64 * (j), (col) + 8 * spc)
    const size_t vbase = ((size_t)b * 64 + skey) * SEQ + 8 * spc;
    v4u kr = *(const v4u*)KADDR(0, ZC_KS), vr = *(const v4u*)(VTS + vbase);
    int tq[2]; size_t grow[2]; v4u qf[2][2]; float g0[2], g1[2], g2[2];
#pragma unroll
    for (int g = 0; g < 2; ++g) { tq[g] = t0 + 8 * wave + 4 * g + tt; grow[g] = (size_t)b * SEQ + tq[g];
#pragma unroll
        for (int ks = 0; ks < 2; ++ks) { const v4u w = *(const v4u*)ZP(Z, grow[g], ZC_Q + 64 * hh + 32 * ks + 8 * q);
            const float qs = 0.125f * 1.4426950408889634f;
            qf[g][ks].x = pk2(bflo(w.x) * qs, bfhi(w.x) * qs); qf[g][ks].y = pk2(bflo(w.y) * qs, bfhi(w.y) * qs);
            qf[g][ks].z = pk2(bflo(w.z) * qs, bfhi(w.z) * qs); qf[g][ks].w = pk2(bflo(w.w) * qs, bfhi(w.w) * qs); }
        g0[g] = sigmoidf_(bf2f(*ZP(Z, grow[g], ZC_G + 3 * hh + 0))); g1[g] = sigmoidf_(bf2f(*ZP(Z, grow[g], ZC_G + 3 * hh + 1))); g2[g] = sigmoidf_(bf2f(*ZP(Z, grow[g], ZC_G + 3 * hh + 2))); }
#pragma unroll
    for (int x = 0; x < 2; ++x) { const int pi = tid + 512 * x;
        { const int c = pi >> 3, pc = pi & 7; *(LAS v4u*)(KT + c * 72 + 8 * pc) = *(const v4u*)(KC + ((size_t)b * 128 + c) * 64 + 8 * pc); }
        { const int c = pi >> 3, pc = pi & 7; const v4u w = *(const v4u*)(VCT + ((size_t)b * 128 + c) * 64 + 8 * pc); LAS bf16* vp = VT + (8 * pc) * 136 + c;
            vp[0] = (bf16)(w.x & 0xffffu); vp[136] = (bf16)(w.x >> 16); vp[272] = (bf16)(w.y & 0xffffu); vp[408] = (bf16)(w.y >> 16);
            vp[544] = (bf16)(w.z & 0xffffu); vp[680] = (bf16)(w.z >> 16); vp[816] = (bf16)(w.w & 0xffffu); vp[952] = (bf16)(w.w >> 16); } }
    __syncthreads();
    f32x4 facc[2][4];
    unsigned msk[2], wny[2];
#pragma unroll 1
    for (int g = 0; g < 2; ++g) {
        const int t = t0 + 8 * wave + 4 * g + tt;
        const v4u q0 = g ? qf[1][0] : qf[0][0], q1 = g ? qf[1][1] : qf[0][1];
        f32x4 s[8];
#pragma unroll
        for (int nt = 0; nt < 8; ++nt) { const v4u k0 = *(const LAS v4u*)(KT + (16 * nt + fr) * 72 + 8 * q), k1 = *(const LAS v4u*)(KT + (16 * nt + fr) * 72 + 32 + 8 * q);
            s[nt] = mfma16(k0, q0, (f32x4){0.f, 0.f, 0.f, 0.f}); s[nt] = mfma16(k1, q1, s[nt]); }
        float mx = -1e30f;
#pragma unroll
        for (int nt = 0; nt < 8; ++nt)
#pragma unroll
            for (int rg = 0; rg < 4; ++rg) { const int c = 16 * nt + 4 * q + rg; const float v = (16 * c + 31 <= t) ? s[nt][rg] : -1e30f; s[nt][rg] = v; mx = fmaxf(mx, v); }
        mx = fmaxf(mx, __shfl_xor(mx, 16)); mx = fmaxf(mx, __shfl_xor(mx, 32));
        float sum = 0.f;
#pragma unroll
        for (int nt = 0; nt < 8; ++nt)
#pragma unroll
            for (int rg = 0; rg < 4; ++rg) { const float p = (s[nt][rg] > -5e29f) ? __builtin_amdgcn_exp2f(s[nt][rg] - mx) : 0.f; s[nt][rg] = p; sum += p; }
        sum += __shfl_xor(sum, 16); sum += __shfl_xor(sum, 32);
        const float inv = (t >= 31) ? 1.0f / sum : 0.f;
#pragma unroll
        for (int nt = 0; nt < 8; ++nt) { s[nt] = s[nt] * inv; *(LAS f32x4*)(PS + fr * 132 + 16 * nt + 4 * q) = s[nt]; }
        f32x4 oc[4];
#pragma unroll
        for (int dt = 0; dt < 4; ++dt) oc[dt] = (f32x4){0.f, 0.f, 0.f, 0.f};
#pragma unroll
        for (int k2 = 0; k2 < 4; ++k2) { v4u pf; pf.x = pk2(s[2 * k2][0], s[2 * k2][1]); pf.y = pk2(s[2 * k2][2], s[2 * k2][3]); pf.z = pk2(s[2 * k2 + 1][0], s[2 * k2 + 1][1]); pf.w = pk2(s[2 * k2 + 1][2], s[2 * k2 + 1][3]);
#pragma unroll
            for (int dt = 0; dt < 4; ++dt) { const v2u va = *(const LAS v2u*)(VT + (16 * dt + fr) * 136 + 32 * k2 + 4 * q), vb = *(const LAS v2u*)(VT + (16 * dt + fr) * 136 + 32 * k2 + 16 + 4 * q);
                v4u vf; vf.x = va.x; vf.y = va.y; vf.z = vb.x; vf.w = vb.y; oc[dt] = mfma16(vf, pf, oc[dt]); } }
        const float gg = g ? g0[1] : g0[0];
#pragma unroll
        for (int dt = 0; dt < 4; ++dt) { const f32x4 v = oc[dt] * gg; if (g) facc[1][dt] = v; else facc[0][dt] = v; }
        LDS_WAIT();
        const int tt2 = lane >> 4, jl = lane & 15, t2 = t0 + 8 * wave + 4 * g + tt2, cur = t2 >> 6;
        float key[2];
#pragma unroll
        for (int x = 0; x < 2; ++x) { const int j = jl + 16 * x; float im = 0.f;
#pragma unroll
            for (int i = 0; i < 5; ++i) { const int c = 4 * j - 1 + i;
                if (c >= 0 && c <= 126) { im += PS[(4 * tt2 + 0) * 132 + c]; im += PS[(4 * tt2 + 1) * 132 + c]; im += PS[(4 * tt2 + 2) * 132 + c]; im += PS[(4 * tt2 + 3) * 132 + c]; } }
            const bool valid = j <= cur, forced = (j == 0) | (j == cur) | (j == cur - 1);
            key[x] = valid ? (forced ? im + 1e4f : im) : -1e30f; IMP[tt2 * 32 + j] = key[x]; }
        LDS_WAIT();
        int rk0 = 0, rk1 = 0;
        f32x4 kq[8];
#pragma unroll
        for (int i = 0; i < 8; ++i) kq[i] = *(const LAS f32x4*)(IMP + tt2 * 32 + 4 * i);
#pragma unroll
        for (int j2 = 0; j2 < 32; ++j2) { const float k2 = kq[j2 >> 2][j2 & 3];
            rk0 += ((k2 > key[0]) || (k2 == key[0] && j2 < jl)) ? 1 : 0; rk1 += ((k2 > key[1]) || (k2 == key[1] && j2 < jl + 16)) ? 1 : 0; }
        const bool sel0 = (jl <= cur) && rk0 < 8, sel1 = (jl + 16 <= cur) && rk1 < 8;
        const unsigned long long bal0 = __ballot(sel0), bal1 = __ballot(sel1);
        const unsigned mk = (unsigned)((bal0 >> (16 * tt)) & 0xffffull) | ((unsigned)((bal1 >> (16 * tt)) & 0xffffull) << 16);
        unsigned wa = 0;
#pragma unroll
        for (int x = 0; x < 4; ++x) wa |= (unsigned)((bal0 >> (16 * x)) & 0xffffull) | ((unsigned)((bal1 >> (16 * x)) & 0xffffull) << 16);
        if (g) { msk[1] = mk; wny[1] = wa; } else { msk[0] = mk; wny[0] = wa; }
        LDS_WAIT();
    }
    if (lane == 0) WANY[wave] = wny[0] | wny[1];
    *(LAS v4u*)(TB + skey * 72 + 8 * spc) = kr; *(LAS v4u*)(TB + 4608 + skey * 72 + 8 * spc) = vr;
    __syncthreads();
    unsigned uni = 0;
#pragma unroll
    for (int w = 0; w < 8; ++w) uni |= WANY[w];
    int cph = 0, cj = 0, nph = 0, nj = 0, tb = 0;
#define ATT_ADV(ph, j) do { if (ph == 0) { const unsigned rem = uni & ~((2u << j) - 1u); if (rem) j = __builtin_ctz(rem); else { ph = 1; j = wlo; } } else if (++j > curb) ph = 2; } while (0)
    ATT_ADV(nph, nj);
    float m_run[2] = {-1e4f, -1e4f}; f32x4 o5[2], o[2][4];
#pragma unroll
    for (int g = 0; g < 2; ++g) { o5[g] = (f32x4){0.f, 0.f, 0.f, 0.f};
#pragma unroll
        for (int dt = 0; dt < 4; ++dt) o[g][dt] = (f32x4){0.f, 0.f, 0.f, 0.f}; }
    while (cph != 2) {
        if (nph != 2) { kr = *(const v4u*)KADDR(nj, nph ? ZC_KW : ZC_KS); vr = *(const v4u*)((nph ? VTW : VTS) + vbase + 64 * nj); }
        { const LAS bf16* Kb = TB + tb * 9216; const LAS bf16* Vb = Kb + 4608; const int kb = 64 * cj;
            const bool need[2] = { cph ? true : (bool)((wny[0] >> cj) & 1u), cph ? true : (bool)((wny[1] >> cj) & 1u) };
            if (need[0] || need[1]) { const float rb[2] = { (cph || ((msk[0] >> cj) & 1u)) ? 0.f : -1e30f, (cph || ((msk[1] >> cj) & 1u)) ? 0.f : -1e30f };
                const int tA = tq[0], tB = tq[1], wl = cph ? 512 : (1 << 30);
                attn_tile2(Kb, Vb, qf, fr, q, m_run, o5, o, need, rb, (cj == curb) || (cph && cj <= wlo),
                           [=](int g, int kk) { const int kp = kb + kk, tg = g ? tB : tA; return (kp <= tg) && (kp > tg - wl); }); } }
        if (nph != 2) { LAS bf16* Kn = TB + (tb ^ 1) * 9216; *(LAS v4u*)(Kn + skey * 72 + 8 * spc) = kr; *(LAS v4u*)(Kn + 4608 + skey * 72 + 8 * spc) = vr; }
        if (cph == 0 && nph == 1) {
#pragma unroll
            for (int g = 0; g < 2; ++g) { const float lt = __shfl(o5[g][0], fr); const float sc = g1[g] / lt;
#pragma unroll
                for (int dt = 0; dt < 4; ++dt) { facc[g][dt] = facc[g][dt] + o[g][dt] * sc; o[g][dt] = (f32x4){0.f, 0.f, 0.f, 0.f}; }
                m_run[g] = -1e4f; o5[g] = (f32x4){0.f, 0.f, 0.f, 0.f}; } }
        __syncthreads();
        cph = nph; cj = nj; tb ^= 1; ATT_ADV(nph, nj);
    }
#undef ATT_ADV
#pragma unroll
    for (int g = 0; g < 2; ++g) { const float lt = __shfl(o5[g][0], fr); const float sc = g2[g] / lt;
#pragma unroll
        for (int dt = 0; dt < 4; ++dt) { const f32x4 v = facc[g][dt] + o[g][dt] * sc; v2u w; w.x = pk2(v.x, v.y); w.y = pk2(v.z, v.w);
            *(v2u*)(MIX + grow[g] * DM + 512 + 64 * hh + 16 * dt + 4 * q) = w; } }
}
#undef KADDR
#undef Z
#undef MIX
#undef VTS
#undef VTW
#undef KC
#undef VCT

#define XB_TMO      128
#define XB_XCNT(j)  (256  + 64 * (j))
#define XB_XSUB(j)  (1280 + 64 * (j))
#define XB_XGEN(j)  (2304 + 64 * (j))
#define XB_TOP      3328
#define XB_TOPGEN   3392
#define XCD_BAR_WORDS 3456
#define XB_SPIN_CAP (1u << 18)

__device__ __forceinline__ unsigned xb_ld(unsigned* p)              { return __hip_atomic_load(p, __ATOMIC_RELAXED, __HIP_MEMORY_SCOPE_AGENT); }
__device__ __forceinline__ unsigned xb_add(unsigned* p, unsigned v) { return __hip_atomic_fetch_add(p, v, __ATOMIC_RELAXED, __HIP_MEMORY_SCOPE_AGENT); }
__device__ __forceinline__ unsigned xb_xcc_id() { return (unsigned)__builtin_amdgcn_s_getreg((3 << 11) | 20) & 0xFu; }
#define XB_SPIN(cond, bar) do { unsigned _sp = 0; while (cond) { __builtin_amdgcn_s_sleep(1); \
    if ((++_sp & 255u) == 0u) { if (xb_ld(&(bar)[XB_TMO])) break; if (_sp > XB_SPIN_CAP) { atomicAdd(&(bar)[XB_TMO], 1u); break; } } } } while (0)

struct XcdBarrier {
    unsigned* bar; unsigned x;
    volatile LAS unsigned* st;
};

__device__ __forceinline__ XcdBarrier xcd_barrier_post(unsigned* bar, volatile LAS unsigned* st) {
    XcdBarrier b; b.bar = bar; b.x = xb_xcc_id(); b.st = st;
    if (threadIdx.x == 0) (void)xb_add(&bar[XB_XCNT(b.x)], 1u);
    return b;
}
__device__ __forceinline__ void xcd_barrier_complete(unsigned* bar, unsigned x, unsigned& nloc, unsigned& nx) {
    const unsigned G = gridDim.x * gridDim.y * gridDim.z;
    unsigned sum, cnt, mine, sp = 0u;
    for (;;) {
        sum = 0u; cnt = 0u; mine = 0u;
#pragma unroll
        for (unsigned j = 0; j < 16; ++j) { const unsigned c = xb_ld(&bar[XB_XCNT(j)]); sum += c; cnt += (c > 0u) ? 1u : 0u; mine = (j == x) ? c : mine; }
        if (sum == G) break;
        __builtin_amdgcn_s_sleep(1);
        if ((++sp & 255u) == 0u) { if (xb_ld(&bar[XB_TMO])) break; if (sp > XB_SPIN_CAP) { atomicAdd(&bar[XB_TMO], 1u); break; } }
    }
    nloc = mine > 0u ? mine : 1u; nx = cnt > 0u ? cnt : 1u;
}

__device__ __forceinline__ void xcd_barrier(const XcdBarrier& b) {
    asm volatile("s_waitcnt vmcnt(0)" ::: "memory");
    __syncthreads();
    if (threadIdx.x == 0) {
        unsigned* bar = b.bar;
        __builtin_amdgcn_s_waitcnt(0);
        unsigned nloc = b.st[0], nx = b.st[1];
        if (nloc == 0u) { xcd_barrier_complete(bar, b.x, nloc, nx); b.st[0] = nloc; b.st[1] = nx; }
        const unsigned old = xb_add(&bar[XB_XSUB(b.x)], 1u);
        const unsigned gen = old / nloc;
        if (old + 1u == (gen + 1u) * nloc) {
            __builtin_amdgcn_fence(__ATOMIC_RELEASE, "agent");
            asm volatile("s_waitcnt vmcnt(0)" ::: "memory");
            const unsigned og = xb_add(&bar[XB_TOP], 1u);
            const unsigned tg = og / nx;
            if (og + 1u == (tg + 1u) * nx) xb_add(&bar[XB_TOPGEN], 1u);
            else XB_SPIN(xb_ld(&bar[XB_TOPGEN]) == tg, bar);
            __builtin_amdgcn_fence(__ATOMIC_ACQUIRE, "agent");
            xb_add(&bar[XB_XGEN(b.x)], 1u);
            asm volatile("s_waitcnt vmcnt(0)" ::: "memory");
        } else {
            XB_SPIN(xb_ld(&bar[XB_XGEN(b.x)]) == gen, bar);
            __builtin_amdgcn_fence(__ATOMIC_ACQUIRE, "agent");
            asm volatile("s_waitcnt vmcnt(0)" ::: "memory");
        }
    }
    __syncthreads();
}

#ifndef POSTBAR_SLEEP
#define POSTBAR_SLEEP do {} while (0)
#endif
#ifndef MIXD_NEW
#define MIXD_NEW 1
#endif
#ifndef MIXB_LNNEW
#define MIXB_LNNEW 1
#endif
#ifndef ATDRY
#define ATDRY 0
#endif
#ifndef ITREP
#define ITREP 0
#endif
#ifndef REPMASK
#define REPMASK 0
#endif
#ifndef PHSEL
#define PHSEL 0xfff
#endif
constexpr int N_PHASES = 1 + 8 * DEPTH;
__global__ void __launch_bounds__(NTHREADS) hybrid_fwd(Args KA) {
    extern __shared__ __attribute__((aligned(16))) unsigned char lds_raw[];
    LAS unsigned char* lds = (LAS unsigned char*)lds_raw;
    cg::grid_group grid = cg::this_grid();
    volatile LAS unsigned* MISC = (volatile LAS unsigned*)(lds + LDS_BYTES - 64);
    if (threadIdx.x < 16) MISC[threadIdx.x] = 0u;
    __syncthreads();
    const XcdBarrier bar = xcd_barrier_post((unsigned*)(KA.ws + WS_CTL), MISC);
#define SEAM(first) do { if (first) { __threadfence(); asm volatile("s_waitcnt vmcnt(0)" ::: "memory"); grid.sync(); __builtin_amdgcn_fence(__ATOMIC_ACQUIRE, "agent"); asm volatile("s_waitcnt vmcnt(0)" ::: "memory"); __syncthreads(); } else { xcd_barrier(bar); POSTBAR_SLEEP; } } while (0)
#if REPMASK
    for (int ph2 = 2 * KA.ph_lo; ph2 < 2 * KA.ph_hi; ++ph2) {
        const int ph = ph2 >> 1;
        if (ph2 & 1) { const int stx = (ph == 0) ? 8 : ((ph - 1) & 7); if (!(((REPMASK & ~0x90) >> stx) & 1) && !((REPMASK >> 9) & 1)) continue; }
        if (ph2 > 2 * KA.ph_lo) SEAM(ph2 == 2 * KA.ph_lo + 2);
        if (ph2 & 1) { const int stx = (ph == 0) ? 8 : ((ph - 1) & 7); if (!(((REPMASK & ~0x90) >> stx) & 1)) continue; }
#else
    for (int ph = KA.ph_lo; ph < KA.ph_hi; ++ph) {
        if (ph > KA.ph_lo) SEAM(ph == KA.ph_lo + 1);
#endif
        ArgP A = (ArgP)__builtin_amdgcn_kernarg_segment_ptr(); asm volatile("" : "+s"(A));
        int tid = threadIdx.x; asm volatile("" : "+v"(tid));
        int G = gridDim.x, bid = blockIdx.x; asm volatile("" : "+s"(G), "+s"(bid));
        const int ngw = G * NWAVES;
        const int lane = tid & 63, wave = __builtin_amdgcn_readfirstlane(tid >> 6), gw = bid * NWAVES + wave;
        unsigned char* ws = A->ws;
        bf16* H = (bf16*)(ws + WS_H); bf16* Zb = (bf16*)(ws + WS_Z); bf16* MIX = (bf16*)(ws + WS_MIX); bf16* HID = (bf16*)(ws + WS_HID); bf16* Y = (bf16*)(ws + WS_Y); float* R2 = (float*)(ws + WS_R2);
        if (ph == 0) {
#if PHSEL & 1
            LAS float* scr = (LAS float*)(lds + wave * 16384);
            for (int it = gw; it < DEPTH * TI_LAYER; it += ngw) prologue_item(A, it, scr, lane);
            for (int idx = bid * NTHREADS + tid; idx < DEPTH * 65536; idx += G * NTHREADS) { const int l = idx >> 16, rem = idx & 65535, tq = (rem >> 7) & 127, sq = rem & 127;
                ((bf16*)(ws + WS_W + (size_t)l * WS_WL + WO_SG))[rem] = (sq <= tq) ? (bf16)f2bf(A->in[I_SGW][idx]) : (bf16)0; }
            norm_first(A->in[I_X], H, R2, bid, G, wave, lane);
#endif
            continue;
        }
        const int l = (ph - 1) >> 3, st = (ph - 1) & 7;
        unsigned char* wl = ws + WS_W + (size_t)l * WS_WL;
        if (st == 0) {
#if PHSEL & 2
            pg8::Gemm g{H, (const bf16*)(wl + WO_IN), MROWS, ZC, DM}; pg8::StaticOrder S; S.init(MROWS, ZC, G, bid);
            pg8::EpiBf16RS E{Zb, 256, R2 + (size_t)(2 * l) * MROWS, ZT};
            pg8::gemm_phase<pg8::EpiBf16RS, pg8::StaticOrder, PG8_ALIGN, PG8_SP2>(lds, g, S, E);
#endif
        } else if (st == 1) {
#if PHSEL & 4
            for (int it0 = bid; it0 < 1536 + (ITREP ? 512 : 0); it0 += G) {
                int it = it0; int tid_i = tid; ArgP A_i = A; asm volatile("" : "+v"(tid_i), "+s"(A_i));
                const int lane_i = tid_i & 63, wave_i = __builtin_amdgcn_readfirstlane(tid_i >> 6);
                if (G == 256 && it0 < 1536) {
                    const int xcd = bid & 7, j = bid >> 3, k = it0 >> 8;
                    if (k == 0) it = (2 * xcd + (j >> 4)) * 16 + (j & 15);
                    else if (k <= 2) it = 256 + (2 * xcd + (k - 1)) * 32 + j;
                    else if (k <= 4) it = 768 + (2 * xcd + (k - 3)) * 32 + j;
                    else it = 1280 + (2 * xcd + (j >> 4)) * 16 + (j & 15); }
                if (it0 >= 1536) { const int e = it0 - 1536; if (ITREP == 1) { if (e >= 256) continue; it = e; } else if (ITREP == 2) it = 256 + e; else if (ITREP == 4) it = 768 + e; else { if (e >= 256) continue; it = 1280 + e; } }
                if (it < 256) {
#if PHSEL & 256
                    mixer_a(A_i, l, it, lds, tid_i, wave_i, lane_i);
#endif
                } else if (it < 768) {
#if PHSEL & 512
                    mixer_b(A_i, l, it - 256, lds, tid_i, wave_i, lane_i);
#endif
                } else if (it < 1280) {
#if PHSEL & 1024
                    mixer_d(A_i, l, it - 768, lds, tid_i, wave_i, lane_i);
#endif
                } else {
#if PHSEL & 2048
                    nsa_compress(A_i, l, it - 1280, lds, tid_i, wave_i, lane_i);
#endif
                }
            }
#endif
        } else if (st == 2) {
#if PHSEL & 8
            for (int it = bid; it < 512; it += G) { int tid_i = tid; ArgP A_i = A; asm volatile("" : "+v"(tid_i), "+s"(A_i));
                nsa_attn(A_i, l, it, lds, tid_i, __builtin_amdgcn_readfirstlane(tid_i >> 6), tid_i & 63); }
#endif
        } else if (st == 3 || st == 6) {
#if PHSEL & 16
            pg8::Gemm g{st == 3 ? MIX : HID, (const bf16*)(wl + (st == 3 ? WO_OUT : WO_DN)), MROWS, DM, st == 3 ? DM : FFH}; pg8::StaticOrder S; S.init(MROWS, DM, G, bid);
            pg8::EpiBf16<0> E{Y, DM, nullptr, 0, 0, 1.f};
            pg8::gemm_phase<pg8::EpiBf16<0>, pg8::StaticOrder, PG8_ALIGN, PG8_SP2>(lds, g, S, E);
#endif
        } else if (st == 4) {
#if PHSEL & 32
#if (REPMASK >> 4) & 1
            norm_bf<false>(H, HID, Y, A->in[I_GQM] + l * DM, (float*)(ws + WS_MIX), nullptr, bid, G, wave, lane);
#endif
            norm_bf<false>(H, H, Y, A->in[I_GQM] + l * DM, R2 + (size_t)(2 * l + 1) * MROWS, nullptr, bid, G, wave, lane);
#endif
        } else if (st == 5) {
#if PHSEL & 64
            pg8::Gemm g{H, (const bf16*)(wl + WO_GU), MROWS, 2 * FFH, DM}; pg8::StaticOrder S; S.init(MROWS, 2 * FFH, G, bid);
            pg8::EpiSwiGLU E{HID, FFH, R2 + (size_t)(2 * l + 1) * MROWS};
            pg8::gemm_phase<pg8::EpiSwiGLU, pg8::StaticOrder, PG8_ALIGN, PG8_SP2>(lds, g, S, E);
#endif
        } else {
#if PHSEL & 128
            const bool last = (l == DEPTH - 1);
#if (REPMASK >> 7) & 1
            norm_bf<false>(H, HID, Y, A->in[I_GQF] + l * DM, (float*)(ws + WS_MIX), nullptr, bid, G, wave, lane);
#endif
            if (last) norm_bf<true>(H, H, Y, A->in[I_GQF] + l * DM, nullptr, A->out, bid, G, wave, lane);
            else norm_bf<false>(H, H, Y, A->in[I_GQF] + l * DM, R2 + (size_t)(2 * l + 2) * MROWS, nullptr, bid, G, wave, lane);
#endif
        }
    }
}

#ifndef MK_MULTI
#define MK_MULTI 0
#endif
extern "C" void kernel_launch(void* const* d_in, const int* in_sizes, int n_in, void* d_out, int out_size, void* d_ws, size_t ws_size, hipStream_t stream) {
    static int grid = 0;
    if (grid == 0) {
        if (n_in != 26 || out_size != MROWS * DM || ws_size < WS_END) { fprintf(stderr, "kernel_launch: unexpected shapes (n_in %d out %d ws %zu)\n", n_in, out_size, ws_size); grid = -1; return; }
        int dev = 0, cus = 0, per_cu = 0;
        hipGetDevice(&dev); hipDeviceGetAttribute(&cus, hipDeviceAttributeMultiprocessorCount, dev);
        hipFuncSetAttribute((const void*)hybrid_fwd, hipFuncAttributeMaxDynamicSharedMemorySize, LDS_BYTES);
        hipOccupancyMaxActiveBlocksPerMultiprocessor(&per_cu, (const void*)hybrid_fwd, NTHREADS, LDS_BYTES);
        if (per_cu < 1) per_cu = 1;
        grid = cus * per_cu;
        (void)hipGetLastError();
    }
    if (grid < 0) return;
    Args a{};
    for (int i = 0; i < 26; ++i) a.in[i] = (const float*)d_in[i];
    a.out = (float*)d_out; a.ws = (unsigned char*)d_ws;
    if (hipMemsetAsync((char*)d_ws + WS_CTL, 0, CTL_BYTES, stream) != hipSuccess) { fprintf(stderr, "kernel_launch: memset of the barrier words failed\n"); return; }
#if MK_MULTI
    for (int ph = 0; ph < N_PHASES; ++ph) { a.ph_lo = ph; a.ph_hi = ph + 1; hipLaunchKernelGGL(hybrid_fwd, dim3(grid), dim3(NTHREADS), LDS_BYTES, stream, a); }
#else
    a.ph_lo = 0; a.ph_hi = N_PHASES;
    void* args[] = {&a};
    hipError_t e = hipLaunchCooperativeKernel((const void*)hybrid_fwd, dim3(grid), dim3(NTHREADS), args, LDS_BYTES, stream);
    if (e != hipSuccess) fprintf(stderr, "cooperative launch failed: %s (grid %d)\n", hipGetErrorString(e), grid);
#endif
}
```
